# Optimizing an MI355X kernel written in HIP

```python
import math
import jax, jax.numpy as jnp
from jax import lax
import numpy as np


D_MODEL = 2048
BATCH = 1
SEQ = 16384
DEPTH = 2

N_MIXERS = 2
RMS_EPS = 1e-6

SSM_WIDTH = D_MODEL
SSM_GROUP = 16
SSM_GROUPS = SSM_WIDTH // SSM_GROUP
SSM_STATE = 64
SSM_CHUNK = 128
DT_MIN = 1e-3
DT_MAX = 1e-1

NSA_HEADS = 16
NSA_HEAD_DIM = 128
NSA_KV_GROUPS = 4
NSA_REP = NSA_HEADS // NSA_KV_GROUPS
NSA_KV_WIDTH = NSA_KV_GROUPS * NSA_HEAD_DIM
N_BRANCH = 3
NSA_IN_WIDTH = NSA_HEADS * NSA_HEAD_DIM + 2 * N_BRANCH * NSA_KV_WIDTH + N_BRANCH * NSA_HEADS
CMP_LEN = 32
CMP_STRIDE = 16
SEL_LEN = 64
SEL_TOPN = 16
WIN = 512
Q_BLOCK = 128

PEER_HEADS = 8
PEER_NKEYS = 128
PEER_EXPERTS = PEER_NKEYS ** 2
PEER_TOPK = 16
PEER_QDIM = 256
PEER_HALF = PEER_QDIM // 2
PEER_CHUNK = 128

kernel_name = 'hybrid_s5_nsa_peer_adaln'


def rmsnorm(x, g):
    xf = x.astype(jnp.float32)
    xf = xf * lax.rsqrt(jnp.mean(xf * xf, axis=-1, keepdims=True) + RMS_EPS)
    return xf.astype(x.dtype) * g


def modulate(h, shift, scale):
    return h * (1 + scale[:, None, :]) + shift[:, None, :]


def masked_softmax(s, mask, axis=-1):
    s = jnp.where(mask, s.astype(jnp.float32), -1e30)
    m = jnp.max(s, axis=axis, keepdims=True)
    p = jnp.exp(s - m) * mask
    return p / jnp.maximum(jnp.sum(p, axis=axis, keepdims=True), 1e-30)


def _lin_rec_combine(e1, e2):
    a1r, a1i, b1r, b1i = e1
    a2r, a2i, b2r, b2i = e2
    return (a1r * a2r - a1i * a2i,
            a1r * a2i + a1i * a2r,
            a2r * b1r - a2i * b1i + b2r,
            a2r * b1i + a2i * b1r + b2i)


def s5_scan(u, lam_re, lam_im, log_dt, b_re, b_im, c_re, c_im, d_skip):
    f32 = jnp.float32
    lam_re, lam_im = lam_re.astype(f32), lam_im.astype(f32)
    b_re, b_im, c_re, c_im = (t.astype(f32) for t in (b_re, b_im, c_re, c_im))
    d_skip = d_skip.astype(f32)
    dt = jnp.exp(log_dt.astype(f32))[:, None]
    mag = jnp.exp(lam_re * dt)
    ar, ai = mag * jnp.cos(lam_im * dt), mag * jnp.sin(lam_im * dt)
    den = lam_re * lam_re + lam_im * lam_im
    coef_r = ((ar - 1.0) * lam_re + ai * lam_im) / den
    coef_i = (ai * lam_re - (ar - 1.0) * lam_im) / den
    bb_r = coef_r[..., None] * b_re - coef_i[..., None] * b_im
    bb_i = coef_r[..., None] * b_im + coef_i[..., None] * b_re
    Bsz, L, G, P = u.shape
    n_chunks = L // SSM_CHUNK
    uc = u.reshape(Bsz, n_chunks, SSM_CHUNK, G, P).transpose(1, 0, 2, 3, 4)
    a_r = jnp.broadcast_to(ar, (Bsz, SSM_CHUNK, G, SSM_STATE))
    a_i = jnp.broadcast_to(ai, (Bsz, SSM_CHUNK, G, SSM_STATE))

    def step(carry, u_blk):
        hr, hi = carry
        bu_r = jnp.einsum('btgp,gnp->btgn', u_blk, bb_r)
        bu_i = jnp.einsum('btgp,gnp->btgn', u_blk, bb_i)
        cr, ci, sr, si = lax.associative_scan(_lin_rec_combine, (a_r, a_i, bu_r, bu_i), axis=1)
        sr = sr + cr * hr[:, None] - ci * hi[:, None]
        si = si + cr * hi[:, None] + ci * hr[:, None]
        y = jnp.einsum('gpn,btgn->btgp', c_re, sr) - jnp.einsum('gpn,btgn->btgp', c_im, si)
        y = y + d_skip * u_blk
        return (sr[:, -1], si[:, -1]), y

    init = (jnp.zeros((Bsz, G, SSM_STATE), f32), jnp.zeros((Bsz, G, SSM_STATE), f32))
    _, ys = lax.scan(step, init, uc)
    return ys.transpose(1, 0, 2, 3, 4).reshape(Bsz, L, G, P)


def s5_mixer(h, w_in, lam_re, lam_im, log_dt, b_re, b_im, c_re, c_im, d_skip, w_out):
    Bsz, L, _ = h.shape
    u = (h @ w_in).reshape(Bsz, L, SSM_GROUPS, SSM_GROUP)
    y = s5_scan(u.astype(jnp.float32), lam_re, lam_im, log_dt, b_re, b_im, c_re, c_im, d_skip)
    y = jax.nn.gelu(y.reshape(Bsz, L, SSM_WIDTH).astype(h.dtype))
    a, b = jnp.split(y @ w_out, 2, axis=-1)
    return a * jax.nn.sigmoid(b)


def compress_blocks(kv, cmp_idx, pos, w1, w2):
    blk = kv[:, cmp_idx] + pos[None, None, :, None, :]
    hid = jax.nn.gelu(jnp.einsum('bnlgd,ldh->bngh', blk, w1))
    return jnp.einsum('bngh,he->bnge', hid, w2)


def nsa_mixer(h, w_in, k_pos, k_w1, k_w2, v_pos, v_w1, v_w2, w_out):
    Bsz, L, _ = h.shape
    G, R, DH = NSA_KV_GROUPS, NSA_REP, NSA_HEAD_DIM
    proj = h @ w_in
    sizes = [NSA_HEADS * DH] + [NSA_KV_WIDTH] * (2 * N_BRANCH) + [N_BRANCH * NSA_HEADS]
    q, kc, vc, ks, vs, kw, vw, gl = jnp.split(proj, np.cumsum(sizes)[:-1].tolist(), axis=-1)
    q = q.reshape(Bsz, L, G, R, DH)
    kc, vc, ks, vs, kw, vw = (t.reshape(Bsz, L, G, DH) for t in (kc, vc, ks, vs, kw, vw))
    gates = jax.nn.sigmoid(gl).reshape(Bsz, L, G, R, N_BRANCH)
    scale = DH ** -0.5

    n_cmp = (L - CMP_LEN) // CMP_STRIDE + 1
    cmp_idx = np.arange(n_cmp)[:, None] * CMP_STRIDE + np.arange(CMP_LEN)[None, :]
    k_cmp = compress_blocks(kc, cmp_idx, k_pos, k_w1, k_w2)
    v_cmp = compress_blocks(vc, cmp_idx, v_pos, v_w1, v_w2)
    cmp_end = jnp.asarray(np.arange(n_cmp) * CMP_STRIDE + CMP_LEN - 1)

    n_sel = L // SEL_LEN
    ratio, span = SEL_LEN // CMP_STRIDE, CMP_LEN // CMP_STRIDE
    agg = np.zeros((n_cmp, n_sel), np.float32)
    jj = np.arange(n_sel)
    for m in range(ratio):
        for n in range(span):
            ii = ratio * jj + m - n
            ok = (ii >= 0) & (ii < n_cmp)
            agg[ii[ok], jj[ok]] += 1.0
    agg = jnp.asarray(agg)
    top_n = min(SEL_TOPN, n_sel)

    ks_blk = ks.reshape(Bsz, n_sel, SEL_LEN, G, DH).transpose(0, 3, 1, 2, 4)
    vs_blk = vs.reshape(Bsz, n_sel, SEL_LEN, G, DH).transpose(0, 3, 1, 2, 4)
    kw_pad = jnp.pad(kw, ((0, 0), (WIN, 0), (0, 0), (0, 0)))
    vw_pad = jnp.pad(vw, ((0, 0), (WIN, 0), (0, 0), (0, 0)))
    b_ix = jnp.arange(Bsz)[:, None, None, None]
    g_ix = jnp.arange(G)[None, None, :, None]
    blk_ids = jnp.arange(n_sel)
    in_blk = jnp.arange(SEL_LEN)
    win_off = jnp.arange(Q_BLOCK + WIN)

    def query_block(bi):
        t0 = bi * Q_BLOCK
        tpos = t0 + jnp.arange(Q_BLOCK)
        qb = lax.dynamic_slice_in_dim(q, t0, Q_BLOCK, axis=1)
        gb = lax.dynamic_slice_in_dim(gates, t0, Q_BLOCK, axis=1)
        s_c = jnp.einsum('btgrd,bigd->bgrti', qb, k_cmp) * scale
        p_c = masked_softmax(s_c, cmp_end[None, :] <= tpos[:, None])
        o_c = jnp.einsum('bgrti,bigd->btgrd', p_c.astype(v_cmp.dtype), v_cmp)
        imp = jnp.einsum('bgrti,ij->btgj', p_c, agg)
        cur = tpos // SEL_LEN
        forced = (blk_ids[None] == 0) | (blk_ids[None] == cur[:, None]) | (blk_ids[None] == cur[:, None] - 1)
        valid = blk_ids[None] * SEL_LEN <= tpos[:, None]
        score = jnp.where(forced[None, :, None, :], 1e9, jnp.where(valid[None, :, None, :], imp, -1e9))
        _, sel = lax.top_k(score, top_n)
        k_g = ks_blk[b_ix, g_ix, sel]
        v_g = vs_blk[b_ix, g_ix, sel]
        s_s = jnp.einsum('btgrd,btgnsd->btgrns', qb, k_g) * scale
        tok = sel[..., None] * SEL_LEN + in_blk
        mask_s = (tok <= tpos[None, :, None, None, None])[:, :, :, None]
        p_s = masked_softmax(s_s, mask_s, axis=(-2, -1))
        o_s = jnp.einsum('btgrns,btgnsd->btgrd', p_s.astype(v_g.dtype), v_g)
        kwb = lax.dynamic_slice_in_dim(kw_pad, t0, Q_BLOCK + WIN, axis=1)
        vwb = lax.dynamic_slice_in_dim(vw_pad, t0, Q_BLOCK + WIN, axis=1)
        spos = t0 - WIN + win_off
        diff = tpos[:, None] - spos[None, :]
        mask_w = (diff >= 0) & (diff < WIN) & (spos[None, :] >= 0)
        s_w = jnp.einsum('btgrd,bsgd->bgrts', qb, kwb) * scale
        p_w = masked_softmax(s_w, mask_w)
        o_w = jnp.einsum('bgrts,bsgd->btgrd', p_w.astype(vwb.dtype), vwb)
        o = gb[..., 0:1] * o_c + gb[..., 1:2] * o_s + gb[..., 2:3] * o_w
        return o.reshape(Bsz, Q_BLOCK, NSA_HEADS * DH)

    o = lax.map(query_block, jnp.arange(L // Q_BLOCK))
    o = o.transpose(1, 0, 2, 3).reshape(Bsz, L, NSA_HEADS * DH)
    return o @ w_out


def peer_ffn(h, w_q, sub_keys, u_tab, v_tab):
    Bsz, L, D = h.shape
    T = Bsz * L
    xt = h.reshape(T, D)
    q = (xt @ w_q).reshape(T, PEER_HEADS, 2, PEER_HALF)
    s = jnp.einsum('thcd,hckd->thck', q, sub_keys).astype(jnp.float32)
    s1, i1 = lax.top_k(s[:, :, 0], PEER_TOPK)
    s2, i2 = lax.top_k(s[:, :, 1], PEER_TOPK)
    cand_s = (s1[..., :, None] + s2[..., None, :]).reshape(T, PEER_HEADS, PEER_TOPK * PEER_TOPK)
    cand_e = (i1[..., :, None] * PEER_NKEYS + i2[..., None, :]).reshape(T, PEER_HEADS, PEER_TOPK * PEER_TOPK)
    top_s, top_pos = lax.top_k(cand_s, PEER_TOPK)
    experts = jnp.take_along_axis(cand_e, top_pos, axis=-1)
    gate = jax.nn.softmax(top_s, axis=-1).astype(h.dtype)
    E = PEER_HEADS * PEER_TOPK
    n_chunks = T // PEER_CHUNK

    def expert_chunk(args):
        xc, ec, gc = args
        u = u_tab[ec]
        act = jax.nn.gelu(jnp.einsum('cd,ced->ce', xc, u))
        return jnp.einsum('ce,ced->cd', gc * act, v_tab[ec])

    y = lax.map(expert_chunk, (xt.reshape(n_chunks, PEER_CHUNK, D),
                               experts.reshape(n_chunks, PEER_CHUNK, E),
                               gate.reshape(n_chunks, PEER_CHUNK, E)))
    return y.reshape(Bsz, L, D)


def setup_inputs(seed: int = 0) -> dict:
    key = jax.random.key(seed)
    ks = jax.random.split(key, 32)
    f32 = jnp.float32

    def nrm(k, shape, s):
        return s * jax.random.normal(k, shape, f32)

    n_ssm = (DEPTH + 1) // 2
    n_nsa = DEPTH // 2
    D, G, N, P, DH = D_MODEL, SSM_GROUPS, SSM_STATE, SSM_GROUP, NSA_HEAD_DIM
    return {
        'x': nrm(ks[0], (BATCH, SEQ, D), 1.0),
        'c': nrm(ks[1], (BATCH, D), 1.0),
        'ada_w': nrm(ks[2], (DEPTH, D, 6 * D), 0.5 * D ** -0.5),
        'ada_b': nrm(ks[3], (DEPTH, 6 * D), 0.02),
        'norm_mix': 1.0 + nrm(ks[4], (DEPTH, D), 0.02),
        'norm_ffn': 1.0 + nrm(ks[5], (DEPTH, D), 0.02),
        'norm_final': 1.0 + nrm(ks[6], (D,), 0.02),
        'ssm_w_in': nrm(ks[7], (n_ssm, D, SSM_WIDTH), D ** -0.5),
        'ssm_lambda_re': -0.5 + nrm(ks[8], (n_ssm, G, N), 0.01),
        'ssm_lambda_im': math.pi * jnp.arange(N, dtype=f32) + nrm(ks[9], (n_ssm, G, N), 0.01),
        'ssm_log_dt': jax.random.uniform(ks[10], (n_ssm, G), f32, math.log(DT_MIN), math.log(DT_MAX)),
        'ssm_b_re': nrm(ks[11], (n_ssm, G, N, P), (2 * P) ** -0.5),
        'ssm_b_im': nrm(ks[12], (n_ssm, G, N, P), (2 * P) ** -0.5),
        'ssm_c_re': nrm(ks[13], (n_ssm, G, P, N), 2 ** -0.5),
        'ssm_c_im': nrm(ks[14], (n_ssm, G, P, N), 2 ** -0.5),
        'ssm_d': nrm(ks[15], (n_ssm, G, P), 0.5),
        'ssm_w_out': nrm(ks[16], (n_ssm, SSM_WIDTH, 2 * D), SSM_WIDTH ** -0.5),
        'nsa_w_in': nrm(ks[17], (n_nsa, D, NSA_IN_WIDTH), D ** -0.5),
        'nsa_cmp_k_pos': nrm(ks[18], (n_nsa, CMP_LEN, DH), 0.1),
        'nsa_cmp_k_w1': nrm(ks[19], (n_nsa, CMP_LEN, DH, DH), (CMP_LEN * DH) ** -0.5),
        'nsa_cmp_k_w2': nrm(ks[20], (n_nsa, DH, DH), DH ** -0.5),
        'nsa_cmp_v_pos': nrm(ks[21], (n_nsa, CMP_LEN, DH), 0.1),
        'nsa_cmp_v_w1': nrm(ks[22], (n_nsa, CMP_LEN, DH, DH), (CMP_LEN * DH) ** -0.5),
        'nsa_cmp_v_w2': nrm(ks[23], (n_nsa, DH, DH), DH ** -0.5),
        'nsa_w_out': nrm(ks[24], (n_nsa, NSA_HEADS * DH, D), (NSA_HEADS * DH) ** -0.5),
        'peer_w_q': nrm(ks[25], (DEPTH, D, PEER_HEADS * PEER_QDIM), D ** -0.5),
        'peer_sub_keys': nrm(ks[26], (DEPTH, PEER_HEADS, 2, PEER_NKEYS, PEER_HALF), PEER_HALF ** -0.5),
        'peer_u': nrm(ks[27], (DEPTH, PEER_EXPERTS, D), D ** -0.5),
        'peer_v': nrm(ks[28], (DEPTH, PEER_EXPERTS, D), 1.0),
    }


def reference(x, c, ada_w, ada_b, norm_mix, norm_ffn, norm_final,
              ssm_w_in, ssm_lambda_re, ssm_lambda_im, ssm_log_dt, ssm_b_re, ssm_b_im,
              ssm_c_re, ssm_c_im, ssm_d, ssm_w_out,
              nsa_w_in, nsa_cmp_k_pos, nsa_cmp_k_w1, nsa_cmp_k_w2,
              nsa_cmp_v_pos, nsa_cmp_v_w1, nsa_cmp_v_w2, nsa_w_out,
              peer_w_q, peer_sub_keys, peer_u, peer_v):
    cond = jax.nn.silu(c)
    for i in range(DEPTH):
        mod = cond @ ada_w[i] + ada_b[i]
        sh1, sc1, g1, sh2, sc2, g2 = jnp.split(mod, 6, axis=-1)
        h = modulate(rmsnorm(x, norm_mix[i]), sh1, sc1)
        j = i // N_MIXERS
        if i % N_MIXERS == 0:
            y = s5_mixer(h, ssm_w_in[j], ssm_lambda_re[j], ssm_lambda_im[j], ssm_log_dt[j],
                         ssm_b_re[j], ssm_b_im[j], ssm_c_re[j], ssm_c_im[j], ssm_d[j], ssm_w_out[j])
        else:
            y = nsa_mixer(h, nsa_w_in[j], nsa_cmp_k_pos[j], nsa_cmp_k_w1[j], nsa_cmp_k_w2[j],
                          nsa_cmp_v_pos[j], nsa_cmp_v_w1[j], nsa_cmp_v_w2[j], nsa_w_out[j])
        x = x + g1[:, None, :] * y
        h = modulate(rmsnorm(x, norm_ffn[i]), sh2, sc2)
        x = x + g2[:, None, :] * peer_ffn(h, peer_w_q[i], peer_sub_keys[i], peer_u[i], peer_v[i])
    return rmsnorm(x, norm_final)
```

```cpp
#include <hip/hip_runtime.h>
#include <hip/hip_cooperative_groups.h>
#include <cstdio>
#include <cstdint>
namespace cg = cooperative_groups;

#define DI __device__ __forceinline__
#define LAS __attribute__((address_space(3)))
typedef unsigned short bf16_t;
typedef unsigned int u32;
typedef short bf16x8 __attribute__((ext_vector_type(8)));
typedef float f32x4 __attribute__((ext_vector_type(4)));
typedef float f32x16 __attribute__((ext_vector_type(16)));
typedef unsigned u32x4 __attribute__((ext_vector_type(4)));
typedef unsigned u32x2 __attribute__((ext_vector_type(2)));

constexpr int DM = 2048;
constexpr int SEQ = 16384;
constexpr int NT = 512;
constexpr int LDS_BYTES = 131072;

constexpr size_t MB = 1024 * 1024;
constexpr size_t WS_MOD    = 0;
constexpr size_t WS_POSB   = 98304;
constexpr size_t WS_SEND   = 1 * MB;
constexpr size_t WS_WT_SIN = 2 * MB;
constexpr size_t WS_WT_SOUT= WS_WT_SIN + 8 * MB;
constexpr size_t WS_WT_NIN = WS_WT_SOUT + 16 * MB;
constexpr size_t WS_WT_NOUT= WS_WT_NIN + 21 * MB;
constexpr size_t WS_WT_PQ  = WS_WT_NOUT + 8 * MB;
constexpr size_t WS_SUBK   = WS_WT_PQ + 16 * MB;
constexpr size_t WS_CW1T   = WS_SUBK + 1 * MB;
constexpr size_t WS_PU     = WS_CW1T + 2 * MB;
constexpr size_t WS_PV     = WS_PU + 128 * MB;
constexpr size_t WS_H      = WS_PV + 128 * MB;
constexpr size_t WS_BUFA   = WS_H + 64 * MB;
constexpr size_t WS_BUFB   = WS_BUFA + 64 * MB;
constexpr size_t WS_XA     = WS_BUFB + 64 * MB;
constexpr size_t WS_EXP    = WS_XA + 128 * MB;
constexpr size_t WS_GATE   = WS_EXP + 8 * MB;
constexpr size_t WS_KV     = WS_GATE + 8 * MB;
constexpr size_t WS_GL     = WS_KV + 96 * MB;
constexpr size_t WS_KCMP   = WS_GL + 3 * MB;
constexpr size_t WS_VCMPT  = WS_KCMP + 1 * MB;
constexpr size_t WS_VST    = WS_VCMPT + 1 * MB;
constexpr size_t WS_VWT    = WS_VST + 16 * MB;
constexpr size_t WS_END    = WS_VWT + 16 * MB;
constexpr size_t KV_T      = (size_t)4 * SEQ * 128;

struct Args { const float* in[29]; float* out; unsigned char* ws; int ph_lo, ph_hi; };
typedef const __attribute__((address_space(4))) Args* ArgsP;
DI ArgsP args_fresh(ArgsP p) { asm volatile("" : "+s"(p)); return p; }

DI float bf2f(bf16_t b) { return __uint_as_float(((u32)b) << 16); }
DI float bflo(u32 w) { return __uint_as_float(w << 16); }
DI float bfhi(u32 w) { return __uint_as_float(w & 0xffff0000u); }
DI bf16_t f2bf(float f) { u32 u = __float_as_uint(f); u += 0x7fffu + ((u >> 16) & 1u); return (bf16_t)(u >> 16); }
DI u32 pk_bf16(float lo, float hi) { return (u32)f2bf(lo) | ((u32)f2bf(hi) << 16); }
DI float fast_rcp(float x) { return __builtin_amdgcn_rcpf(x); }
DI float sigmoidf_(float x) { return fast_rcp(1.0f + __expf(-x)); }
DI float gelu_tanh(float x) { const float z = 1.5957691216057308f * (x + 0.044715f * x * x * x); return x * fast_rcp(1.0f + __expf(-z)); }
DI float wave_sum(float v) {
#pragma unroll
    for (int o = 32; o >= 1; o >>= 1) v += __shfl_xor(v, o);
    return v;
}
namespace pg8 {
#define PG8_LAS __attribute__((address_space(3)))
typedef unsigned short bf16_t;
typedef short bf16x8 __attribute__((ext_vector_type(8)));
typedef float f32x4 __attribute__((ext_vector_type(4)));
typedef unsigned u32x4 __attribute__((ext_vector_type(4)));
constexpr int BM = 256, BK = 64, HALF = 128, HTB = HALF * BK * 2  , STAGE_BYTES = 8 * HTB, NXCD = 8, WGM = 8;

__host__ __device__ __forceinline__ int lds_byte(int r, int c) { const int st = (r >> 4) * 2 + (c >> 5), rr = r & 15, cc = c & 31, ob = rr * 64 + cc * 2; return st * 1024 + (ob ^ (((ob >> 9) & 1) << 5)); }
__host__ __device__ __forceinline__ void stage_rc(int b, int& R, int& C) { const int st = b / 1024, sb = b % 1024, swz = sb ^ (((sb >> 9) & 1) << 5); R = (st >> 1) * 16 + swz / 64; C = (st & 1) * 32 + (swz % 64) / 2; }
__host__ __device__ __forceinline__ int perm32(int rho) { const int n = rho >> 4, i = rho & 15; return 8 * (i >> 2) + 4 * n + (i & 3); }

struct Unit { int pm, pn; };
struct Gemm { const bf16_t* A; const bf16_t* Bt; int M, N, K; };

struct StaticOrder {
    int nM, nN, nwg, G, c;
    __host__ __device__ void init(int M, int N, int G_, int c_) { nM = M / BM; nN = N / BM; nwg = nM * nN; G = G_; c = c_; }
    __host__ __device__ bool next(int i, Unit& u) const {
        const long L = (long)i * G + c; if (L >= nwg) return false;
        int wgid = (int)L; { const int q = nwg / NXCD, r = nwg % NXCD, xcd = wgid % NXCD, off = wgid / NXCD; wgid = (xcd < r ? xcd * (q + 1) : r * (q + 1) + (xcd - r) * q) + off; }
        const int nig = WGM * nN, gid = wgid / nig, fm = gid * WGM, gsz = (nM - fm) < WGM ? (nM - fm) : WGM;
        u.pm = fm + ((wgid % nig) % gsz); u.pn = (wgid % nig) / gsz; return true;
    }
    __device__ __forceinline__ void a_ready(const Unit&) const {}
    __device__ __forceinline__ void done(const Unit&) const {}
};
__device__ __forceinline__ unsigned cvt_pk_bf16(float lo, float hi) { unsigned r; asm volatile("v_cvt_pk_bf16_f32 %0, %1, %2" : "=v"(r) : "v"(lo), "v"(hi)); return r; }
struct EpiStoreBf16 {
    static constexpr bool PERM = true, AFTER_DRAIN = false;
    bf16_t* O; int ldc;
    __device__ __forceinline__ void operator()(const f32x4 (&acc)[2][2][4][2], const Unit& u, int wr, int wc, int fr, int fq) const {
        const int row0 = u.pm * BM + wr * 64 + fr, col0 = u.pn * BM + wc * 32 + 8 * fq;
#pragma unroll
        for (int ai = 0; ai < 2; ++ai)
#pragma unroll
            for (int m = 0; m < 4; ++m) { bf16_t* rowp = O + (size_t)(row0 + ai * HALF + m * 16) * ldc + col0;
#pragma unroll
                for (int bj = 0; bj < 2; ++bj) { const f32x4 v0 = acc[ai][bj][m][0], v1 = acc[ai][bj][m][1];
                    u32x4 w; w.x = cvt_pk_bf16(v0[0], v0[1]); w.y = cvt_pk_bf16(v0[2], v0[3]); w.z = cvt_pk_bf16(v1[0], v1[1]); w.w = cvt_pk_bf16(v1[2], v1[3]);
                    *(u32x4*)(rowp + bj * HALF) = w; } }
    }
};
struct EpiGlu {
    static constexpr bool PERM = false, AFTER_DRAIN = false;
    const float* xin; float* xout; const float* g1;
    __device__ __forceinline__ void operator()(const f32x4 (&acc)[2][2][4][2], const Unit& u, int wr, int wc, int fr, int fq) const {
        const int row0 = u.pm * BM + wr * 64 + fr, col0 = u.pn * HALF + wc * 32 + 4 * fq;
#pragma unroll
        for (int ai = 0; ai < 2; ++ai)
#pragma unroll
            for (int m = 0; m < 4; ++m) { const size_t ro = (size_t)(row0 + ai * HALF + m * 16) * DM;
#pragma unroll
                for (int n = 0; n < 2; ++n) { const int col = col0 + 16 * n;
                    const f32x4 a = acc[ai][0][m][n], b = acc[ai][1][m][n];
                    const f32x4 xi = *(const f32x4*)(xin + ro + col), gg = *(const f32x4*)(g1 + col);
                    f32x4 o;
#pragma unroll
                    for (int j = 0; j < 4; ++j) o[j] = xi[j] + gg[j] * a[j] * __builtin_amdgcn_rcpf(1.0f + __expf(-b[j]));
                    *(f32x4*)(xout + ro + col) = o; } }
    }
};
struct EpiResid {
    static constexpr bool PERM = false, AFTER_DRAIN = false;
    float* x; const float* g1;
    __device__ __forceinline__ void operator()(const f32x4 (&acc)[2][2][4][2], const Unit& u, int wr, int wc, int fr, int fq) const {
        const int row0 = u.pm * BM + wr * 64 + fr, col0 = u.pn * BM + wc * 32 + 4 * fq;
#pragma unroll
        for (int ai = 0; ai < 2; ++ai)
#pragma unroll
            for (int m = 0; m < 4; ++m) { float* rowp = x + (size_t)(row0 + ai * HALF + m * 16) * DM + col0;
#pragma unroll
                for (int bj = 0; bj < 2; ++bj)
#pragma unroll
                    for (int n = 0; n < 2; ++n) { const f32x4 gg = *(const f32x4*)(g1 + col0 + bj * HALF + n * 16);
                        f32x4 xi = *(const f32x4*)(rowp + bj * HALF + n * 16); xi += gg * acc[ai][bj][m][n]; *(f32x4*)(rowp + bj * HALF + n * 16) = xi; } }
    }
};
struct EpiNsaIn {
    static constexpr bool PERM = true, AFTER_DRAIN = false;
    bf16_t* Q; bf16_t* KV; float* GL;
    __device__ __forceinline__ void operator()(const f32x4 (&acc)[2][2][4][2], const Unit& u, int wr, int wc, int fr, int fq) const {
        const int row0 = u.pm * BM + wr * 64 + fr, lc0 = wc * 32 + 8 * fq;
#pragma unroll
        for (int ai = 0; ai < 2; ++ai)
#pragma unroll
            for (int m = 0; m < 4; ++m) { const int row = row0 + ai * HALF + m * 16;
#pragma unroll
                for (int bj = 0; bj < 2; ++bj) { const f32x4 v0 = acc[ai][bj][m][0], v1 = acc[ai][bj][m][1];
                    if (u.pn < 20) {
                        u32x4 w; w.x = cvt_pk_bf16(v0[0], v0[1]); w.y = cvt_pk_bf16(v0[2], v0[3]); w.z = cvt_pk_bf16(v1[0], v1[1]); w.w = cvt_pk_bf16(v1[2], v1[3]);
                        bf16_t* dst;
                        if (u.pn < 8) dst = Q + (size_t)row * DM + u.pn * BM + bj * HALF + lc0;
                        else { const int tsr = (u.pn - 8) >> 1, c512 = ((u.pn - 8) & 1) * 256 + bj * HALF + lc0, g = c512 >> 7, d = c512 & 127;
                               dst = KV + (size_t)tsr * ((size_t)4 * SEQ * 128) + ((size_t)g * SEQ + row) * 128 + d; }
                        *(u32x4*)dst = w;
                    } else if (bj == 0 && lc0 < 48) {
                        float* dst = GL + (size_t)row * 48 + lc0; f32x4 s0, s1;
#pragma unroll
                        for (int j = 0; j < 4; ++j) { s0[j] = __builtin_amdgcn_rcpf(1.0f + __expf(-v0[j])); s1[j] = __builtin_amdgcn_rcpf(1.0f + __expf(-v1[j])); }
                        *(f32x4*)dst = s0; *(f32x4*)(dst + 4) = s1;
                    } } }
    }
};
template <class Epi, class Sched, bool STAMP = false>
__device__ __forceinline__ void gemm_phase(PG8_LAS unsigned char* lds, const Gemm g, const Sched& S, const Epi& E, unsigned long long* stamps) {
    const int tid = threadIdx.x, wid = __builtin_amdgcn_readfirstlane(tid >> 6), lane = tid & 63, wr = wid >> 2, wc = wid & 3, fr = lane & 15, fq = lane >> 4;
    const int K = g.K, nt = K / BK;
    int ts_lo = 0, ts_hi = 0, nts = 0; const unsigned long long rt_entry = STAMP ? (unsigned long long)wall_clock64() : 0ull;
#define PG8_STAMP() do { if (STAMP && wid == 0 && nts < 64) { const unsigned long long _c = (unsigned long long)clock64(); \
        ts_lo = (lane == nts) ? (int)(unsigned)_c : ts_lo; ts_hi = (lane == nts) ? (int)(unsigned)(_c >> 32) : ts_hi; ++nts; } } while (0)
    PG8_STAMP();
    unsigned voffA[2], voffB[2];
#pragma unroll
    for (int i = 0; i < 2; ++i) { int R, C; stage_rc(tid * 16 + i * 8192, R, C); const int Rb = Epi::PERM ? ((R & ~31) + perm32(R & 31)) : R;
        voffA[i] = (unsigned)(R * K + C) * 2u; voffB[i] = (unsigned)(Rb * K + C) * 2u; }
    const size_t kstep = (size_t)(BK * 2);
    const size_t hstep = (size_t)HALF * K * 2;
    const size_t tstep = 2 * hstep;
    const unsigned ldsw = (unsigned)wid * 1024u;
    const int aoff = lds_byte(wr * 64 + fr, fq * 8), boff = lds_byte(wc * 32 + fr, fq * 8);
#define PG8_SA(b, h) (((b) * 2 + (h)) * HTB)
#define PG8_SB(b, h) ((4 + (b) * 2 + (h)) * HTB)
#define PG8_STAGE(bufoff, gbase, voff) do { _Pragma("unroll") for (int _i = 0; _i < 2; ++_i) \
        __builtin_amdgcn_global_load_lds((const unsigned*)((const char*)(gbase) + (voff)[_i]), (PG8_LAS unsigned*)(lds + (bufoff) + ldsw + _i * 8192), 16, 0, 0); } while (0)
#define PG8_LDA(dst, b, h) do { _Pragma("unroll") for (int m = 0; m < 4; ++m) _Pragma("unroll") for (int k = 0; k < 2; ++k) dst[m][k] = *(const PG8_LAS bf16x8*)(lds + PG8_SA(b, h) + aoff + m * 2048 + k * 1024); } while (0)
#define PG8_LDB(dst, b, h) do { _Pragma("unroll") for (int n = 0; n < 2; ++n) _Pragma("unroll") for (int k = 0; k < 2; ++k) dst[n][k] = *(const PG8_LAS bf16x8*)(lds + PG8_SB(b, h) + boff + n * 2048 + k * 1024); } while (0)
#define PG8_MMA(ai, bj, At, Bt) do { __builtin_amdgcn_s_setprio(1); _Pragma("unroll") for (int m = 0; m < 4; ++m) _Pragma("unroll") for (int n = 0; n < 2; ++n) _Pragma("unroll") for (int k = 0; k < 2; ++k) \
        acc[ai][bj][m][n] = __builtin_amdgcn_mfma_f32_16x16x32_bf16(Bt[n][k], At[m][k], acc[ai][bj][m][n], 0, 0, 0); __builtin_amdgcn_s_setprio(0); } while (0)
#define PG8_WAIT_V(n) asm volatile("s_waitcnt vmcnt(" #n ")" ::: "memory")
#define PG8_WAIT_L(n) asm volatile("s_waitcnt lgkmcnt(" #n ")" ::: "memory")
#define PG8_BAR __builtin_amdgcn_s_barrier()
#define PG8_SCHED __builtin_amdgcn_sched_barrier(0)
    Unit cur, nxt; int ui = 0;
    if (!S.next(0, cur)) return;
    f32x4 acc[2][2][4][2];
#pragma unroll
    for (int a = 0; a < 2; ++a)
#pragma unroll
        for (int b = 0; b < 2; ++b)
#pragma unroll
            for (int m = 0; m < 4; ++m)
#pragma unroll
                for (int n = 0; n < 2; ++n) acc[a][b][m][n] = (f32x4){0.f, 0.f, 0.f, 0.f};
    bf16x8 At[4][2], B0[2][2], B1[2][2];
    const char* cA = (const char*)g.A + (size_t)cur.pm * tstep; const char* cB = (const char*)g.Bt + (size_t)cur.pn * tstep;
    S.a_ready(cur);
    PG8_STAGE(PG8_SB(0, 0), cB, voffB); PG8_STAGE(PG8_SA(0, 0), cA, voffA); PG8_STAGE(PG8_SB(0, 1), cB + hstep, voffB); PG8_STAGE(PG8_SA(0, 1), cA + hstep, voffA);
    if (wr == 1) PG8_BAR;
    PG8_WAIT_V(4); PG8_BAR;
    PG8_STAGE(PG8_SB(1, 0), cB + kstep, voffB); PG8_STAGE(PG8_SA(1, 0), cA + kstep, voffA); PG8_STAGE(PG8_SB(1, 1), cB + hstep + kstep, voffB);
    PG8_WAIT_V(6); PG8_BAR;
    PG8_STAMP();
    for (;;) {
        const bool has_next = S.next(ui + 1, nxt);
        const char* nA = has_next ? (const char*)g.A + (size_t)nxt.pm * tstep : cA; const char* nB = has_next ? (const char*)g.Bt + (size_t)nxt.pn * tstep : cB;
        for (int t = 0; t < nt; t += 2) {
            const bool last = (t == nt - 2);
            const char* a1 = cA + (size_t)(t + 1) * kstep;
            const char* a2 = last ? nA : cA + (size_t)(t + 2) * kstep; const char* b2 = last ? nB : cB + (size_t)(t + 2) * kstep;
            const char* a3 = a2 + kstep; const char* b3 = b2 + kstep;
            if (last && has_next) S.a_ready(nxt);
            PG8_LDB(B0, 0, 0); PG8_SCHED; PG8_LDA(At, 0, 0); PG8_STAGE(PG8_SA(1, 1), a1 + hstep, voffA);
            PG8_WAIT_L(8); PG8_BAR; PG8_WAIT_L(0); PG8_MMA(0, 0, At, B0); PG8_BAR; PG8_SCHED;
            PG8_LDB(B1, 0, 1); PG8_STAGE(PG8_SB(0, 0), b2, voffB);
            PG8_BAR; PG8_WAIT_L(0); PG8_MMA(0, 1, At, B1); PG8_BAR;
            PG8_LDA(At, 0, 1); PG8_STAGE(PG8_SA(0, 0), a2, voffA);
            PG8_BAR; PG8_WAIT_L(0); PG8_MMA(1, 0, At, B0); PG8_BAR; PG8_SCHED;
            PG8_STAGE(PG8_SB(0, 1), b2 + hstep, voffB);
            PG8_WAIT_V(6); PG8_BAR; PG8_MMA(1, 1, At, B1); PG8_BAR;
            PG8_LDB(B0, 1, 0); PG8_SCHED; PG8_LDA(At, 1, 0); PG8_STAGE(PG8_SA(0, 1), a2 + hstep, voffA);
            PG8_WAIT_L(8); PG8_BAR; PG8_WAIT_L(0); PG8_MMA(0, 0, At, B0); PG8_BAR; PG8_SCHED;
            PG8_LDB(B1, 1, 1); PG8_STAGE(PG8_SB(1, 0), b3, voffB);
            PG8_BAR; PG8_WAIT_L(0); PG8_MMA(0, 1, At, B1); PG8_BAR;
            PG8_LDA(At, 1, 1); PG8_STAGE(PG8_SA(1, 0), a3, voffA);
            PG8_BAR; PG8_WAIT_L(0); PG8_MMA(1, 0, At, B0); PG8_BAR; PG8_SCHED;
            PG8_STAGE(PG8_SB(1, 1), b3 + hstep, voffB);
            PG8_WAIT_V(6); PG8_BAR; PG8_MMA(1, 1, At, B1); PG8_BAR;
        }
        PG8_STAMP();
        if constexpr (!Epi::AFTER_DRAIN) { E(acc, cur, wr, wc, fr, fq); S.done(cur); }
        PG8_STAMP();
        if (!has_next) break;
#pragma unroll
        for (int a = 0; a < 2; ++a)
#pragma unroll
            for (int b = 0; b < 2; ++b)
#pragma unroll
                for (int m = 0; m < 4; ++m)
#pragma unroll
                    for (int n = 0; n < 2; ++n) acc[a][b][m][n] = (f32x4){0.f, 0.f, 0.f, 0.f};
        cur = nxt; cA = nA; cB = nB; ++ui;
    }
    PG8_WAIT_V(0);
    if (wr == 0) PG8_BAR;
    PG8_BAR;
    if constexpr (Epi::AFTER_DRAIN) { E.fused(acc, cur, wr, wc, fr, fq, lds, wid, lane); S.done(cur); }
    PG8_STAMP();
    if (STAMP && wid == 0) { stamps[lane] = lane < nts ? (((unsigned long long)(unsigned)ts_hi << 32) | (unsigned)ts_lo) : 0ull;
        if (lane == 62) stamps[62] = rt_entry; if (lane == 63) stamps[63] = (unsigned long long)wall_clock64(); }
#undef PG8_STAMP
#undef PG8_SA
#undef PG8_SB
#undef PG8_STAGE
#undef PG8_LDA
#undef PG8_LDB
#undef PG8_MMA
#undef PG8_WAIT_V
#undef PG8_WAIT_L
#undef PG8_BAR
#undef PG8_SCHED
}
}

constexpr int P0_GEMV = 96;
constexpr int P0_TR0 = P0_GEMV;
constexpr int P0_TR_TOTAL = 1024 + 2048 + 2688 + 1024 + 1024 + 1024 + 128 + 128;
constexpr int P0_CV0 = P0_TR0 + P0_TR_TOTAL;
constexpr int CV_PU = 8192, CV_PV = 8192, CV_SK = 64;
constexpr int P0_PB0 = P0_CV0 + CV_PU + CV_PV + CV_SK;
constexpr int P0_TOTAL = P0_PB0 + 2;

DI void p0_gemv(ArgsP a, int item, LAS float* sm) {
    const int tid = threadIdx.x, layer = item / 48, n0 = (item % 48) * 256, nl = tid & 255, kh = tid >> 8;
    const float* c = a->in[1];
    for (int k = tid; k < DM; k += NT) { const float cv = c[k]; sm[k] = cv / (1.0f + __expf(-cv)); }
    __syncthreads();
    const float* W = a->in[2] + (size_t)layer * DM * 12288 + n0 + nl;
    float acc0 = 0.f, acc1 = 0.f, acc2 = 0.f, acc3 = 0.f;
    const int k0 = kh * 1024;
    for (int k = k0; k < k0 + 1024; k += 8) {
        float w[8];
#pragma unroll
        for (int j = 0; j < 8; ++j) w[j] = W[(size_t)(k + j) * 12288];
        acc0 += sm[k] * w[0] + sm[k + 4] * w[4]; acc1 += sm[k + 1] * w[1] + sm[k + 5] * w[5];
        acc2 += sm[k + 2] * w[2] + sm[k + 6] * w[6]; acc3 += sm[k + 3] * w[3] + sm[k + 7] * w[7];
    }
    __syncthreads();
    sm[DM + tid] = (acc0 + acc1) + (acc2 + acc3);
    __syncthreads();
    if (tid < 256) { float* mod = (float*)(a->ws + WS_MOD); mod[layer * 12288 + n0 + nl] = sm[DM + tid] + sm[DM + tid + 256] + a->in[3][layer * 12288 + n0 + nl]; }
    __syncthreads();
}

DI void p0_transpose(ArgsP a, int idx, LAS float* sm) {
    int mat, base;
    if (idx < 1024) { mat = 0; base = 0; } else if (idx < 3072) { mat = 1; base = 1024; } else if (idx < 5760) { mat = 2; base = 3072; } else if (idx < 6784) { mat = 3; base = 5760; }
    else if (idx < 7808) { mat = 4; base = 6784; } else if (idx < 8832) { mat = 5; base = 7808; } else if (idx < 8960) { mat = 6; base = 8832; } else { mat = 7; base = 8960; }
    int N = 2048, K = 2048, Nsrc = 2048; const float* src = nullptr; bf16_t* dst = nullptr;
    switch (mat) {
        case 0: src = a->in[7];  dst = (bf16_t*)(a->ws + WS_WT_SIN);  N = 2048; K = 2048; Nsrc = 2048; break;
        case 1: src = a->in[16]; dst = (bf16_t*)(a->ws + WS_WT_SOUT); N = 4096; K = 2048; Nsrc = 4096; break;
        case 2: src = a->in[17]; dst = (bf16_t*)(a->ws + WS_WT_NIN);  N = 5376; K = 2048; Nsrc = 5168; break;
        case 3: src = a->in[24]; dst = (bf16_t*)(a->ws + WS_WT_NOUT); N = 2048; K = 2048; Nsrc = 2048; break;
        case 4: src = a->in[25]; dst = (bf16_t*)(a->ws + WS_WT_PQ);   N = 2048; K = 2048; Nsrc = 2048; break;
        case 5: src = a->in[25] + (size_t)DM * DM; dst = (bf16_t*)(a->ws + WS_WT_PQ) + (size_t)DM * DM; N = 2048; K = 2048; Nsrc = 2048; break;
        case 6: src = a->in[19]; dst = (bf16_t*)(a->ws + WS_CW1T); N = 128; K = 4096; Nsrc = 128; break;
        default: src = a->in[22]; dst = (bf16_t*)(a->ws + WS_CW1T) + (size_t)128 * 4096; N = 128; K = 4096; Nsrc = 128; break;
    }
    const int li = idx - base, ntn = N / 64, nt = li % ntn, kt = li / ntn, k0 = kt * 64, nd0 = nt * 64;
    int ns0 = nd0;
    if (mat == 1) { const int pn = nt >> 2, r0 = (nt & 3) * 64; ns0 = (r0 < 128) ? (128 * pn + r0) : (2048 + 128 * pn + r0 - 128); }
    const int tid = threadIdx.x, kl = tid >> 4, n4 = (tid & 15) * 4;
#pragma unroll
    for (int h = 0; h < 2; ++h) {
        const int k = kl + 32 * h; f32x4 v = {0.f, 0.f, 0.f, 0.f};
        if (ns0 + n4 < Nsrc) v = *(const f32x4*)(src + (size_t)(k0 + k) * Nsrc + ns0 + n4);
        sm[k * 65 + n4] = v[0]; sm[k * 65 + n4 + 1] = v[1]; sm[k * 65 + n4 + 2] = v[2]; sm[k * 65 + n4 + 3] = v[3];
    }
    __syncthreads();
    const int nl = tid >> 3, k8 = (tid & 7) * 8;
    u32x4 w;
    w.x = pk_bf16(sm[(k8 + 0) * 65 + nl], sm[(k8 + 1) * 65 + nl]); w.y = pk_bf16(sm[(k8 + 2) * 65 + nl], sm[(k8 + 3) * 65 + nl]);
    w.z = pk_bf16(sm[(k8 + 4) * 65 + nl], sm[(k8 + 5) * 65 + nl]); w.w = pk_bf16(sm[(k8 + 6) * 65 + nl], sm[(k8 + 7) * 65 + nl]);
    *(u32x4*)(dst + (size_t)(nd0 + nl) * K + k0 + k8) = w;
    __syncthreads();
}

DI void p0_convert(const float* src, bf16_t* dst, int item) {
    const size_t e0 = (size_t)item * 8192 + (size_t)threadIdx.x * 8;
#pragma unroll
    for (int h = 0; h < 2; ++h) {
        const size_t e = e0 + (size_t)h * 4096;
        const f32x4 v0 = *(const f32x4*)(src + e), v1 = *(const f32x4*)(src + e + 4);
        u32x4 w; w.x = pk_bf16(v0[0], v0[1]); w.y = pk_bf16(v0[2], v0[3]); w.z = pk_bf16(v1[0], v1[1]); w.w = pk_bf16(v1[2], v1[3]);
        *(u32x4*)(dst + e) = w;
    }
}

DI void p0_posb(ArgsP a, int kv, LAS float* sm) {
    const float* pos = a->in[kv ? 21 : 18]; const float* w1 = a->in[kv ? 22 : 19];
    const int tid = threadIdx.x, h = tid & 127, part = tid >> 7;
    float acc = 0.f;
    for (int i = part * 1024; i < part * 1024 + 1024; ++i) acc += pos[i] * w1[(size_t)i * 128 + h];
    sm[tid] = acc; __syncthreads();
    if (tid < 128) ((float*)(a->ws + WS_POSB))[kv * 128 + tid] = (sm[tid] + sm[tid + 128]) + (sm[tid + 256] + sm[tid + 384]);
    __syncthreads();
}

DI void phase_prep(ArgsP a, LAS unsigned char* lds) {
    LAS float* sm = (LAS float*)lds;
    for (int item = blockIdx.x; item < P0_TOTAL; item += gridDim.x) {
        if (item < P0_GEMV) p0_gemv(a, item, sm);
        else if (item < P0_CV0) p0_transpose(a, item - P0_TR0, sm);
        else if (item < P0_CV0 + CV_PU) p0_convert(a->in[27], (bf16_t*)(a->ws + WS_PU), item - P0_CV0);
        else if (item < P0_CV0 + CV_PU + CV_PV) p0_convert(a->in[28], (bf16_t*)(a->ws + WS_PV), item - P0_CV0 - CV_PU);
        else if (item < P0_PB0) p0_convert(a->in[26], (bf16_t*)(a->ws + WS_SUBK), item - P0_CV0 - CV_PU - CV_PV);
        else p0_posb(a, item - P0_PB0, sm);
    }
}

DI void phase_norm(const float* x, const float* gamma, const float* shift, const float* scale, bf16_t* H) {
    const int lane = threadIdx.x & 63, wave = threadIdx.x >> 6;
    for (int row = blockIdx.x * 8 + wave; row < SEQ; row += gridDim.x * 8) {
        const float* xr = x + (size_t)row * DM;
        f32x4 v[8]; float ss = 0.f;
#pragma unroll
        for (int j = 0; j < 8; ++j) { v[j] = *(const f32x4*)(xr + 4 * lane + 256 * j); ss += v[j][0] * v[j][0] + v[j][1] * v[j][1] + v[j][2] * v[j][2] + v[j][3] * v[j][3]; }
        ss = wave_sum(ss);
        const float rstd = rsqrtf(ss * (1.0f / DM) + 1e-6f);
#pragma unroll
        for (int j = 0; j < 8; ++j) {
            const int col = 4 * lane + 256 * j;
            const f32x4 g = *(const f32x4*)(gamma + col), sc = *(const f32x4*)(scale + col), sh = *(const f32x4*)(shift + col);
            float o[4];
#pragma unroll
            for (int i = 0; i < 4; ++i) o[i] = (v[j][i] * rstd * g[i]) * (1.0f + sc[i]) + sh[i];
            u32x2 w; w.x = pk_bf16(o[0], o[1]); w.y = pk_bf16(o[2], o[3]);
            *(u32x2*)(H + (size_t)row * DM + col) = w;
        }
    }
}

struct S5Par { float ar, ai; float bbr[16], bbi[16]; };
DI void s5_setup(ArgsP a, int g, int n, S5Par& P) {
    const float lre = a->in[8][g * 64 + n], lim = a->in[9][g * 64 + n], dt = expf(a->in[10][g]);
    const float mag = expf(lre * dt); P.ar = mag * cosf(lim * dt); P.ai = mag * sinf(lim * dt);
    const float den = lre * lre + lim * lim;
    const float cr = ((P.ar - 1.0f) * lre + P.ai * lim) / den, ci = (P.ai * lre - (P.ar - 1.0f) * lim) / den;
    const float* br = a->in[11] + (size_t)(g * 64 + n) * 16; const float* bi = a->in[12] + (size_t)(g * 64 + n) * 16;
#pragma unroll
    for (int p = 0; p < 16; ++p) { const float r = br[p], i = bi[p]; P.bbr[p] = cr * r - ci * i; P.bbi[p] = cr * i + ci * r; }
}
DI void s5_step(const S5Par& P, const u32x4 w0, const u32x4 w1, float& hr, float& hi) {
    float sr = 0.f, si = 0.f;
#pragma unroll
    for (int q = 0; q < 4; ++q) {
        const float u0 = bflo(w0[q]), u1 = bfhi(w0[q]), u2 = bflo(w1[q]), u3 = bfhi(w1[q]);
        sr += P.bbr[2 * q] * u0 + P.bbr[2 * q + 1] * u1; si += P.bbi[2 * q] * u0 + P.bbi[2 * q + 1] * u1;
        sr += P.bbr[8 + 2 * q] * u2 + P.bbr[8 + 2 * q + 1] * u3; si += P.bbi[8 + 2 * q] * u2 + P.bbi[8 + 2 * q + 1] * u3;
    }
    const float nr = P.ar * hr - P.ai * hi + sr, ni = P.ar * hi + P.ai * hr + si;
    hr = nr; hi = ni;
}
DI void phase_s5a(ArgsP a) {
    const int lane = threadIdx.x & 63, wave = threadIdx.x >> 6;
    const bf16_t* U = (const bf16_t*)(a->ws + WS_BUFA);
    float* Send = (float*)(a->ws + WS_SEND);
    for (int bi = blockIdx.x; bi < 256; bi += gridDim.x) {
        const int g = bi >> 1, c = (bi & 1) * 8 + wave;
        if (c == 15) continue;
        S5Par P; s5_setup(a, g, lane, P);
        float hr = 0.f, hi = 0.f;
        const bf16_t* up = U + (size_t)c * 1024 * DM + g * 16;
        for (int t = 0; t < 1024; t += 4) {
            u32x4 w[4][2];
#pragma unroll
            for (int k = 0; k < 4; ++k) { w[k][0] = *(const u32x4*)(up + (size_t)(t + k) * DM); w[k][1] = *(const u32x4*)(up + (size_t)(t + k) * DM + 8); }
#pragma unroll
            for (int k = 0; k < 4; ++k) s5_step(P, w[k][0], w[k][1], hr, hi);
        }
        Send[((size_t)(c * 128 + g) * 64 + lane) * 2] = hr; Send[((size_t)(c * 128 + g) * 64 + lane) * 2 + 1] = hi;
    }
}
DI void phase_s5c(ArgsP a, LAS unsigned char* lds) {
    const int tid = threadIdx.x, lane = tid & 63, wave = tid >> 6;
    const bf16_t* U = (const bf16_t*)(a->ws + WS_BUFA);
    bf16_t* YG = (bf16_t*)(a->ws + WS_BUFB);
    const float* Send = (const float*)(a->ws + WS_SEND);
    LAS f32x4* C4 = (LAS f32x4*)lds;
    LAS float* Hb = (LAS float*)(lds + 8192 + wave * 8192);
    for (int bi = blockIdx.x; bi < 256; bi += gridDim.x) {
        const int g = bi >> 1, c = (bi & 1) * 8 + wave;
        __syncthreads();
        { const int n2 = tid >> 4, p = tid & 15;
          const float* cre = a->in[13] + (size_t)(g * 16 + p) * 64 + 2 * n2; const float* cim = a->in[14] + (size_t)(g * 16 + p) * 64 + 2 * n2;
          C4[n2 * 16 + p] = (f32x4){cre[0], cim[0], cre[1], cim[1]}; }
        __syncthreads();
        S5Par P; s5_setup(a, g, lane, P);
        float hr = 0.f, hi = 0.f;
        { float tr = P.ar, ti = P.ai;
#pragma unroll
          for (int s = 0; s < 10; ++s) { const float nr = tr * tr - ti * ti, ni = 2.0f * tr * ti; tr = nr; ti = ni; }
          for (int cc = 0; cc < c; ++cc) { const float sr = Send[((size_t)(cc * 128 + g) * 64 + lane) * 2], si = Send[((size_t)(cc * 128 + g) * 64 + lane) * 2 + 1];
              const float nr = tr * hr - ti * hi + sr, ni = tr * hi + ti * hr + si; hr = nr; hi = ni; } }
        const int tq = lane >> 4, p = lane & 15;
        const float dsk = a->in[15][g * 16 + p];
        const bf16_t* up = U + (size_t)c * 1024 * DM + g * 16;
        bf16_t* yp = YG + (size_t)c * 1024 * DM + g * 16;
        for (int t = 0; t < 1024; t += 16) {
#pragma unroll 1
            for (int t4 = 0; t4 < 16; t4 += 4) {
                u32x4 w[4][2];
#pragma unroll
                for (int k = 0; k < 4; ++k) { w[k][0] = *(const u32x4*)(up + (size_t)(t + t4 + k) * DM); w[k][1] = *(const u32x4*)(up + (size_t)(t + t4 + k) * DM + 8); }
#pragma unroll
                for (int k = 0; k < 4; ++k) { s5_step(P, w[k][0], w[k][1], hr, hi); Hb[((t4 + k) * 64 + lane) * 2] = hr; Hb[((t4 + k) * 64 + lane) * 2 + 1] = hi; }
            }
#pragma unroll 1
            for (int r = 0; r < 4; ++r) {
                const int tl = r * 4 + tq;
                const LAS f32x4* h4 = (const LAS f32x4*)(Hb + tl * 128);
                float y0 = 0.f, y1 = 0.f;
#pragma unroll 8
                for (int n2 = 0; n2 < 32; ++n2) { const f32x4 hv = h4[n2], cv = C4[n2 * 16 + p]; y0 += cv[0] * hv[0] - cv[1] * hv[1]; y1 += cv[2] * hv[2] - cv[3] * hv[3]; }
                const float uv = bf2f(up[(size_t)(t + tl) * DM + p]);
                const float y = y0 + y1 + dsk * uv;
                yp[(size_t)(t + tl) * DM + p] = f2bf(gelu_tanh(y));
            }
        }
    }
}

DI int ord_key(float f) { int b = __float_as_int(f); return b ^ ((b >> 31) & 0x7fffffff); }
DI float ord_val(int k) { return __int_as_float(k ^ ((k >> 31) & 0x7fffffff)); }

DI void phase_route(ArgsP a, int layer, LAS unsigned char* lds) {
    const int tid = threadIdx.x, lane = tid & 63, wave = tid >> 6, l32 = lane & 31, hf = lane >> 5;
    const bf16_t* Q = (const bf16_t*)(a->ws + WS_BUFA);
    const bf16_t* SK = (const bf16_t*)(a->ws + WS_SUBK) + (size_t)layer * 8 * 2 * 128 * 128;
    int* EXPv = (int*)(a->ws + WS_EXP); float* GATE = (float*)(a->ws + WS_GATE);
    LAS int* top = (LAS int*)(lds + wave * 8192);
    for (int item = blockIdx.x * 8 + wave; item < 512 * 8; item += gridDim.x * 8) {
        const int tt = item >> 3, h = item & 7, t0 = tt * 32;
#pragma unroll 1
        for (int c = 0; c < 2; ++c) {
            f32x16 acc[4];
#pragma unroll
            for (int kt = 0; kt < 4; ++kt)
#pragma unroll
                for (int i = 0; i < 16; ++i) acc[kt][i] = 0.f;
            const bf16_t* qp = Q + (size_t)(t0 + l32) * DM + h * 256 + c * 128 + hf * 8;
            const bf16_t* kp = SK + ((size_t)(h * 2 + c) * 128 + l32) * 128 + hf * 8;
#pragma unroll
            for (int ks = 0; ks < 8; ++ks) {
                const bf16x8 bq = *(const bf16x8*)(qp + ks * 16);
#pragma unroll
                for (int kt = 0; kt < 4; ++kt) { const bf16x8 ak = *(const bf16x8*)(kp + (size_t)kt * 32 * 128 + ks * 16); acc[kt] = __builtin_amdgcn_mfma_f32_32x32x16_bf16(ak, bq, acc[kt], 0, 0, 0); }
            }
            int keys[64];
#pragma unroll
            for (int kt = 0; kt < 4; ++kt)
#pragma unroll
                for (int i = 0; i < 16; ++i) { const int kidx = 32 * kt + 8 * (i >> 2) + (i & 3) + 4 * hf; keys[kt * 16 + i] = (ord_key(acc[kt][i]) & ~127) | (127 - kidx); }
#pragma unroll 1
            for (int r = 0; r < 16; ++r) {
                int m = keys[0];
#pragma unroll
                for (int i = 1; i < 64; ++i) m = max(m, keys[i]);
                const int mo = __shfl_xor(m, 32); m = max(m, mo);
#pragma unroll
                for (int i = 0; i < 64; ++i) keys[i] = (keys[i] == m) ? (int)0x80000000 : keys[i];
                if (hf == 0) top[(c * 32 + l32) * 16 + r] = m;
            }
        }
        int k1[16], k2[16];
#pragma unroll
        for (int i = 0; i < 16; ++i) { k1[i] = top[(0 * 32 + l32) * 16 + i]; k2[i] = top[(1 * 32 + l32) * 16 + i]; }
        int ck[50], ce[50];
        {
            int n = 0;
#pragma unroll
            for (int aa = 0; aa < 16; ++aa)
#pragma unroll
                for (int bb = 0; bb < 16; ++bb)
                    if ((aa + 1) * (bb + 1) <= 16) {
                        const float s = ord_val(k1[aa] & ~127) + ord_val(k2[bb] & ~127);
                        ck[n] = (ord_key(s) & ~63) | (63 - n);
                        ce[n] = (127 - (k1[aa] & 127)) * 128 + (127 - (k2[bb] & 127));
                        ++n;
                    }
        }
#pragma unroll 1
        for (int r = 0; r < 16; ++r) {
            int m = ck[0];
#pragma unroll
            for (int i = 1; i < 50; ++i) m = max(m, ck[i]);
            int e = 0;
#pragma unroll
            for (int i = 0; i < 50; ++i) { const bool hit = (ck[i] == m); e = hit ? ce[i] : e; ck[i] = hit ? (int)0x80000000 : ck[i]; }
            if (hf == 0) { top[1024 + (l32 * 16 + r) * 2] = m & ~63; top[1024 + (l32 * 16 + r) * 2 + 1] = e; }
        }
        if (hf == 0) {
            float sv[16]; int ev[16]; float mx = -3.0e38f;
#pragma unroll
            for (int i = 0; i < 16; ++i) { sv[i] = ord_val(top[1024 + (l32 * 16 + i) * 2]); ev[i] = top[1024 + (l32 * 16 + i) * 2 + 1]; mx = fmaxf(mx, sv[i]); }
            float sum = 0.f;
#pragma unroll
            for (int i = 0; i < 16; ++i) { sv[i] = __expf(sv[i] - mx); sum += sv[i]; }
            const float inv = 1.0f / sum;
            int* ep = EXPv + (size_t)(t0 + l32) * 128 + h * 16; float* gp = GATE + (size_t)(t0 + l32) * 128 + h * 16;
#pragma unroll
            for (int i = 0; i < 16; i += 4) { *(f32x4*)(gp + i) = (f32x4){sv[i] * inv, sv[i + 1] * inv, sv[i + 2] * inv, sv[i + 3] * inv};
                *(u32x4*)(ep + i) = (u32x4){(u32)ev[i], (u32)ev[i + 1], (u32)ev[i + 2], (u32)ev[i + 3]}; }
        }
    }
}

DI float dot8(const u32x4 u, const u32x4 h, float acc) {
#pragma unroll
    for (int q = 0; q < 4; ++q) { acc += bflo(u[q]) * bflo(h[q]); acc += bfhi(u[q]) * bfhi(h[q]); }
    return acc;
}
DI void phase_peer(ArgsP a, int layer, bool final_norm) {
    const int lane = threadIdx.x & 63, wave = threadIdx.x >> 6;
    const bf16_t* H = (const bf16_t*)(a->ws + WS_H);
    const bf16_t* PU = (const bf16_t*)(a->ws + WS_PU) + (size_t)layer * SEQ * DM;
    const bf16_t* PV = (const bf16_t*)(a->ws + WS_PV) + (size_t)layer * SEQ * DM;
    const int* EXPv = (const int*)(a->ws + WS_EXP); const float* GATE = (const float*)(a->ws + WS_GATE);
    float* XA = (float*)(a->ws + WS_XA);
    const float* g2 = (const float*)(a->ws + WS_MOD) + layer * 12288 + 5 * DM;
    for (int t = blockIdx.x * 8 + wave; t < SEQ; t += gridDim.x * 8) {
        u32x4 hv[4];
#pragma unroll
        for (int j = 0; j < 4; ++j) hv[j] = *(const u32x4*)(H + (size_t)t * DM + 8 * lane + 512 * j);
        const int e_lo = EXPv[(size_t)t * 128 + lane], e_hi = EXPv[(size_t)t * 128 + 64 + lane];
        const float g_lo = GATE[(size_t)t * 128 + lane], g_hi = GATE[(size_t)t * 128 + 64 + lane];
        float y[32];
#pragma unroll
        for (int i = 0; i < 32; ++i) y[i] = 0.f;
#pragma unroll 1
        for (int kb = 0; kb < 128; kb += 4) {
            u32x4 ur[4][4], vr[4][4]; float gk[4];
#pragma unroll
            for (int k = 0; k < 4; ++k) {
                const int kk = kb + k;
                const int e = (kk < 64) ? __builtin_amdgcn_readlane(e_lo, kk & 63) : __builtin_amdgcn_readlane(e_hi, kk & 63);
                gk[k] = __int_as_float((kk < 64) ? __builtin_amdgcn_readlane(__float_as_int(g_lo), kk & 63) : __builtin_amdgcn_readlane(__float_as_int(g_hi), kk & 63));
                const bf16_t* up = PU + (size_t)e * DM + 8 * lane; const bf16_t* vp = PV + (size_t)e * DM + 8 * lane;
#pragma unroll
                for (int j = 0; j < 4; ++j) { ur[k][j] = *(const u32x4*)(up + 512 * j); vr[k][j] = *(const u32x4*)(vp + 512 * j); }
            }
            float d[4];
#pragma unroll
            for (int k = 0; k < 4; ++k) { float s = 0.f;
#pragma unroll
                for (int j = 0; j < 4; ++j) s = dot8(ur[k][j], hv[j], s);
                d[k] = s; }
#pragma unroll
            for (int o = 32; o >= 1; o >>= 1) {
#pragma unroll
                for (int k = 0; k < 4; ++k) d[k] += __shfl_xor(d[k], o); }
#pragma unroll
            for (int k = 0; k < 4; ++k) {
                const float gate = gk[k];
                const float wk = gate * gelu_tanh(d[k]);
#pragma unroll
                for (int j = 0; j < 4; ++j)
#pragma unroll
                    for (int q = 0; q < 4; ++q) { y[j * 8 + 2 * q] += wk * bflo(vr[k][j][q]); y[j * 8 + 2 * q + 1] += wk * bfhi(vr[k][j][q]); }
            }
        }
        float xn[32]; float ss = 0.f;
#pragma unroll
        for (int j = 0; j < 4; ++j) {
            const int col = 8 * lane + 512 * j;
            const f32x4 x0 = *(const f32x4*)(XA + (size_t)t * DM + col), x1 = *(const f32x4*)(XA + (size_t)t * DM + col + 4);
            const f32x4 q0 = *(const f32x4*)(g2 + col), q1 = *(const f32x4*)(g2 + col + 4);
#pragma unroll
            for (int i = 0; i < 4; ++i) { xn[j * 8 + i] = x0[i] + q0[i] * y[j * 8 + i]; xn[j * 8 + 4 + i] = x1[i] + q1[i] * y[j * 8 + 4 + i]; }
#pragma unroll
            for (int i = 0; i < 8; ++i) ss += xn[j * 8 + i] * xn[j * 8 + i];
        }
        if (!final_norm) {
#pragma unroll
            for (int j = 0; j < 4; ++j) { const int col = 8 * lane + 512 * j;
                *(f32x4*)(XA + (size_t)t * DM + col) = (f32x4){xn[j * 8], xn[j * 8 + 1], xn[j * 8 + 2], xn[j * 8 + 3]};
                *(f32x4*)(XA + (size_t)t * DM + col + 4) = (f32x4){xn[j * 8 + 4], xn[j * 8 + 5], xn[j * 8 + 6], xn[j * 8 + 7]}; }
        } else {
            ss = wave_sum(ss);
            const float rstd = rsqrtf(ss * (1.0f / DM) + 1e-6f);
            const float* nf = a->in[6];
#pragma unroll
            for (int j = 0; j < 4; ++j) { const int col = 8 * lane + 512 * j;
                const f32x4 n0 = *(const f32x4*)(nf + col), n1 = *(const f32x4*)(nf + col + 4);
                *(f32x4*)(a->out + (size_t)t * DM + col) = (f32x4){xn[j * 8] * rstd * n0[0], xn[j * 8 + 1] * rstd * n0[1], xn[j * 8 + 2] * rstd * n0[2], xn[j * 8 + 3] * rstd * n0[3]};
                *(f32x4*)(a->out + (size_t)t * DM + col + 4) = (f32x4){xn[j * 8 + 4] * rstd * n1[0], xn[j * 8 + 5] * rstd * n1[1], xn[j * 8 + 6] * rstd * n1[2], xn[j * 8 + 7] * rstd * n1[3]}; }
        }
    }
}

DI void cmp_item(ArgsP a, int id, LAS unsigned char* lds) {
    const int tid = threadIdx.x, lane = tid & 63, wave = tid >> 6, l32 = lane & 31, hf = lane >> 5;
    const int kv = id >> 7, g = (id >> 5) & 3, ntile = id & 31;
    const bf16_t* KVb = (const bf16_t*)(a->ws + WS_KV) + (size_t)kv * KV_T + (size_t)g * SEQ * 128;
    const bf16_t* W1T = (const bf16_t*)(a->ws + WS_CW1T) + (size_t)kv * 128 * 4096;
    int rowA = 32 * ntile + l32; rowA = rowA > 1022 ? 1022 : rowA;
    const bf16_t* ap = KVb + (size_t)16 * rowA * 128 + wave * 512 + hf * 8;
    const bf16_t* bp = W1T + (size_t)l32 * 4096 + wave * 512 + hf * 8;
    f32x16 acc[4];
#pragma unroll
    for (int ht = 0; ht < 4; ++ht)
#pragma unroll
        for (int i = 0; i < 16; ++i) acc[ht][i] = 0.f;
#pragma unroll 4
    for (int ks = 0; ks < 32; ++ks) {
        const bf16x8 af = *(const bf16x8*)(ap + ks * 16);
#pragma unroll
        for (int ht = 0; ht < 4; ++ht) { const bf16x8 bf = *(const bf16x8*)(bp + (size_t)ht * 32 * 4096 + ks * 16); acc[ht] = __builtin_amdgcn_mfma_f32_32x32x16_bf16(af, bf, acc[ht], 0, 0, 0); }
    }
    LAS float* slot = (LAS float*)lds + (wave & 3) * 4096;
    __syncthreads();
    if (wave < 4) {
#pragma unroll
        for (int ht = 0; ht < 4; ++ht)
#pragma unroll
            for (int i = 0; i < 16; ++i) slot[(8 * (i >> 2) + 4 * hf + (i & 3)) * 128 + 32 * ht + l32] = acc[ht][i];
    }
    __syncthreads();
    if (wave >= 4) {
#pragma unroll
        for (int ht = 0; ht < 4; ++ht)
#pragma unroll
            for (int i = 0; i < 16; ++i) slot[(8 * (i >> 2) + 4 * hf + (i & 3)) * 128 + 32 * ht + l32] += acc[ht][i];
    }
    __syncthreads();
    LAS float* S = (LAS float*)lds; LAS float* hid = (LAS float*)lds + 16384;
    const float* posb = (const float*)(a->ws + WS_POSB) + kv * 128;
#pragma unroll
    for (int j = 0; j < 8; ++j) { const int o = tid + 512 * j; const float v = (S[o] + S[4096 + o]) + (S[8192 + o] + S[12288 + o]) + posb[o & 127]; hid[o] = gelu_tanh(v); }
    __syncthreads();
    const float* w2 = a->in[kv ? 23 : 20];
    const int e = tid & 127, mq = tid >> 7;
    float o8[8];
#pragma unroll
    for (int r = 0; r < 8; ++r) o8[r] = 0.f;
#pragma unroll 4
    for (int h = 0; h < 128; ++h) { const float w = w2[h * 128 + e];
#pragma unroll
        for (int r = 0; r < 8; ++r) o8[r] += hid[(mq * 8 + r) * 128 + h] * w; }
    bf16_t* KC = (bf16_t*)(a->ws + WS_KCMP) + (size_t)g * 1024 * 128; bf16_t* VCT = (bf16_t*)(a->ws + WS_VCMPT) + (size_t)g * 128 * 1024;
#pragma unroll
    for (int r = 0; r < 8; ++r) { const int n = 32 * ntile + mq * 8 + r; const bf16_t v = (n < 1023) ? f2bf(o8[r]) : (bf16_t)0;
        if (kv == 0) KC[(size_t)n * 128 + e] = v; else VCT[(size_t)e * 1024 + n] = v; }
    __syncthreads();
}
DI void vtr_item(ArgsP a, int id, LAS unsigned char* lds) {
    const int tid = threadIdx.x;
    const int which = id >> 10, g = (id >> 8) & 3, tt = id & 255, t0 = tt * 64;
    const bf16_t* src = (const bf16_t*)(a->ws + WS_KV) + (size_t)(which ? 5 : 3) * KV_T + ((size_t)g * SEQ + t0) * 128;
    bf16_t* dst = (bf16_t*)(a->ws + (which ? WS_VWT : WS_VST)) + (size_t)g * 128 * SEQ + t0;
    LAS bf16_t* tile = (LAS bf16_t*)lds;
#pragma unroll
    for (int h = 0; h < 2; ++h) { const int q = tid + 512 * h, tl = q >> 4, d8 = (q & 15) * 8; *(LAS u32x4*)(tile + tl * 136 + d8) = *(const u32x4*)(src + (size_t)tl * 128 + d8); }
    __syncthreads();
#pragma unroll
    for (int h = 0; h < 2; ++h) { const int q = tid + 512 * h, d = q >> 3, t8 = (q & 7) * 8;
        u32x4 w;
        w.x = (u32)tile[(t8 + 0) * 136 + d] | ((u32)tile[(t8 + 1) * 136 + d] << 16); w.y = (u32)tile[(t8 + 2) * 136 + d] | ((u32)tile[(t8 + 3) * 136 + d] << 16);
        w.z = (u32)tile[(t8 + 4) * 136 + d] | ((u32)tile[(t8 + 5) * 136 + d] << 16); w.w = (u32)tile[(t8 + 6) * 136 + d] | ((u32)tile[(t8 + 7) * 136 + d] << 16);
        *(u32x4*)(dst + (size_t)d * SEQ + t8) = w; }
    __syncthreads();
}
DI void phase_cmp(ArgsP a, LAS unsigned char* lds) {
    for (int item = blockIdx.x; item < 256 + 2048; item += gridDim.x) { if (item < 256) cmp_item(a, item, lds); else vtr_item(a, item - 256, lds); }
}

constexpr float ATT_SCALE = 0.08838834764831845f;
struct AttState { float m, l; f32x4 O[8]; };
DI void att_reset(AttState& S) { S.m = -1e30f; S.l = 0.f;
#pragma unroll
    for (int i = 0; i < 8; ++i) S.O[i] = (f32x4){0.f, 0.f, 0.f, 0.f}; }
DI void att_scores(const bf16_t* Kp, int kb, const bf16x8 (&qf)[4], int l16, int q, f32x4& s0, f32x4& s1) {
    s0 = (f32x4){0.f, 0.f, 0.f, 0.f}; s1 = s0;
    const bf16_t* k0 = Kp + (size_t)(kb + l16) * 128 + 8 * q; const bf16_t* k1 = k0 + 16 * 128;
#pragma unroll
    for (int ks = 0; ks < 4; ++ks) { const bf16x8 a0 = *(const bf16x8*)(k0 + 32 * ks), a1 = *(const bf16x8*)(k1 + 32 * ks);
        s0 = __builtin_amdgcn_mfma_f32_16x16x32_bf16(a0, qf[ks], s0, 0, 0, 0); s1 = __builtin_amdgcn_mfma_f32_16x16x32_bf16(a1, qf[ks], s1, 0, 0, 0); }
}
template <int BR> DI bool att_valid(int key, int t, int sel) {
    if (BR == 0) return (16 * key + 31 <= t);
    if (BR == 1) return sel && (key <= t);
    return (key <= t) && (t - key < 512);
}
template <int BR> DI void att_step(AttState& S, const bf16_t* Kp, const bf16_t* VTp, size_t ldv, int kb, const bf16x8 (&qf)[4], int l16, int q, int t, int sel) {
    f32x4 s0, s1; att_scores(Kp, kb, qf, l16, q, s0, s1);
    bool v0[4], v1[4]; float mx = -1e30f;
#pragma unroll
    for (int i = 0; i < 4; ++i) { v0[i] = att_valid<BR>(kb + 4 * q + i, t, sel); v1[i] = att_valid<BR>(kb + 16 + 4 * q + i, t, sel);
        s0[i] = v0[i] ? s0[i] * ATT_SCALE : -1e30f; s1[i] = v1[i] ? s1[i] * ATT_SCALE : -1e30f; mx = fmaxf(mx, fmaxf(s0[i], s1[i])); }
    mx = fmaxf(mx, __shfl_xor(mx, 16)); mx = fmaxf(mx, __shfl_xor(mx, 32));
    const float mn = fmaxf(S.m, mx), corr = __expf(S.m - mn);
    S.m = mn;
    float p0[4], p1[4], ps = 0.f;
#pragma unroll
    for (int i = 0; i < 4; ++i) { p0[i] = v0[i] ? __expf(s0[i] - mn) : 0.f; p1[i] = v1[i] ? __expf(s1[i] - mn) : 0.f; ps += p0[i] + p1[i]; }
    S.l = S.l * corr + ps;
    u32x4 pw; pw.x = pk_bf16(p0[0], p0[1]); pw.y = pk_bf16(p0[2], p0[3]); pw.z = pk_bf16(p1[0], p1[1]); pw.w = pk_bf16(p1[2], p1[3]);
    const bf16x8 pf = __builtin_bit_cast(bf16x8, pw);
    const bf16_t* vp = VTp + (size_t)l16 * ldv + kb + 4 * q;
#pragma unroll
    for (int dt = 0; dt < 8; ++dt) {
        const u32x2 va = *(const u32x2*)(vp + (size_t)dt * 16 * ldv), vb = *(const u32x2*)(vp + (size_t)dt * 16 * ldv + 16);
        const u32x4 vw = {va.x, va.y, vb.x, vb.y};
        S.O[dt] = S.O[dt] * corr;
        S.O[dt] = __builtin_amdgcn_mfma_f32_16x16x32_bf16(__builtin_bit_cast(bf16x8, vw), pf, S.O[dt], 0, 0, 0);
    }
}
DI void att_fold(const AttState& S, float gate, f32x4 (&OF)[8]) {
    float l = S.l; l += __shfl_xor(l, 16); l += __shfl_xor(l, 32);
    const float w = (l > 0.f) ? gate / l : 0.f;
#pragma unroll
    for (int dt = 0; dt < 8; ++dt) OF[dt] += S.O[dt] * w;
}

DI void phase_att(ArgsP a, LAS unsigned char* lds) {
    const int tid = threadIdx.x, lane = tid & 63, wave = tid >> 6, l16 = lane & 15, q = lane >> 4, tok = l16 >> 2, r = l16 & 3;
    const bf16_t* Qb = (const bf16_t*)(a->ws + WS_BUFA);
    const bf16_t* KVb = (const bf16_t*)(a->ws + WS_KV);
    const float* GL = (const float*)(a->ws + WS_GL);
    bf16_t* Ob = (bf16_t*)(a->ws + WS_BUFB);
    LAS float* imp = (LAS float*)(lds + wave * 8192);
    LAS u32* selm = (LAS u32*)(lds + wave * 8192 + 4096);
    const int wv = blockIdx.x * 8 + wave, nwv = gridDim.x * 8;
    for (int item = wv; item < 4096 * 4; item += nwv) {
        const int g = item & 3, tq = item >> 2, t0 = tq * 4, t = t0 + tok, head = 4 * g + r;
        bf16x8 qf[4];
        { const bf16_t* qp = Qb + (size_t)t * DM + head * 128 + 8 * q;
#pragma unroll
          for (int ks = 0; ks < 4; ++ks) qf[ks] = *(const bf16x8*)(qp + 32 * ks); }
        const float g0 = GL[(size_t)t * 48 + head * 3], g1 = GL[(size_t)t * 48 + head * 3 + 1], g2 = GL[(size_t)t * 48 + head * 3 + 2];
        f32x4 OF[8];
#pragma unroll
        for (int i = 0; i < 8; ++i) OF[i] = (f32x4){0.f, 0.f, 0.f, 0.f};
        AttState S;
        const bf16_t* Kc = (const bf16_t*)(a->ws + WS_KCMP) + (size_t)g * 1024 * 128; const bf16_t* VcT = (const bf16_t*)(a->ws + WS_VCMPT) + (size_t)g * 128 * 1024;
        const int ncmp = (t0 + 3 >= 31) ? ((t0 + 3 - 31) / 16 + 1) : 0;
        att_reset(S);
        for (int kb = 0; kb < ncmp; kb += 32) att_step<0>(S, Kc, VcT, 1024, kb, qf, l16, q, t, 0);
        att_fold(S, g0, OF);
        for (int i = lane; i < 1024; i += 64) imp[i] = 0.f;
        if (lane < 32) selm[lane] = 0u;
        { float l = S.l; l += __shfl_xor(l, 16); l += __shfl_xor(l, 32);
          const float inv = (l > 0.f) ? 1.0f / l : 0.f, mfin = S.m;
          for (int kb = 0; kb < ncmp; kb += 32) {
              f32x4 s0, s1; att_scores(Kc, kb, qf, l16, q, s0, s1);
              float pv[8];
#pragma unroll
              for (int i = 0; i < 4; ++i) { pv[i] = att_valid<0>(kb + 4 * q + i, t, 0) ? __expf(s0[i] * ATT_SCALE - mfin) * inv : 0.f;
                  pv[4 + i] = att_valid<0>(kb + 16 + 4 * q + i, t, 0) ? __expf(s1[i] * ATT_SCALE - mfin) * inv : 0.f; }
#pragma unroll
              for (int i = 0; i < 8; ++i) { pv[i] += __shfl_xor(pv[i], 1); pv[i] += __shfl_xor(pv[i], 2); }
              if (r == 0) {
#pragma unroll
                  for (int T = 0; T < 2; ++T) { const int j = ((kb + 16 * T) >> 2) + q;
                      atomicAdd((float*)&imp[tok * 256 + j], 2.0f * (pv[4 * T] + pv[4 * T + 1] + pv[4 * T + 2]) + pv[4 * T + 3]);
                      if (j + 1 < 256) atomicAdd((float*)&imp[tok * 256 + j + 1], pv[4 * T + 3]); }
              }
          } }
        { const int tk = q, tt = t0 + tk, cur = tt >> 6;
          int key[16];
#pragma unroll
          for (int i = 0; i < 16; ++i) { const int j = 16 * l16 + i; const float v = imp[tk * 256 + j];
              const bool forced = (j == 0) || (j == cur) || (j == cur - 1);
              key[i] = (j <= cur && !forced) ? ((__float_as_int(v) & ~255) | (255 - j)) : -1; }
          const int nforced = (cur >= 2) ? 3 : (cur + 1);
          if (l16 == 0) { atomicOr((u32*)&selm[tk * 8], 1u); atomicOr((u32*)&selm[tk * 8 + (cur >> 5)], 1u << (cur & 31)); if (cur >= 1) atomicOr((u32*)&selm[tk * 8 + ((cur - 1) >> 5)], 1u << ((cur - 1) & 31)); }
          for (int rr = 0; rr < 16 - nforced; ++rr) {
              int m = key[0];
#pragma unroll
              for (int i = 1; i < 16; ++i) m = max(m, key[i]);
              m = max(m, __shfl_xor(m, 1)); m = max(m, __shfl_xor(m, 2)); m = max(m, __shfl_xor(m, 4)); m = max(m, __shfl_xor(m, 8));
              if (m >= 0) { const int j = 255 - (m & 255); if (l16 == 0) atomicOr((u32*)&selm[tk * 8 + (j >> 5)], 1u << (j & 31));
#pragma unroll
                  for (int i = 0; i < 16; ++i) key[i] = (key[i] == m) ? -1 : key[i]; }
          } }
        { const bf16_t* Ks = KVb + (size_t)2 * KV_T + (size_t)g * SEQ * 128; const bf16_t* VsT = (const bf16_t*)(a->ws + WS_VST) + (size_t)g * 128 * SEQ;
          att_reset(S);
          for (int w = 0; w < 8; ++w) {
              const u32 mine = selm[tok * 8 + w];
              u32 U = selm[w] | selm[8 + w] | selm[16 + w] | selm[24 + w];
              U = (u32)__builtin_amdgcn_readfirstlane((int)U);
              while (U) { const int b = __builtin_ctz(U); U &= U - 1u; const int j = 32 * w + b, sel = (int)((mine >> b) & 1u);
                  att_step<1>(S, Ks, VsT, SEQ, 64 * j, qf, l16, q, t, sel); att_step<1>(S, Ks, VsT, SEQ, 64 * j + 32, qf, l16, q, t, sel); }
          }
          att_fold(S, g1, OF); }
        { const bf16_t* Kw = KVb + (size_t)4 * KV_T + (size_t)g * SEQ * 128; const bf16_t* VwT = (const bf16_t*)(a->ws + WS_VWT) + (size_t)g * 128 * SEQ;
          att_reset(S);
          int kb0 = t0 - 511; kb0 = kb0 < 0 ? 0 : (kb0 & ~31);
          for (int kb = kb0; kb <= t0 + 3; kb += 32) att_step<2>(S, Kw, VwT, SEQ, kb, qf, l16, q, t, 0);
          att_fold(S, g2, OF); }
        { bf16_t* op = Ob + (size_t)t * DM + head * 128 + 4 * q;
#pragma unroll
          for (int dt = 0; dt < 8; ++dt) { u32x2 w; w.x = pk_bf16(OF[dt][0], OF[dt][1]); w.y = pk_bf16(OF[dt][2], OF[dt][3]); *(u32x2*)(op + 16 * dt) = w; } }
    }
}

constexpr int N_PHASES = 20;
#ifndef PHASE_MASK
#define PHASE_MASK 0xFFFFF
#endif
template <class Epi> DI void run_gemm(LAS unsigned char* lds, const bf16_t* A, const bf16_t* Bt, int N, const Epi& E) {
    pg8::Gemm g{A, Bt, SEQ, N, DM}; pg8::StaticOrder S; S.init(SEQ, N, (int)gridDim.x, (int)blockIdx.x);
    pg8::gemm_phase<Epi, pg8::StaticOrder, false>((PG8_LAS unsigned char*)lds, g, S, E, nullptr);
}

__global__ void __launch_bounds__(NT, 2) fwd_mega(Args a_by_value) {
    const ArgsP a0 = (ArgsP)__builtin_amdgcn_kernarg_segment_ptr();
    extern __shared__ __attribute__((aligned(16))) unsigned char lds_raw[];
    LAS unsigned char* lds = (LAS unsigned char*)lds_raw;
    cg::grid_group grid = cg::this_grid();
    const int lo = a0->ph_lo, hi = a0->ph_hi;
#define PH_VARS const ArgsP a = args_fresh(a0); unsigned char* ws = a->ws; const float* mod0 = (const float*)(ws + WS_MOD); const float* mod1 = mod0 + 12288; \
    bf16_t* H = (bf16_t*)(ws + WS_H); bf16_t* BA = (bf16_t*)(ws + WS_BUFA); bf16_t* BB = (bf16_t*)(ws + WS_BUFB); float* XA = (float*)(ws + WS_XA); \
    (void)mod0; (void)mod1; (void)H; (void)BA; (void)BB; (void)XA;
#define IN(k) (lo <= (k) && (k) < hi)
#define SEAM(k) do { if (IN(k) && IN((k) + 1)) grid.sync(); } while (0)
#if (PHASE_MASK >> 0) & 1
        if (IN(0)) { PH_VARS phase_prep(a, lds); }
        SEAM(0);
#endif
#if (PHASE_MASK >> 1) & 1
        if (IN(1)) { PH_VARS phase_norm(a->in[0], a->in[4], mod0, mod0 + DM, H); }
        SEAM(1);
#endif
#if (PHASE_MASK >> 2) & 1
        if (IN(2)) { PH_VARS { pg8::EpiStoreBf16 E{BA, DM}; run_gemm(lds, H, (const bf16_t*)(ws + WS_WT_SIN), 2048, E); } }
        SEAM(2);
#endif
#if (PHASE_MASK >> 3) & 1
        if (IN(3)) { PH_VARS phase_s5a(a); }
        SEAM(3);
#endif
#if (PHASE_MASK >> 4) & 1
        if (IN(4)) { PH_VARS phase_s5c(a, lds); }
        SEAM(4);
#endif
#if (PHASE_MASK >> 5) & 1
        if (IN(5)) { PH_VARS { pg8::EpiGlu E{a->in[0], XA, mod0 + 2 * DM}; run_gemm(lds, BB, (const bf16_t*)(ws + WS_WT_SOUT), 4096, E); } }
        SEAM(5);
#endif
#if (PHASE_MASK >> 6) & 1
        if (IN(6)) { PH_VARS phase_norm(XA, a->in[5], mod0 + 3 * DM, mod0 + 4 * DM, H); }
        SEAM(6);
#endif
#if (PHASE_MASK >> 7) & 1
        if (IN(7)) { PH_VARS { pg8::EpiStoreBf16 E{BA, DM}; run_gemm(lds, H, (const bf16_t*)(ws + WS_WT_PQ), 2048, E); } }
        SEAM(7);
#endif
#if (PHASE_MASK >> 8) & 1
        if (IN(8)) { PH_VARS phase_route(a, 0, lds); }
        SEAM(8);
#endif
#if (PHASE_MASK >> 9) & 1
        if (IN(9)) { PH_VARS phase_peer(a, 0, false); }
        SEAM(9);
#endif
#if (PHASE_MASK >> 10) & 1
        if (IN(10)) { PH_VARS phase_norm(XA, a->in[4] + DM, mod1, mod1 + DM, H); }
        SEAM(10);
#endif
#if (PHASE_MASK >> 11) & 1
        if (IN(11)) { PH_VARS { pg8::EpiNsaIn E{BA, (bf16_t*)(ws + WS_KV), (float*)(ws + WS_GL)}; run_gemm(lds, H, (const bf16_t*)(ws + WS_WT_NIN), 5376, E); } }
        SEAM(11);
#endif
#if (PHASE_MASK >> 12) & 1
        if (IN(12)) { PH_VARS phase_cmp(a, lds); }
        SEAM(12);
#endif
#if (PHASE_MASK >> 13) & 1
        if (IN(13)) { PH_VARS phase_att(a, lds); }
        SEAM(13);
#endif
#if (PHASE_MASK >> 14) & 1
        if (IN(14)) { PH_VARS { pg8::EpiResid E{XA, mod1 + 2 * DM}; run_gemm(lds, BB, (const bf16_t*)(ws + WS_WT_NOUT), 2048, E); } }
        SEAM(14);
#endif
#if (PHASE_MASK >> 15) & 1
        if (IN(15)) { PH_VARS phase_norm(XA, a->in[5] + DM, mod1 + 3 * DM, mod1 + 4 * DM, H); }
        SEAM(15);
#endif
#if (PHASE_MASK >> 16) & 1
        if (IN(16)) { PH_VARS { pg8::EpiStoreBf16 E{BA, DM}; run_gemm(lds, H, (const bf16_t*)(ws + WS_WT_PQ) + (size_t)DM * DM, 2048, E); } }
        SEAM(16);
#endif
#if (PHASE_MASK >> 17) & 1
        if (IN(17)) { PH_VARS phase_route(a, 1, lds); }
        SEAM(17);
#endif
#if (PHASE_MASK >> 18) & 1
        if (IN(18)) { PH_VARS phase_peer(a, 1, true); }
        SEAM(18);
#endif
#undef IN
#undef SEAM
}

#ifndef N_LAUNCH_MODE
#define N_LAUNCH_MODE 0
#endif
extern "C" void kernel_launch(void* const* d_in, const int* in_sizes, int n_in, void* d_out, int out_size, void* d_ws, size_t ws_size, hipStream_t stream) {
    static int grid = 0;
    if (grid == 0) {
        if (n_in != 29 || out_size != SEQ * DM || ws_size < WS_END) { fprintf(stderr, "kernel_launch: unexpected problem (n_in %d, out %d, ws %zu < %zu)\n", n_in, out_size, ws_size, (size_t)WS_END); grid = -1; return; }
        int dev = 0, cus = 0, per_cu = 0;
        hipGetDevice(&dev); hipDeviceGetAttribute(&cus, hipDeviceAttributeMultiprocessorCount, dev);
        hipFuncSetAttribute((const void*)fwd_mega, hipFuncAttributeMaxDynamicSharedMemorySize, LDS_BYTES);
        hipOccupancyMaxActiveBlocksPerMultiprocessor(&per_cu, (const void*)fwd_mega, NT, LDS_BYTES);
        if (per_cu < 1) { fprintf(stderr, "kernel_launch: occupancy query says %d workgroups per CU\n", per_cu); per_cu = 1; }
        grid = cus;
        (void)hipGetLastError();
    }
    if (grid < 0) return;
    Args a{};
    for (int i = 0; i < 29; ++i) a.in[i] = (const float*)d_in[i];
    a.out = (float*)d_out; a.ws = (unsigned char*)d_ws;
#if N_LAUNCH_MODE == 1
    a.ph_lo = 0; a.ph_hi = N_PHASES - 1;
    { void* args[] = {&a}; hipError_t e = hipLaunchCooperativeKernel((const void*)fwd_mega, dim3(grid), dim3(NT), args, LDS_BYTES, stream);
      if (e != hipSuccess) fprintf(stderr, "cooperative launch failed: %s (grid %d)\n", hipGetErrorString(e), grid); }
#else
    for (int ph = 0; ph < N_PHASES - 1; ++ph) {
        a.ph_lo = ph; a.ph_hi = ph + 1;
        void* args[] = {&a}; hipError_t e = hipLaunchCooperativeKernel((const void*)fwd_mega, dim3(grid), dim3(NT), args, LDS_BYTES, stream);
        if (e != hipSuccess) { fprintf(stderr, "launch of phase %d failed: %s (grid %d)\n", ph, hipGetErrorString(e), grid); break; }
    }
#endif
}
```

```cpp
#define ATT_NG 1
#include <hip/hip_runtime.h>
#include <hip/hip_cooperative_groups.h>
#include <cstdio>
#include <cstdint>
namespace cg = cooperative_groups;

#define DI __device__ __forceinline__
#define LAS __attribute__((address_space(3)))
typedef unsigned short bf16_t;
typedef unsigned int u32;
typedef short bf16x8 __attribute__((ext_vector_type(8)));
typedef float f32x4 __attribute__((ext_vector_type(4)));
typedef float f32x16 __attribute__((ext_vector_type(16)));
typedef unsigned u32x4 __attribute__((ext_vector_type(4)));
typedef unsigned u32x2 __attribute__((ext_vector_type(2)));
typedef float f32x2v __attribute__((ext_vector_type(2)));
typedef short s16x2 __attribute__((ext_vector_type(2)));
typedef __bf16 bf16x2_hw __attribute__((ext_vector_type(2)));
DI u32 cvt_pk_bf16_cc(float lo, float hi) { const bf16x2_hw r = __builtin_convertvector((f32x2v){lo, hi}, bf16x2_hw); return __builtin_bit_cast(u32, r); }

constexpr int DM = 2048;
constexpr int SEQ = 16384;
constexpr int NT = 512;
constexpr int LDS_BYTES = 147456;
constexpr int LDS_BARST = LDS_BYTES - 64;

constexpr size_t MB = 1024 * 1024;
constexpr size_t WS_MOD    = 0;
constexpr size_t WS_POSB   = 98304;
constexpr size_t WS_PSC    = 262144;
constexpr size_t WS_BAR    = 524288;
constexpr size_t WS_SEND   = 1 * MB;
constexpr size_t WS_WT_SIN = 2 * MB;
constexpr size_t WS_WT_SOUT= WS_WT_SIN + 8 * MB;
constexpr size_t WS_WT_NIN = WS_WT_SOUT + 16 * MB;
constexpr size_t WS_WT_NOUT= WS_WT_NIN + 21 * MB;
constexpr size_t WS_WT_PQ  = WS_WT_NOUT + 8 * MB;
constexpr size_t WS_SUBK   = WS_WT_PQ + 16 * MB;
constexpr size_t WS_CW1T   = WS_SUBK + 1 * MB;
constexpr size_t WS_PU     = WS_CW1T + 2 * MB;
constexpr size_t WS_PV     = WS_PU + 128 * MB;
constexpr size_t WS_H      = WS_PV + 128 * MB;
constexpr size_t WS_BUFA   = WS_H + 64 * MB;
constexpr size_t WS_BUFB   = WS_BUFA + 64 * MB;
constexpr size_t WS_XA     = WS_BUFB + 64 * MB;
constexpr size_t WS_EXP    = WS_XA + 128 * MB;
constexpr size_t WS_GATE   = WS_EXP + 8 * MB;
constexpr size_t WS_KV     = WS_GATE + 8 * MB;
constexpr size_t WS_GL     = WS_KV + 96 * MB;
constexpr size_t WS_KCMP   = WS_GL + 3 * MB;
constexpr size_t WS_VCMPT  = WS_KCMP + 1 * MB;
constexpr size_t WS_VST    = WS_VCMPT + 1 * MB;
constexpr size_t WS_VWT    = WS_VST + 16 * MB;
constexpr size_t WS_S5BB   = WS_PU + 64 * MB;
constexpr size_t WS_S5CT   = WS_S5BB + 1 * MB;
constexpr size_t WS_PW     = WS_S5CT + 1 * MB;
constexpr size_t WS_PBP    = WS_PW + 8 * MB;
constexpr size_t WS_KS8    = WS_PBP + 1 * MB;
constexpr size_t WS_VST8   = WS_KS8 + 8 * MB;
constexpr size_t WS_END    = WS_VWT + 16 * MB;
constexpr int PEER_ROWB = 1536;
constexpr size_t KV_T      = (size_t)4 * SEQ * 128;

struct Args { const float* in[29]; float* out; unsigned char* ws; int ph_lo, ph_hi; };
typedef const __attribute__((address_space(4))) Args* ArgsP;
DI ArgsP args_fresh(ArgsP p) { asm volatile("" : "+s"(p)); return p; }

DI float bf2f(bf16_t b) { return __uint_as_float(((u32)b) << 16); }
DI float bflo(u32 w) { return __uint_as_float(w << 16); }
DI float bfhi(u32 w) { return __uint_as_float(w & 0xffff0000u); }
DI bf16_t f2bf(float f) { u32 u = __float_as_uint(f); u += 0x7fffu + ((u >> 16) & 1u); return (bf16_t)(u >> 16); }
DI u32 pk_bf16(float lo, float hi) { return (u32)f2bf(lo) | ((u32)f2bf(hi) << 16); }
DI float fast_rcp(float x) { return __builtin_amdgcn_rcpf(x); }
DI float sigmoidf_(float x) { return fast_rcp(1.0f + __expf(-x)); }
DI float gelu_tanh(float x) { const float z = 1.5957691216057308f * (x + 0.044715f * x * x * x); return x * fast_rcp(1.0f + __expf(-z)); }
template <int CTRL> DI float dppf(float v) { return __int_as_float(__builtin_amdgcn_update_dpp(0, __float_as_int(v), CTRL, 0xF, 0xF, false)); }
template <int CTRL> DI int dppi(int v) { return __builtin_amdgcn_update_dpp(0, v, CTRL, 0xF, 0xF, false); }
constexpr int DPP_XOR1 = 0xB1, DPP_XOR2 = 0x4E, DPP_HMIRROR = 0x141, DPP_MIRROR = 0x140;
DI float sum_x16(float v) { const auto r = __builtin_amdgcn_permlane16_swap(__float_as_uint(v), __float_as_uint(v), false, false); return __uint_as_float(r[0]) + __uint_as_float(r[1]); }
DI float sum_x32(float v) { const auto r = __builtin_amdgcn_permlane32_swap(__float_as_uint(v), __float_as_uint(v), false, false); return __uint_as_float(r[0]) + __uint_as_float(r[1]); }
DI float row16_sum(float v) { v += dppf<DPP_XOR1>(v); v += dppf<DPP_XOR2>(v); v += dppf<DPP_HMIRROR>(v); v += dppf<DPP_MIRROR>(v); return v; }
DI float wave_sum(float v) { return sum_x32(sum_x16(row16_sum(v))); }
namespace pg8 {
#define PG8_LAS __attribute__((address_space(3)))
typedef unsigned short bf16_t;
typedef short bf16x8 __attribute__((ext_vector_type(8)));
typedef float f32x4 __attribute__((ext_vector_type(4)));
typedef unsigned u32x4 __attribute__((ext_vector_type(4)));
constexpr int BM = 256, BK = 64, HALF = 128, HTB = HALF * BK * 2  , STAGE_BYTES = 8 * HTB, NXCD = 8, WGM = 8;

__host__ __device__ __forceinline__ int lds_byte(int r, int c) { const int st = (r >> 4) * 2 + (c >> 5), rr = r & 15, cc = c & 31, ob = rr * 64 + cc * 2; return st * 1024 + (ob ^ (((ob >> 9) & 1) << 5)); }
__host__ __device__ __forceinline__ void stage_rc(int b, int& R, int& C) { const int st = b / 1024, sb = b % 1024, swz = sb ^ (((sb >> 9) & 1) << 5); R = (st >> 1) * 16 + swz / 64; C = (st & 1) * 32 + (swz % 64) / 2; }
__host__ __device__ __forceinline__ int perm32(int rho) { const int n = rho >> 4, i = rho & 15; return 8 * (i >> 2) + 4 * n + (i & 3); }

struct Unit { int pm, pn; };
struct Gemm { const bf16_t* A; const bf16_t* Bt; int M, N, K; };

struct StaticOrder {
    int nM, nN, nwg, G, c;
    __host__ __device__ void init(int M, int N, int G_, int c_) { nM = M / BM; nN = N / BM; nwg = nM * nN; G = G_; c = c_; }
    __host__ __device__ bool next(int i, Unit& u) const {
        const long L = (long)i * G + c; if (L >= nwg) return false;
        int wgid = (int)L; { const int q = nwg / NXCD, r = nwg % NXCD, xcd = wgid % NXCD, off = wgid / NXCD; wgid = (xcd < r ? xcd * (q + 1) : r * (q + 1) + (xcd - r) * q) + off; }
        const int nig = WGM * nN, gid = wgid / nig, fm = gid * WGM, gsz = (nM - fm) < WGM ? (nM - fm) : WGM;
        u.pm = fm + ((wgid % nig) % gsz); u.pn = (wgid % nig) / gsz; return true;
    }
    __device__ __forceinline__ void a_ready(const Unit&) const {}
    __device__ __forceinline__ void done(const Unit&) const {}
};
__device__ __forceinline__ unsigned cvt_pk_bf16(float lo, float hi) { return cvt_pk_bf16_cc(lo, hi); }
struct EpiStoreBf16 {
    static constexpr bool PERM = true, AFTER_DRAIN = false;
    bf16_t* O; int ldc;
    __device__ __forceinline__ void operator()(const f32x4 (&acc)[2][2][4][2], const Unit& u, int wr, int wc, int fr, int fq) const {
        const int row0 = u.pm * BM + wr * 64 + fr, col0 = u.pn * BM + wc * 32 + 8 * fq;
#pragma unroll
        for (int ai = 0; ai < 2; ++ai)
#pragma unroll
            for (int m = 0; m < 4; ++m) { bf16_t* rowp = O + (size_t)(row0 + ai * HALF + m * 16) * ldc + col0;
#pragma unroll
                for (int bj = 0; bj < 2; ++bj) { const f32x4 v0 = acc[ai][bj][m][0], v1 = acc[ai][bj][m][1];
                    u32x4 w; w.x = cvt_pk_bf16(v0[0], v0[1]); w.y = cvt_pk_bf16(v0[2], v0[3]); w.z = cvt_pk_bf16(v1[0], v1[1]); w.w = cvt_pk_bf16(v1[2], v1[3]);
                    *(u32x4*)(rowp + bj * HALF) = w; } }
    }
};
struct EpiGlu {
    static constexpr bool PERM = false, AFTER_DRAIN = false;
    const float* xin; float* xout; const float* g1;
    __device__ __forceinline__ void operator()(const f32x4 (&acc)[2][2][4][2], const Unit& u, int wr, int wc, int fr, int fq) const {
        const int row0 = u.pm * BM + wr * 64 + fr, col0 = u.pn * HALF + wc * 32 + 4 * fq;
#pragma unroll
        for (int ai = 0; ai < 2; ++ai)
#pragma unroll
            for (int m = 0; m < 4; ++m) { const size_t ro = (size_t)(row0 + ai * HALF + m * 16) * DM;
#pragma unroll
                for (int n = 0; n < 2; ++n) { const int col = col0 + 16 * n;
                    const f32x4 a = acc[ai][0][m][n], b = acc[ai][1][m][n];
                    const f32x4 xi = *(const f32x4*)(xin + ro + col), gg = *(const f32x4*)(g1 + col);
                    f32x4 o;
#pragma unroll
                    for (int j = 0; j < 4; ++j) o[j] = xi[j] + gg[j] * a[j] * __builtin_amdgcn_rcpf(1.0f + __expf(-b[j]));
                    *(f32x4*)(xout + ro + col) = o; } }
    }
};
struct EpiResid {
    static constexpr bool PERM = false, AFTER_DRAIN = false;
    float* x; const float* g1;
    __device__ __forceinline__ void operator()(const f32x4 (&acc)[2][2][4][2], const Unit& u, int wr, int wc, int fr, int fq) const {
        const int row0 = u.pm * BM + wr * 64 + fr, col0 = u.pn * BM + wc * 32 + 4 * fq;
#pragma unroll
        for (int ai = 0; ai < 2; ++ai)
#pragma unroll
            for (int m = 0; m < 4; ++m) { float* rowp = x + (size_t)(row0 + ai * HALF + m * 16) * DM + col0;
#pragma unroll
                for (int bj = 0; bj < 2; ++bj)
#pragma unroll
                    for (int n = 0; n < 2; ++n) { const f32x4 gg = *(const f32x4*)(g1 + col0 + bj * HALF + n * 16);
                        f32x4 xi = *(const f32x4*)(rowp + bj * HALF + n * 16); xi += gg * acc[ai][bj][m][n]; *(f32x4*)(rowp + bj * HALF + n * 16) = xi; } }
    }
};
struct EpiNsaIn {
    static constexpr bool PERM = true, AFTER_DRAIN = false;
    bf16_t* Q; bf16_t* KV; float* GL;
    __device__ __forceinline__ void operator()(const f32x4 (&acc)[2][2][4][2], const Unit& u, int wr, int wc, int fr, int fq) const {
        const int row0 = u.pm * BM + wr * 64 + fr, lc0 = wc * 32 + 8 * fq;
#pragma unroll
        for (int ai = 0; ai < 2; ++ai)
#pragma unroll
            for (int m = 0; m < 4; ++m) { const int row = row0 + ai * HALF + m * 16;
#pragma unroll
                for (int bj = 0; bj < 2; ++bj) { const f32x4 v0 = acc[ai][bj][m][0], v1 = acc[ai][bj][m][1];
                    if (u.pn < 20) {
                        u32x4 w; w.x = cvt_pk_bf16(v0[0], v0[1]); w.y = cvt_pk_bf16(v0[2], v0[3]); w.z = cvt_pk_bf16(v1[0], v1[1]); w.w = cvt_pk_bf16(v1[2], v1[3]);
                        bf16_t* dst;
                        if (u.pn < 8) dst = Q + (size_t)row * DM + u.pn * BM + bj * HALF + lc0;
                        else { const int tsr = (u.pn - 8) >> 1, c512 = ((u.pn - 8) & 1) * 256 + bj * HALF + lc0, g = c512 >> 7, d = c512 & 127;
                               dst = KV + (size_t)tsr * ((size_t)4 * SEQ * 128) + ((size_t)g * SEQ + row) * 128 + d; }
                        *(u32x4*)dst = w;
                    } else if (bj == 0 && lc0 < 48) {
                        float* dst = GL + (size_t)row * 48 + lc0; f32x4 s0, s1;
#pragma unroll
                        for (int j = 0; j < 4; ++j) { s0[j] = __builtin_amdgcn_rcpf(1.0f + __expf(-v0[j])); s1[j] = __builtin_amdgcn_rcpf(1.0f + __expf(-v1[j])); }
                        *(f32x4*)dst = s0; *(f32x4*)(dst + 4) = s1;
                    } } }
    }
};
template <class Epi, class Sched, bool STAMP = false>
__device__ __forceinline__ void gemm_phase(PG8_LAS unsigned char* lds, const Gemm g, const Sched& S, const Epi& E, unsigned long long* stamps) {
    const int tid = threadIdx.x, wid = __builtin_amdgcn_readfirstlane(tid >> 6), lane = tid & 63, wr = wid >> 2, wc = wid & 3, fr = lane & 15, fq = lane >> 4;
    const int K = g.K, nt = K / BK;
    int ts_lo = 0, ts_hi = 0, nts = 0; const unsigned long long rt_entry = STAMP ? (unsigned long long)wall_clock64() : 0ull;
#define PG8_STAMP() do { if (STAMP && wid == 0 && nts < 64) { const unsigned long long _c = (unsigned long long)clock64(); \
        ts_lo = (lane == nts) ? (int)(unsigned)_c : ts_lo; ts_hi = (lane == nts) ? (int)(unsigned)(_c >> 32) : ts_hi; ++nts; } } while (0)
    PG8_STAMP();
    unsigned voffA[2], voffB[2];
#pragma unroll
    for (int i = 0; i < 2; ++i) { int R, C; stage_rc(tid * 16 + i * 8192, R, C); const int Rb = Epi::PERM ? ((R & ~31) + perm32(R & 31)) : R;
        voffA[i] = (unsigned)(R * K + C) * 2u; voffB[i] = (unsigned)(Rb * K + C) * 2u; }
    const size_t kstep = (size_t)(BK * 2);
    const size_t hstep = (size_t)HALF * K * 2;
    const size_t tstep = 2 * hstep;
    const unsigned ldsw = (unsigned)wid * 1024u;
    const int aoff = lds_byte(wr * 64 + fr, fq * 8), boff = lds_byte(wc * 32 + fr, fq * 8);
#define PG8_SA(b, h) (((b) * 2 + (h)) * HTB)
#define PG8_SB(b, h) ((4 + (b) * 2 + (h)) * HTB)
#define PG8_STAGE(bufoff, gbase, voff) do { _Pragma("unroll") for (int _i = 0; _i < 2; ++_i) \
        __builtin_amdgcn_global_load_lds((const unsigned*)((const char*)(gbase) + (voff)[_i]), (PG8_LAS unsigned*)(lds + (bufoff) + ldsw + _i * 8192), 16, 0, 0); } while (0)
#define PG8_LDA(dst, b, h) do { _Pragma("unroll") for (int m = 0; m < 4; ++m) _Pragma("unroll") for (int k = 0; k < 2; ++k) dst[m][k] = *(const PG8_LAS bf16x8*)(lds + PG8_SA(b, h) + aoff + m * 2048 + k * 1024); } while (0)
#define PG8_LDB(dst, b, h) do { _Pragma("unroll") for (int n = 0; n < 2; ++n) _Pragma("unroll") for (int k = 0; k < 2; ++k) dst[n][k] = *(const PG8_LAS bf16x8*)(lds + PG8_SB(b, h) + boff + n * 2048 + k * 1024); } while (0)
#define PG8_MMA(ai, bj, At, Bt) do { __builtin_amdgcn_s_setprio(1); _Pragma("unroll") for (int m = 0; m < 4; ++m) _Pragma("unroll") for (int n = 0; n < 2; ++n) _Pragma("unroll") for (int k = 0; k < 2; ++k) \
        acc[ai][bj][m][n] = __builtin_amdgcn_mfma_f32_16x16x32_bf16(Bt[n][k], At[m][k], acc[ai][bj][m][n], 0, 0, 0); __builtin_amdgcn_s_setprio(0); } while (0)
#define PG8_WAIT_V(n) asm volatile("s_waitcnt vmcnt(" #n ")" ::: "memory")
#define PG8_WAIT_L(n) asm volatile("s_waitcnt lgkmcnt(" #n ")" ::: "memory")
#define PG8_BAR __builtin_amdgcn_s_barrier()
#define PG8_SCHED __builtin_amdgcn_sched_barrier(0)
    Unit cur, nxt; int ui = 0;
    if (!S.next(0, cur)) return;
    f32x4 acc[2][2][4][2];
#pragma unroll
    for (int a = 0; a < 2; ++a)
#pragma unroll
        for (int b = 0; b < 2; ++b)
#pragma unroll
            for (int m = 0; m < 4; ++m)
#pragma unroll
                for (int n = 0; n < 2; ++n) acc[a][b][m][n] = (f32x4){0.f, 0.f, 0.f, 0.f};
    bf16x8 At[4][2], B0[2][2], B1[2][2];
    const char* cA = (const char*)g.A + (size_t)cur.pm * tstep; const char* cB = (const char*)g.Bt + (size_t)cur.pn * tstep;
    S.a_ready(cur);
    PG8_STAGE(PG8_SB(0, 0), cB, voffB); PG8_STAGE(PG8_SA(0, 0), cA, voffA); PG8_STAGE(PG8_SB(0, 1), cB + hstep, voffB); PG8_STAGE(PG8_SA(0, 1), cA + hstep, voffA);
    if (wr == 1) PG8_BAR;
    PG8_WAIT_V(4); PG8_BAR;
    PG8_STAGE(PG8_SB(1, 0), cB + kstep, voffB); PG8_STAGE(PG8_SA(1, 0), cA + kstep, voffA); PG8_STAGE(PG8_SB(1, 1), cB + hstep + kstep, voffB);
    PG8_WAIT_V(6); PG8_BAR;
    PG8_STAMP();
    for (;;) {
        const bool has_next = S.next(ui + 1, nxt);
        const char* nA = has_next ? (const char*)g.A + (size_t)nxt.pm * tstep : cA; const char* nB = has_next ? (const char*)g.Bt + (size_t)nxt.pn * tstep : cB;
        for (int t = 0; t < nt; t += 2) {
            const bool last = (t == nt - 2);
            const char* a1 = cA + (size_t)(t + 1) * kstep;
            const char* a2 = last ? nA : cA + (size_t)(t + 2) * kstep; const char* b2 = last ? nB : cB + (size_t)(t + 2) * kstep;
            const char* a3 = a2 + kstep; const char* b3 = b2 + kstep;
            if (last && has_next) S.a_ready(nxt);
            PG8_LDB(B0, 0, 0); PG8_SCHED; PG8_LDA(At, 0, 0); PG8_STAGE(PG8_SA(1, 1), a1 + hstep, voffA);
            PG8_WAIT_L(8); PG8_BAR; PG8_WAIT_L(0); PG8_MMA(0, 0, At, B0); PG8_BAR; PG8_SCHED;
            PG8_LDB(B1, 0, 1); PG8_STAGE(PG8_SB(0, 0), b2, voffB);
            PG8_BAR; PG8_WAIT_L(0); PG8_MMA(0, 1, At, B1); PG8_BAR;
            PG8_LDA(At, 0, 1); PG8_STAGE(PG8_SA(0, 0), a2, voffA);
            PG8_BAR; PG8_WAIT_L(0); PG8_MMA(1, 0, At, B0); PG8_BAR; PG8_SCHED;
            PG8_STAGE(PG8_SB(0, 1), b2 + hstep, voffB);
            PG8_WAIT_V(6); PG8_BAR; PG8_MMA(1, 1, At, B1); PG8_BAR;
            PG8_LDB(B0, 1, 0); PG8_SCHED; PG8_LDA(At, 1, 0); PG8_STAGE(PG8_SA(0, 1), a2 + hstep, voffA);
            PG8_WAIT_L(8); PG8_BAR; PG8_WAIT_L(0); PG8_MMA(0, 0, At, B0); PG8_BAR; PG8_SCHED;
            PG8_LDB(B1, 1, 1); PG8_STAGE(PG8_SB(1, 0), b3, voffB);
            PG8_BAR; PG8_WAIT_L(0); PG8_MMA(0, 1, At, B1); PG8_BAR;
            PG8_LDA(At, 1, 1); PG8_STAGE(PG8_SA(1, 0), a3, voffA);
            PG8_BAR; PG8_WAIT_L(0); PG8_MMA(1, 0, At, B0); PG8_BAR; PG8_SCHED;
            PG8_STAGE(PG8_SB(1, 1), b3 + hstep, voffB);
            PG8_WAIT_V(6); PG8_BAR; PG8_MMA(1, 1, At, B1); PG8_BAR;
        }
        PG8_STAMP();
        if constexpr (!Epi::AFTER_DRAIN) { E(acc, cur, wr, wc, fr, fq); S.done(cur); }
        PG8_STAMP();
        if (!has_next) break;
#pragma unroll
        for (int a = 0; a < 2; ++a)
#pragma unroll
            for (int b = 0; b < 2; ++b)
#pragma unroll
                for (int m = 0; m < 4; ++m)
#pragma unroll
                    for (int n = 0; n < 2; ++n) acc[a][b][m][n] = (f32x4){0.f, 0.f, 0.f, 0.f};
        cur = nxt; cA = nA; cB = nB; ++ui;
    }
    PG8_WAIT_V(0);
    if (wr == 0) PG8_BAR;
    PG8_BAR;
    if constexpr (Epi::AFTER_DRAIN) { E.fused(acc, cur, wr, wc, fr, fq, lds, wid, lane); S.done(cur); }
    PG8_STAMP();
    if (STAMP && wid == 0) { stamps[lane] = lane < nts ? (((unsigned long long)(unsigned)ts_hi << 32) | (unsigned)ts_lo) : 0ull;
        if (lane == 62) stamps[62] = rt_entry; if (lane == 63) stamps[63] = (unsigned long long)wall_clock64(); }
#undef PG8_STAMP
#undef PG8_SA
#undef PG8_SB
#undef PG8_STAGE
#undef PG8_LDA
#undef PG8_LDB
#undef PG8_MMA
#undef PG8_WAIT_V
#undef PG8_WAIT_L
#undef PG8_BAR
#undef PG8_SCHED
}
}

#define XB_TMO      128
#define XB_XCNT(j)  (256  + 64 * (j))
#define XB_XSUB(j)  (1280 + 64 * (j))
#define XB_XGEN(j)  (2304 + 64 * (j))
#define XB_TOP      3328
#define XB_TOPGEN   3392
#define XCD_BAR_WORDS 3456
#define XB_SPIN_CAP (1u << 22)

__device__ __forceinline__ unsigned xb_ld(unsigned* p)              { return __hip_atomic_load(p, __ATOMIC_RELAXED, __HIP_MEMORY_SCOPE_AGENT); }
__device__ __forceinline__ unsigned xb_add(unsigned* p, unsigned v) { return __hip_atomic_fetch_add(p, v, __ATOMIC_RELAXED, __HIP_MEMORY_SCOPE_AGENT); }
__device__ __forceinline__ unsigned xb_xcc_id() { return (unsigned)__builtin_amdgcn_s_getreg((3 << 11) | 20) & 0xFu; }
#define XB_SPIN(cond, bar) do { unsigned _sp = 0; while (cond) { __builtin_amdgcn_s_sleep(1); \
    if ((++_sp & 255u) == 0u) { if (xb_ld(&(bar)[XB_TMO])) break; if (_sp > XB_SPIN_CAP) { atomicAdd(&(bar)[XB_TMO], 1u); break; } } } } while (0)

struct XcdBarrier {
    unsigned* bar; unsigned x;
    volatile LAS unsigned* st;
};

__device__ __forceinline__ XcdBarrier xcd_barrier_post(unsigned* bar, volatile LAS unsigned* st) {
    XcdBarrier b; b.bar = bar; b.x = xb_xcc_id(); b.st = st;
    if (threadIdx.x == 0) (void)xb_add(&bar[XB_XCNT(b.x)], 1u);
    return b;
}
__device__ __forceinline__ void xcd_barrier_complete(unsigned* bar, unsigned x, unsigned& nloc, unsigned& nx) {
    const unsigned G = gridDim.x * gridDim.y * gridDim.z;
    unsigned sum, cnt, mine, sp = 0u;
    for (;;) {
        sum = 0u; cnt = 0u; mine = 0u;
#pragma unroll
        for (unsigned j = 0; j < 16; ++j) { const unsigned c = xb_ld(&bar[XB_XCNT(j)]); sum += c; cnt += (c > 0u) ? 1u : 0u; mine = (j == x) ? c : mine; }
        if (sum == G) break;
        __builtin_amdgcn_s_sleep(1);
        if ((++sp & 255u) == 0u) { if (xb_ld(&bar[XB_TMO])) break; if (sp > XB_SPIN_CAP) { atomicAdd(&bar[XB_TMO], 1u); break; } }
    }
    nloc = mine > 0u ? mine : 1u; nx = cnt > 0u ? cnt : 1u;
}

__device__ __forceinline__ void xcd_barrier(const XcdBarrier& b) {
    asm volatile("s_waitcnt vmcnt(0)" ::: "memory");
    __syncthreads();
    if (threadIdx.x == 0) {
        unsigned* bar = b.bar;
        __builtin_amdgcn_s_waitcnt(0);
        unsigned nloc = b.st[0], nx = b.st[1];
        if (nloc == 0u) { xcd_barrier_complete(bar, b.x, nloc, nx); b.st[0] = nloc; b.st[1] = nx; }
        const unsigned old = xb_add(&bar[XB_XSUB(b.x)], 1u);
        const unsigned gen = old / nloc;
        if (old + 1u == (gen + 1u) * nloc) {
            __builtin_amdgcn_fence(__ATOMIC_RELEASE, "agent");
            asm volatile("s_waitcnt vmcnt(0)" ::: "memory");
            const unsigned og = xb_add(&bar[XB_TOP], 1u);
            const unsigned tg = og / nx;
            if (og + 1u == (tg + 1u) * nx) xb_add(&bar[XB_TOPGEN], 1u);
            else XB_SPIN(xb_ld(&bar[XB_TOPGEN]) == tg, bar);
            __builtin_amdgcn_fence(__ATOMIC_ACQUIRE, "agent");
            xb_add(&bar[XB_XGEN(b.x)], 1u);
            asm volatile("s_waitcnt vmcnt(0)" ::: "memory");
        } else {
            XB_SPIN(xb_ld(&bar[XB_XGEN(b.x)]) == gen, bar);
            __builtin_amdgcn_fence(__ATOMIC_ACQUIRE, "agent");
            asm volatile("s_waitcnt vmcnt(0)" ::: "memory");
        }
    }
    __syncthreads();
}

constexpr int P0_GEMV = 768;
constexpr int P0_TR0 = P0_GEMV;
constexpr int P0_TR_TOTAL = 256 + 512 + 672 + 256 + 256 + 256 + 64 + 64;
constexpr int P0_CV0 = P0_TR0 + P0_TR_TOTAL;
constexpr int CV_PU = 0, CV_PV = 0, CV_SK = 64;
constexpr int P0_PB0 = P0_CV0 + CV_PU + CV_PV + CV_SK;
constexpr int P0_S50 = P0_PB0 + 32;
constexpr int P0_TOTAL = P0_S50 + 128;

DI void p0_gemv(ArgsP a, int item, LAS float* sm) {
    const int tid = threadIdx.x, lane = tid & 63, wave = tid >> 6, layer = item / 384, n0 = (item % 384) * 32, col = lane & 31, par = lane >> 5;
    const float* c = a->in[1];
    __syncthreads();
    for (int k = tid; k < DM; k += NT) { const float cv = c[k]; sm[k] = cv / (1.0f + __expf(-cv)); }
    __syncthreads();
    const float* W = a->in[2] + (size_t)layer * DM * 12288 + n0 + col;
    float acc = 0.f;
    const int k0 = wave * 256 + par;
#pragma unroll 1
    for (int kk = 0; kk < 256; kk += 64) {
        float w[32];
#pragma unroll
        for (int j = 0; j < 32; ++j) w[j] = W[(size_t)(k0 + kk + 2 * j) * 12288];
#pragma unroll
        for (int j = 0; j < 32; ++j) acc += sm[k0 + kk + 2 * j] * w[j];
    }
    acc += __shfl_xor(acc, 32);
    if (lane < 32) sm[DM + wave * 32 + lane] = acc;
    __syncthreads();
    if (tid < 32) { float s = 0.f;
#pragma unroll
        for (int w = 0; w < 8; ++w) s += sm[DM + w * 32 + tid];
        ((float*)(a->ws + WS_MOD))[layer * 12288 + n0 + tid] = s + a->in[3][layer * 12288 + n0 + tid]; }
}

DI void p0_transpose(ArgsP a, int idx, LAS float* sm) {
    int mat, base;
    if (idx < 256) { mat = 0; base = 0; } else if (idx < 768) { mat = 1; base = 256; } else if (idx < 1440) { mat = 2; base = 768; } else if (idx < 1696) { mat = 3; base = 1440; }
    else if (idx < 1952) { mat = 4; base = 1696; } else if (idx < 2208) { mat = 5; base = 1952; } else if (idx < 2272) { mat = 6; base = 2208; } else { mat = 7; base = 2272; }
    int N = 2048, K = 2048, Nsrc = 2048; const float* src = nullptr; bf16_t* dst = nullptr;
    switch (mat) {
        case 0: src = a->in[7];  dst = (bf16_t*)(a->ws + WS_WT_SIN);  N = 2048; K = 2048; Nsrc = 2048; break;
        case 1: src = a->in[16]; dst = (bf16_t*)(a->ws + WS_WT_SOUT); N = 4096; K = 2048; Nsrc = 4096; break;
        case 2: src = a->in[17]; dst = (bf16_t*)(a->ws + WS_WT_NIN);  N = 5376; K = 2048; Nsrc = 5168; break;
        case 3: src = a->in[24]; dst = (bf16_t*)(a->ws + WS_WT_NOUT); N = 2048; K = 2048; Nsrc = 2048; break;
        case 4: src = a->in[25]; dst = (bf16_t*)(a->ws + WS_WT_PQ);   N = 2048; K = 2048; Nsrc = 2048; break;
        case 5: src = a->in[25] + (size_t)DM * DM; dst = (bf16_t*)(a->ws + WS_WT_PQ) + (size_t)DM * DM; N = 2048; K = 2048; Nsrc = 2048; break;
        case 6: src = a->in[19]; dst = (bf16_t*)(a->ws + WS_CW1T); N = 128; K = 4096; Nsrc = 128; break;
        default: src = a->in[22]; dst = (bf16_t*)(a->ws + WS_CW1T) + (size_t)128 * 4096; N = 128; K = 4096; Nsrc = 128; break;
    }
    const int li = idx - base, ntn = (N + 255) / 256, nt = li % ntn, kt = li / ntn, k0 = kt * 64, nd0 = nt * 256;
    const int tid = threadIdx.x;
    __syncthreads();
#pragma unroll
    for (int it = 0; it < 8; ++it) {
        const int k = it * 8 + (tid >> 6), nl = (tid & 63) * 4;
        int ns = nd0 + nl;
        if (mat == 1) ns = (nl < 128) ? (128 * nt + nl) : (2048 + 128 * nt + nl - 128);
        f32x4 v = {0.f, 0.f, 0.f, 0.f};
        if (ns < Nsrc) v = *(const f32x4*)(src + (size_t)(k0 + k) * Nsrc + ns);
        LAS float* p = sm + k * 257 + nl; p[0] = v[0]; p[1] = v[1]; p[2] = v[2]; p[3] = v[3];
    }
    __syncthreads();
#pragma unroll
    for (int it = 0; it < 4; ++it) {
        const int c = it * 512 + tid, nl = c >> 3, k8 = (c & 7) * 8;
        if (nd0 + nl < N) {
            u32x4 w;
            w.x = pk_bf16(sm[(k8 + 0) * 257 + nl], sm[(k8 + 1) * 257 + nl]); w.y = pk_bf16(sm[(k8 + 2) * 257 + nl], sm[(k8 + 3) * 257 + nl]);
            w.z = pk_bf16(sm[(k8 + 4) * 257 + nl], sm[(k8 + 5) * 257 + nl]); w.w = pk_bf16(sm[(k8 + 6) * 257 + nl], sm[(k8 + 7) * 257 + nl]);
            *(u32x4*)(dst + (size_t)(nd0 + nl) * K + k0 + k8) = w;
        }
    }
}

DI void p0_convert(const float* src, bf16_t* dst, int item) {
    const size_t e0 = (size_t)item * 8192 + (size_t)threadIdx.x * 8;
#pragma unroll
    for (int h = 0; h < 2; ++h) {
        const size_t e = e0 + (size_t)h * 4096;
        const f32x4 v0 = *(const f32x4*)(src + e), v1 = *(const f32x4*)(src + e + 4);
        u32x4 w; w.x = pk_bf16(v0[0], v0[1]); w.y = pk_bf16(v0[2], v0[3]); w.z = pk_bf16(v1[0], v1[1]); w.w = pk_bf16(v1[2], v1[3]);
        *(u32x4*)(dst + e) = w;
    }
}

DI u32 fp6_e2m3(float x) {
    const u32 b = __float_as_uint(x), sgn = (b >> 26) & 0x20u; const float ax = fabsf(x);
    const u32 ab = b & 0x7fffffffu;
    const u32 nrm = ((ab + 0x7ffffu + ((ab >> 20) & 1u)) >> 20) - ((127u - 1u) << 3);
    const u32 sub = (u32)__float2int_rn(ax * 8.0f);
    u32 c = (ax < 1.0f) ? sub : nrm; c = c > 31u ? 31u : c;
    return sgn | c;
}
DI void p0_quant_load(f32x4 (&v)[8], const float* src, int row, int lane) {
    const float* sp = src + (size_t)row * DM + 32 * lane;
#pragma unroll
    for (int j = 0; j < 8; ++j) v[j] = *(const f32x4*)(sp + 4 * j);
}
DI void p0_quant_emit(const f32x4 (&v)[8], unsigned char* dst, float* inv_scale, int row, int lane) {
    float mx = 0.f;
#pragma unroll
    for (int j = 0; j < 8; ++j) mx = fmaxf(mx, fmaxf(fmaxf(fabsf(v[j][0]), fabsf(v[j][1])), fmaxf(fabsf(v[j][2]), fabsf(v[j][3]))));
#pragma unroll
    for (int o = 32; o >= 1; o >>= 1) mx = fmaxf(mx, __shfl_xor(mx, o));
    const float sc = (mx > 0.f) ? 7.5f / mx : 1.0f;
    unsigned long long w[3] = {0ull, 0ull, 0ull};
#pragma unroll
    for (int j = 0; j < 32; ++j) { const unsigned long long c = fp6_e2m3(v[j >> 2][j & 3] * sc); const int pos = 6 * j, wd = pos >> 6, off = pos & 63;
        w[wd] |= c << off; if (off > 58) w[wd + 1] |= c >> (64 - off); }
    unsigned long long* dp = (unsigned long long*)(dst + (size_t)row * PEER_ROWB + lane * 24);
    dp[0] = w[0]; dp[1] = w[1]; dp[2] = w[2];
    if (lane == 0) inv_scale[row] = (mx > 0.f) ? mx * (1.0f / 7.5f) : 1.0f;
}
DI void p0_quant_all(ArgsP a) {
    const int lane = threadIdx.x & 63, wv = blockIdx.x * 8 + (threadIdx.x >> 6), nwv = gridDim.x * 8;
#pragma unroll 1
    for (int tb = 0; tb < 2; ++tb) {
        const float* src = a->in[27 + tb]; unsigned char* dst = a->ws + (tb ? WS_PV : WS_PU); float* isc = (float*)(a->ws + WS_PSC) + tb * 2 * 16384;
        f32x4 va[8], vb[8];
        const int per = (32768 + nwv - 1) / nwv, r0 = wv * per, rend = (r0 + per < 32768) ? (r0 + per) : 32768;
        int row = r0;
        if (row < rend) p0_quant_load(va, src, row, lane);
#pragma unroll 1
        for (; row < rend; row += 2) {
            const int r1 = row + 1, r2 = row + 2;
            if (r1 < rend) p0_quant_load(vb, src, r1, lane);
            p0_quant_emit(va, dst, isc, row, lane);
            if (r2 < rend) p0_quant_load(va, src, r2, lane);
            if (r1 < rend) p0_quant_emit(vb, dst, isc, r1, lane);
        }
    }
}

DI void p0_posb(ArgsP a, int item, LAS float* sm) {
    const int kv = item >> 4, sl = item & 15;
    const float* pos = a->in[kv ? 21 : 18]; const float* w1 = a->in[kv ? 22 : 19];
    const int tid = threadIdx.x, h = tid & 127, part = tid >> 7, i0 = sl * 256 + part * 64;
    float acc0 = 0.f, acc1 = 0.f, acc2 = 0.f, acc3 = 0.f;
#pragma unroll 4
    for (int i = 0; i < 64; i += 4) {
        acc0 += pos[i0 + i] * w1[(size_t)(i0 + i) * 128 + h];         acc1 += pos[i0 + i + 1] * w1[(size_t)(i0 + i + 1) * 128 + h];
        acc2 += pos[i0 + i + 2] * w1[(size_t)(i0 + i + 2) * 128 + h]; acc3 += pos[i0 + i + 3] * w1[(size_t)(i0 + i + 3) * 128 + h]; }
    __syncthreads();
    sm[tid] = (acc0 + acc1) + (acc2 + acc3); __syncthreads();
    if (tid < 128) ((float*)(a->ws + WS_PBP))[(kv * 16 + sl) * 128 + tid] = (sm[tid] + sm[tid + 128]) + (sm[tid + 256] + sm[tid + 384]);
}

DI void p0_s5tab(ArgsP a, int g);
template <int ONLY> DI void phase_prep(ArgsP a, LAS unsigned char* lds) {
    LAS float* sm = (LAS float*)lds;
    for (int item = blockIdx.x; item < P0_TOTAL; item += gridDim.x) {
        if (ONLY == 1 && item >= P0_GEMV) break;
        if (ONLY == 2 && (item < P0_GEMV || item >= P0_CV0)) continue;
        if (ONLY == 3) break;
        if (item < P0_GEMV) p0_gemv(a, item, sm);
        else if (item < P0_CV0) p0_transpose(a, item - P0_TR0, sm);
        else if (item < P0_PB0) p0_convert(a->in[26], (bf16_t*)(a->ws + WS_SUBK), item - P0_CV0 - CV_PU - CV_PV);
        else if (item < P0_S50) p0_posb(a, item - P0_PB0, sm);
        else p0_s5tab(a, item - P0_S50);
    }
    if (ONLY == 3) p0_quant_all(a);
}

DI void phase_norm(const float* x, const float* gamma, const float* shift, const float* scale, bf16_t* H) {
    const int lane = threadIdx.x & 63, wave = threadIdx.x >> 6;
    for (int row = blockIdx.x * 8 + wave; row < SEQ; row += gridDim.x * 8) {
        const float* xr = x + (size_t)row * DM;
        f32x4 v[8]; float ss = 0.f;
#pragma unroll
        for (int j = 0; j < 8; ++j) { v[j] = *(const f32x4*)(xr + 4 * lane + 256 * j); ss += v[j][0] * v[j][0] + v[j][1] * v[j][1] + v[j][2] * v[j][2] + v[j][3] * v[j][3]; }
        ss = wave_sum(ss);
        const float rstd = rsqrtf(ss * (1.0f / DM) + 1e-6f);
#pragma unroll
        for (int j = 0; j < 8; ++j) {
            const int col = 4 * lane + 256 * j;
            const f32x4 g = *(const f32x4*)(gamma + col), sc = *(const f32x4*)(scale + col), sh = *(const f32x4*)(shift + col);
            float o[4];
#pragma unroll
            for (int i = 0; i < 4; ++i) o[i] = (v[j][i] * rstd * g[i]) * (1.0f + sc[i]) + sh[i];
            u32x2 w; w.x = pk_bf16(o[0], o[1]); w.y = pk_bf16(o[2], o[3]);
            *(u32x2*)(H + (size_t)row * DM + col) = w;
        }
    }
}

DI void s5_abar(ArgsP a, int g, int n, float& ar, float& ai, float& cr, float& ci) {
    const float lre = a->in[8][g * 64 + n], lim = a->in[9][g * 64 + n], dt = expf(a->in[10][g]);
    const float mag = expf(lre * dt); ar = mag * cosf(lim * dt); ai = mag * sinf(lim * dt);
    const float den = lre * lre + lim * lim;
    cr = ((ar - 1.0f) * lre + ai * lim) / den; ci = (ai * lre - (ar - 1.0f) * lim) / den;
}
DI void p0_s5tab(ArgsP a, int g) {
    const int tid = threadIdx.x;
    { const int c = tid >> 2, p0 = (tid & 3) * 4, n = c & 63, part = c >> 6;
      float ar, ai, cr, ci; s5_abar(a, g, n, ar, ai, cr, ci);
      const float* br = a->in[11] + (size_t)(g * 64 + n) * 16 + p0; const float* bi = a->in[12] + (size_t)(g * 64 + n) * 16 + p0;
      float v[4];
#pragma unroll
      for (int j = 0; j < 4; ++j) v[j] = part ? (cr * bi[j] + ci * br[j]) : (cr * br[j] - ci * bi[j]);
      *(u32x2*)((bf16_t*)(a->ws + WS_S5BB) + ((size_t)(g * 128 + c) * 16 + p0)) = (u32x2){pk_bf16(v[0], v[1]), pk_bf16(v[2], v[3])}; }
    { const int p = tid >> 5, k0 = (tid & 31) * 4;
      const float* cre = a->in[13] + (size_t)(g * 16 + p) * 64 + (k0 >> 1); const float* cim = a->in[14] + (size_t)(g * 16 + p) * 64 + (k0 >> 1);
      *(u32x2*)((bf16_t*)(a->ws + WS_S5CT) + ((size_t)(g * 16 + p) * 128 + k0)) = (u32x2){pk_bf16(cre[0], -cim[0]), pk_bf16(cre[1], -cim[1])}; }
}
template <bool FULL> DI void phase_s5(ArgsP a, LAS unsigned char* lds) {
    const int tid = threadIdx.x, lane = tid & 63, wave = tid >> 6, ln = lane & 15, q = lane >> 4;
    const bf16_t* U = (const bf16_t*)(a->ws + WS_BUFA);
    bf16_t* YG = (bf16_t*)(a->ws + WS_BUFB);
    float* Send = (float*)(a->ws + WS_SEND);
    const bf16_t* BBt = (const bf16_t*)(a->ws + WS_S5BB); const bf16_t* CT = (const bf16_t*)(a->ws + WS_S5CT);
    LAS float* BU = (LAS float*)(lds + wave * 12544);
    LAS unsigned char* HB = lds + wave * 12544 + 8192;
    const bf16x8 zero8 = {0, 0, 0, 0, 0, 0, 0, 0};
    for (int bi = blockIdx.x; bi < 256; bi += gridDim.x) {
        const int g = bi >> 1, c = (bi & 1) * 8 + wave;
        if (!FULL && c == 15) continue;
        float ar, ai, cr_, ci_; s5_abar(a, g, lane, ar, ai, cr_, ci_);
        bf16x8 bb[8];
#pragma unroll
        for (int ct = 0; ct < 8; ++ct) bb[ct] = (q < 2) ? *(const bf16x8*)(BBt + ((size_t)(g * 128 + 16 * ct + ln) * 16 + 8 * q)) : zero8;
        bf16x8 cf[4]; float dsk = 0.f;
        if (FULL) {
#pragma unroll
            for (int ks = 0; ks < 4; ++ks) cf[ks] = *(const bf16x8*)(CT + ((size_t)(g * 16 + ln) * 128 + 32 * ks + 8 * q));
            dsk = a->in[15][g * 16 + ln];
        }
        float hr = 0.f, hi = 0.f;
        if (FULL) { float tr = ar, ti = ai;
#pragma unroll
            for (int s = 0; s < 10; ++s) { const float nr = tr * tr - ti * ti, ni = 2.0f * tr * ti; tr = nr; ti = ni; }
#pragma unroll
            for (int cc = 0; cc < 15; ++cc) { const bool on = (cc < c);
                const f32x2v sv = on ? *(const f32x2v*)(Send + ((size_t)(cc * 128 + g) * 64 + lane) * 2) : (f32x2v){0.f, 0.f};
                const float nr = tr * hr - ti * hi + sv.x, ni = tr * hi + ti * hr + sv.y; hr = on ? nr : hr; hi = on ? ni : hi; } }
        const bf16_t* up = U + (size_t)c * 1024 * DM + g * 16;
        bf16_t* yp = YG + (size_t)c * 1024 * DM + g * 16;
#pragma unroll 1
        for (int t0 = 0; t0 < 1024; t0 += 16) {
            const bf16x8 af = (q < 2) ? *(const bf16x8*)(up + (size_t)(t0 + ln) * DM + 8 * q) : zero8;
            bf16_t uraw[4];
            if (FULL) {
#pragma unroll
                for (int i = 0; i < 4; ++i) uraw[i] = up[(size_t)(t0 + 4 * q + i) * DM + ln]; }
            f32x4 acc[8];
#pragma unroll
            for (int ct = 0; ct < 8; ++ct) acc[ct] = __builtin_amdgcn_mfma_f32_16x16x32_bf16(af, bb[ct], (f32x4){0.f, 0.f, 0.f, 0.f}, 0, 0, 0);
            asm volatile("" :: "v"(af));
#pragma unroll
            for (int ct = 0; ct < 4; ++ct)
#pragma unroll
                for (int i = 0; i < 4; ++i) *(LAS f32x2v*)(BU + ((4 * q + i) * 64 + 16 * ct + ln) * 2) = (f32x2v){acc[ct][i], acc[ct + 4][i]};
            asm volatile("s_waitcnt lgkmcnt(0)" ::: "memory");
#pragma unroll
            for (int tl = 0; tl < 16; ++tl) {
                const f32x2v b = *(const LAS f32x2v*)(BU + (tl * 64 + lane) * 2);
                const float nr = ar * hr - ai * hi + b.x, ni = ar * hi + ai * hr + b.y; hr = nr; hi = ni;
                if (FULL) *(LAS s16x2*)(HB + tl * 272 + lane * 4) = __builtin_bit_cast(s16x2, pk_bf16(hr, hi));
            }
            asm volatile("s_waitcnt lgkmcnt(0)" ::: "memory");
            if (FULL) {
                f32x4 y = {0.f, 0.f, 0.f, 0.f};
#pragma unroll
                for (int ks = 0; ks < 4; ++ks) { const bf16x8 ah = *(const LAS bf16x8*)(HB + ln * 272 + (32 * ks + 8 * q) * 2); y = __builtin_amdgcn_mfma_f32_16x16x32_bf16(ah, cf[ks], y, 0, 0, 0); asm volatile("" :: "v"(ah)); }
#pragma unroll
                for (int i = 0; i < 4; ++i) { const size_t o = (size_t)(t0 + 4 * q + i) * DM + ln; const float uv = bf2f(uraw[i]); yp[o] = f2bf(gelu_tanh(y[i] + dsk * uv)); }
                asm volatile("s_waitcnt lgkmcnt(0)" ::: "memory");
            }
        }
        if (!FULL) { Send[((size_t)(c * 128 + g) * 64 + lane) * 2] = hr; Send[((size_t)(c * 128 + g) * 64 + lane) * 2 + 1] = hi; }
    }
}

DI int imax3(int a, int b, int c) { return max(max(a, b), c); }
template <int N> DI int imax_tree(const int (&k)[N]) {
    if constexpr (N == 1) return k[0];
    else if constexpr (N == 2) return max(k[0], k[1]);
    else { constexpr int M = (N + 2) / 3; int t[M];
#pragma unroll
        for (int i = 0; i < M; ++i) { const int a = k[3 * i], b = (3 * i + 1 < N) ? k[3 * i + 1] : a, c = (3 * i + 2 < N) ? k[3 * i + 2] : a; t[i] = imax3(a, b, c); }
        return imax_tree<M>(t); }
}
DI void ce_desc(int& a, int& b) { const int hi = max(a, b), lo = min(a, b); a = hi; b = lo; }
DI void bitonic_merge16_desc(int (&v)[16]) {
#pragma unroll
    for (int j = 8; j > 0; j >>= 1)
#pragma unroll
        for (int i = 0; i < 16; ++i) if ((i & j) == 0) ce_desc(v[i], v[i | j]);
}
DI void sort16_desc(int (&v)[16]) {
#pragma unroll
    for (int k = 2; k <= 16; k <<= 1)
#pragma unroll
        for (int j = k >> 1; j > 0; j >>= 1)
#pragma unroll
            for (int i = 0; i < 16; ++i) { const int l = i ^ j;
                if (l > i) { if ((i & k) == 0 || k == 16) ce_desc(v[i], v[l]); else ce_desc(v[l], v[i]); } }
}
DI void top16_of_two(int (&a)[16], const int (&b)[16]) {
#pragma unroll
    for (int i = 0; i < 16; ++i) a[i] = max(a[i], b[15 - i]);
    bitonic_merge16_desc(a);
}
DI int ord_key(float f) { int b = __float_as_int(f); return b ^ ((b >> 31) & 0x7fffffff); }
DI float ord_val(int k) { return __int_as_float(k ^ ((k >> 31) & 0x7fffffff)); }

DI void phase_route(ArgsP a, int layer, LAS unsigned char* lds) {
    const int tid = threadIdx.x, lane = tid & 63, wave = tid >> 6, l32 = lane & 31, hf = lane >> 5;
    const bf16_t* Q = (const bf16_t*)(a->ws + WS_BUFA);
    const bf16_t* SK = (const bf16_t*)(a->ws + WS_SUBK) + (size_t)layer * 8 * 2 * 128 * 128;
    int* EXPv = (int*)(a->ws + WS_EXP); float* GATE = (float*)(a->ws + WS_GATE);
    LAS unsigned char* skl = lds;
    LAS int* top = (LAS int*)(lds + 69632 + wave * 8192);
    for (int item = blockIdx.x; item < 512; item += gridDim.x) {
        const int h = item & 7, tg = item >> 3, tt = tg * 8 + wave, t0 = tt * 32;
        __syncthreads();
#pragma unroll
        for (int it = 0; it < 8; ++it) { const int c16 = it * 512 + tid, row = c16 >> 4, ch = c16 & 15;
            *(LAS u32x4*)(skl + row * 272 + ch * 16) = *(const u32x4*)(SK + ((size_t)h * 256 + row) * 128 + ch * 8); }
        __syncthreads();
        int k1[16], k2[16];
#pragma unroll 1
        for (int c = 0; c < 2; ++c) {
            f32x16 acc[4];
#pragma unroll
            for (int kt = 0; kt < 4; ++kt)
#pragma unroll
                for (int i = 0; i < 16; ++i) acc[kt][i] = 0.f;
            const bf16_t* qp = Q + (size_t)(t0 + l32) * DM + h * 256 + c * 128 + hf * 8;
            const LAS unsigned char* kp = skl + (c * 128 + l32) * 272 + hf * 16;
#pragma unroll
            for (int ks = 0; ks < 8; ++ks) {
                const bf16x8 bq = *(const bf16x8*)(qp + ks * 16);
#pragma unroll
                for (int kt = 0; kt < 4; ++kt) { const bf16x8 ak = *(const LAS bf16x8*)(kp + kt * 32 * 272 + ks * 32); acc[kt] = __builtin_amdgcn_mfma_f32_32x32x16_bf16(ak, bq, acc[kt], 0, 0, 0); }
            }
            int g0[16], g1[16], g2[16], g3[16];
#pragma unroll
            for (int i = 0; i < 16; ++i) { const int kb_ = 8 * (i >> 2) + (i & 3) + 4 * hf;
                g0[i] = (ord_key(acc[0][i]) & ~127) | (127 - (kb_));      g1[i] = (ord_key(acc[1][i]) & ~127) | (127 - (32 + kb_));
                g2[i] = (ord_key(acc[2][i]) & ~127) | (127 - (64 + kb_)); g3[i] = (ord_key(acc[3][i]) & ~127) | (127 - (96 + kb_)); }
            sort16_desc(g0); sort16_desc(g1); sort16_desc(g2); sort16_desc(g3);
            top16_of_two(g0, g1); top16_of_two(g2, g3); top16_of_two(g0, g2);
            int pr[16];
#pragma unroll
            for (int i = 0; i < 16; ++i) pr[i] = __shfl_xor(g0[i], 32);
            top16_of_two(g0, pr);
#pragma unroll
            for (int i = 0; i < 16; ++i) { if (c == 0) k1[i] = g0[i]; else k2[i] = g0[i]; }
        }
        int ck[50], ce[50];
        {
            int n = 0;
#pragma unroll
            for (int aa = 0; aa < 16; ++aa)
#pragma unroll
                for (int bb = 0; bb < 16; ++bb)
                    if ((aa + 1) * (bb + 1) <= 16) {
                        const float s = ord_val(k1[aa] & ~127) + ord_val(k2[bb] & ~127);
                        ck[n] = (ord_key(s) & ~63) | (63 - n);
                        ce[n] = (127 - (k1[aa] & 127)) * 128 + (127 - (k2[bb] & 127));
                        ++n;
                    }
        }
#pragma unroll 1
        for (int r = 0; r < 16; ++r) {
            const int m = imax_tree<50>(ck);
            int e = 0;
#pragma unroll
            for (int i = 0; i < 50; ++i) { const bool hit = (ck[i] == m); e = hit ? ce[i] : e; ck[i] = hit ? (int)0x80000000 : ck[i]; }
            if (hf == 0) { top[1024 + (l32 * 16 + r) * 2] = m & ~63; top[1024 + (l32 * 16 + r) * 2 + 1] = e; }
        }
        if (hf == 0) {
            float sv[16]; int ev[16]; float mx = -3.0e38f;
#pragma unroll
            for (int i = 0; i < 16; ++i) { sv[i] = ord_val(top[1024 + (l32 * 16 + i) * 2]); ev[i] = top[1024 + (l32 * 16 + i) * 2 + 1]; mx = fmaxf(mx, sv[i]); }
            float sum = 0.f;
#pragma unroll
            for (int i = 0; i < 16; ++i) { sv[i] = __expf(sv[i] - mx); sum += sv[i]; }
            const float inv = 1.0f / sum;
            int* ep = EXPv + (size_t)(t0 + l32) * 128 + h * 16; float* gp = GATE + (size_t)(t0 + l32) * 128 + h * 16;
#pragma unroll
            for (int i = 0; i < 16; i += 4) { *(f32x4*)(gp + i) = (f32x4){sv[i] * inv, sv[i + 1] * inv, sv[i + 2] * inv, sv[i + 3] * inv};
                *(u32x4*)(ep + i) = (u32x4){(u32)ev[i], (u32)ev[i + 1], (u32)ev[i + 2], (u32)ev[i + 3]}; }
        }
    }
}

typedef float f32x32 __attribute__((ext_vector_type(32)));
typedef int i32x6 __attribute__((ext_vector_type(6)));
constexpr int PEER_B = 4;
DI void phase_peer(ArgsP a, int layer, int mode) {
    const int lane = threadIdx.x & 63, wave = threadIdx.x >> 6;
    const bf16_t* H = (const bf16_t*)(a->ws + WS_H);
    const unsigned char* PU = a->ws + WS_PU + (size_t)layer * SEQ * PEER_ROWB;
    const unsigned char* PV = a->ws + WS_PV + (size_t)layer * SEQ * PEER_ROWB;
    const float* SCU = (const float*)(a->ws + WS_PSC) + layer * 16384; const float* SCV = SCU + 2 * 16384;
    const int* EXPv = (const int*)(a->ws + WS_EXP); const float* GATE = (const float*)(a->ws + WS_GATE);
    float* XA = (float*)(a->ws + WS_XA);
    const float* g2 = (const float*)(a->ws + WS_MOD) + layer * 12288 + 5 * DM;
    for (int t = blockIdx.x * 8 + wave; t < SEQ; t += gridDim.x * 8) {
        float hf[32];
#pragma unroll
        for (int j = 0; j < 4; ++j) { const u32x4 h0 = *(const u32x4*)(H + (size_t)t * DM + 32 * lane + 8 * j);
#pragma unroll
            for (int w = 0; w < 4; ++w) { hf[8 * j + 2 * w] = bflo(h0[w]); hf[8 * j + 2 * w + 1] = bfhi(h0[w]); } }
        const int e_lo = EXPv[(size_t)t * 128 + lane], e_hi = EXPv[(size_t)t * 128 + 64 + lane];
        const float g_lo = GATE[(size_t)t * 128 + lane], g_hi = GATE[(size_t)t * 128 + 64 + lane];
        float y[32];
#pragma unroll
        for (int i = 0; i < 32; ++i) y[i] = 0.f;
#pragma unroll 1
        for (int kb = 0; kb < 128; kb += PEER_B) {
            u32x2 ur[PEER_B][3], vr[PEER_B][3]; float gk[PEER_B], su[PEER_B], sv[PEER_B];
#pragma unroll
            for (int k = 0; k < PEER_B; ++k) {
                const int kk = kb + k;
                const int e = (kk < 64) ? __builtin_amdgcn_readlane(e_lo, kk & 63) : __builtin_amdgcn_readlane(e_hi, kk & 63);
                gk[k] = __int_as_float((kk < 64) ? __builtin_amdgcn_readlane(__float_as_int(g_lo), kk & 63) : __builtin_amdgcn_readlane(__float_as_int(g_hi), kk & 63));
                const unsigned char* up = PU + (size_t)e * PEER_ROWB + 24 * lane; const unsigned char* vp = PV + (size_t)e * PEER_ROWB + 24 * lane;
#pragma unroll
                for (int j = 0; j < 3; ++j) { ur[k][j] = *(const u32x2*)(up + 8 * j); vr[k][j] = *(const u32x2*)(vp + 8 * j); }
                su[k] = SCU[e]; sv[k] = SCV[e];
            }
            float d[PEER_B];
#pragma unroll
            for (int k = 0; k < PEER_B; ++k) {
                const i32x6 pk = {(int)ur[k][0].x, (int)ur[k][0].y, (int)ur[k][1].x, (int)ur[k][1].y, (int)ur[k][2].x, (int)ur[k][2].y};
                const f32x32 uf = __builtin_amdgcn_cvt_scalef32_pk32_f32_fp6(pk, 1.0f);
                float s0 = 0.f, s1 = 0.f;
#pragma unroll
                for (int i = 0; i < 32; i += 2) { s0 += uf[i] * hf[i]; s1 += uf[i + 1] * hf[i + 1]; }
                d[k] = s0 + s1; __builtin_amdgcn_sched_barrier(0); }
#pragma unroll
            for (int k = 0; k < PEER_B; ++k) d[k] = wave_sum(d[k]);
#pragma unroll
            for (int k = 0; k < PEER_B; ++k) {
                const float wk = gk[k] * gelu_tanh(d[k] * su[k]) * sv[k];
                const i32x6 pk = {(int)vr[k][0].x, (int)vr[k][0].y, (int)vr[k][1].x, (int)vr[k][1].y, (int)vr[k][2].x, (int)vr[k][2].y};
                const f32x32 vf = __builtin_amdgcn_cvt_scalef32_pk32_f32_fp6(pk, 1.0f);
#pragma unroll
                for (int i = 0; i < 32; ++i) y[i] += wk * vf[i];
                __builtin_amdgcn_sched_barrier(0);
            }
        }
        float ss = 0.f;
#pragma unroll
        for (int w = 0; w < 8; ++w) { const int col = 32 * lane + 4 * w;
            const f32x4 x0 = *(const f32x4*)(XA + (size_t)t * DM + col), q0 = *(const f32x4*)(g2 + col);
#pragma unroll
            for (int i = 0; i < 4; ++i) { const float v = x0[i] + q0[i] * y[4 * w + i]; y[4 * w + i] = v; ss += v * v; } }
        if (mode != 1) {
#pragma unroll
            for (int w = 0; w < 8; ++w) { const int col = 32 * lane + 4 * w;
                *(f32x4*)(XA + (size_t)t * DM + col) = (f32x4){y[4 * w], y[4 * w + 1], y[4 * w + 2], y[4 * w + 3]}; }
            if (mode == 2) {
                ss = wave_sum(ss);
                const float rstd = rsqrtf(ss * (1.0f / DM) + 1e-6f);
                const float* gam = a->in[4] + (layer + 1) * DM; const float* modn = (const float*)(a->ws + WS_MOD) + (layer + 1) * 12288;
                bf16_t* Hw = (bf16_t*)(a->ws + WS_H);
#pragma unroll
                for (int j = 0; j < 4; ++j) { u32 pk[4];
#pragma unroll
                    for (int w = 0; w < 2; ++w) { const int col = 32 * lane + 8 * j + 4 * w;
                        const f32x4 gg = *(const f32x4*)(gam + col), sh = *(const f32x4*)(modn + col), sc = *(const f32x4*)(modn + DM + col);
                        float o[4];
#pragma unroll
                        for (int i = 0; i < 4; ++i) o[i] = (y[8 * j + 4 * w + i] * rstd * gg[i]) * (1.0f + sc[i]) + sh[i];
                        pk[2 * w] = pk_bf16(o[0], o[1]); pk[2 * w + 1] = pk_bf16(o[2], o[3]); }
                    *(u32x4*)(Hw + (size_t)t * DM + 32 * lane + 8 * j) = (u32x4){pk[0], pk[1], pk[2], pk[3]}; }
            }
        } else {
            ss = wave_sum(ss);
            const float rstd = rsqrtf(ss * (1.0f / DM) + 1e-6f);
            const float* nf = a->in[6];
#pragma unroll
            for (int w = 0; w < 8; ++w) { const int col = 32 * lane + 4 * w; const f32x4 n0 = *(const f32x4*)(nf + col);
                *(f32x4*)(a->out + (size_t)t * DM + col) = (f32x4){y[4 * w] * rstd * n0[0], y[4 * w + 1] * rstd * n0[1], y[4 * w + 2] * rstd * n0[2], y[4 * w + 3] * rstd * n0[3]}; }
        }
    }
}

DI void cmp_item(ArgsP a, int id, LAS unsigned char* lds) {
    const int tid = threadIdx.x, lane = tid & 63, wave = tid >> 6, l32 = lane & 31, hf = lane >> 5;
    const int kv = id >> 7, g = (id >> 5) & 3, ntile = id & 31;
    const bf16_t* KVb = (const bf16_t*)(a->ws + WS_KV) + (size_t)kv * KV_T + (size_t)g * SEQ * 128;
    const bf16_t* W1T = (const bf16_t*)(a->ws + WS_CW1T) + (size_t)kv * 128 * 4096;
    int rowA = 32 * ntile + l32; rowA = rowA > 1022 ? 1022 : rowA;
    const bf16_t* ap = KVb + (size_t)16 * rowA * 128 + wave * 512 + hf * 8;
    const bf16_t* bp = W1T + (size_t)l32 * 4096 + wave * 512 + hf * 8;
    f32x16 acc[4];
#pragma unroll
    for (int ht = 0; ht < 4; ++ht)
#pragma unroll
        for (int i = 0; i < 16; ++i) acc[ht][i] = 0.f;
#pragma unroll 4
    for (int ks = 0; ks < 32; ++ks) {
        const bf16x8 af = *(const bf16x8*)(ap + ks * 16);
#pragma unroll
        for (int ht = 0; ht < 4; ++ht) { const bf16x8 bf = *(const bf16x8*)(bp + (size_t)ht * 32 * 4096 + ks * 16); acc[ht] = __builtin_amdgcn_mfma_f32_32x32x16_bf16(af, bf, acc[ht], 0, 0, 0); }
    }
    LAS float* slot = (LAS float*)lds + (wave & 3) * 4096;
    __syncthreads();
    if (wave < 4) {
#pragma unroll
        for (int ht = 0; ht < 4; ++ht)
#pragma unroll
            for (int i = 0; i < 16; ++i) slot[(8 * (i >> 2) + 4 * hf + (i & 3)) * 128 + 32 * ht + l32] = acc[ht][i];
    }
    __syncthreads();
    if (wave >= 4) {
#pragma unroll
        for (int ht = 0; ht < 4; ++ht)
#pragma unroll
            for (int i = 0; i < 16; ++i) slot[(8 * (i >> 2) + 4 * hf + (i & 3)) * 128 + 32 * ht + l32] += acc[ht][i];
    }
    __syncthreads();
    LAS float* S = (LAS float*)lds; LAS float* hid = (LAS float*)lds + 16384;
    const float* pbp = (const float*)(a->ws + WS_PBP) + kv * 16 * 128 + (tid & 127);
    float posb = 0.f;
#pragma unroll
    for (int sl = 0; sl < 16; ++sl) posb += pbp[sl * 128];
#pragma unroll
    for (int j = 0; j < 8; ++j) { const int o = tid + 512 * j; const float v = (S[o] + S[4096 + o]) + (S[8192 + o] + S[12288 + o]) + posb; hid[o] = gelu_tanh(v); }
    __syncthreads();
    const float* w2 = a->in[kv ? 23 : 20];
    const int e = tid & 127, mq = tid >> 7;
    float o8[8];
#pragma unroll
    for (int r = 0; r < 8; ++r) o8[r] = 0.f;
#pragma unroll 1
    for (int h0 = 0; h0 < 128; h0 += 32) { float wv[32];
#pragma unroll
        for (int j = 0; j < 32; ++j) wv[j] = w2[(h0 + j) * 128 + e];
#pragma unroll
        for (int j = 0; j < 32; ++j)
#pragma unroll
            for (int r = 0; r < 8; ++r) o8[r] += hid[(mq * 8 + r) * 128 + h0 + j] * wv[j]; }
    bf16_t* KC = (bf16_t*)(a->ws + WS_KCMP) + (size_t)g * 1024 * 128; bf16_t* VCT = (bf16_t*)(a->ws + WS_VCMPT) + (size_t)g * 128 * 1024;
#pragma unroll
    for (int r = 0; r < 8; ++r) { const int n = 32 * ntile + mq * 8 + r; const bf16_t v = (n < 1023) ? f2bf(o8[r]) : (bf16_t)0;
        if (kv == 0) KC[(size_t)n * 128 + e] = v; else VCT[(size_t)e * 1024 + n] = v; }
    __syncthreads();
}
DI void vtr_item(ArgsP a, int id, LAS unsigned char* lds) {
    const int tid = threadIdx.x;
    const int which = id >> 10, g = (id >> 8) & 3, tt = id & 255, t0 = tt * 64;
    const bf16_t* src = (const bf16_t*)(a->ws + WS_KV) + (size_t)(which ? 5 : 3) * KV_T + ((size_t)g * SEQ + t0) * 128;
    bf16_t* dst = (bf16_t*)(a->ws + (which ? WS_VWT : WS_VST)) + (size_t)g * 128 * SEQ + t0;
    LAS bf16_t* tile = (LAS bf16_t*)lds;
#pragma unroll
    for (int h = 0; h < 2; ++h) { const int q = tid + 512 * h, tl = q >> 4, d8 = (q & 15) * 8; *(LAS u32x4*)(tile + tl * 136 + d8) = *(const u32x4*)(src + (size_t)tl * 128 + d8); }
    __syncthreads();
#pragma unroll
    for (int h = 0; h < 2; ++h) { const int q = tid + 512 * h, d = q >> 3, t8 = (q & 7) * 8;
        u32x4 w;
        w.x = (u32)tile[(t8 + 0) * 136 + d] | ((u32)tile[(t8 + 1) * 136 + d] << 16); w.y = (u32)tile[(t8 + 2) * 136 + d] | ((u32)tile[(t8 + 3) * 136 + d] << 16);
        w.z = (u32)tile[(t8 + 4) * 136 + d] | ((u32)tile[(t8 + 5) * 136 + d] << 16); w.w = (u32)tile[(t8 + 6) * 136 + d] | ((u32)tile[(t8 + 7) * 136 + d] << 16);
        *(u32x4*)(dst + (size_t)d * SEQ + t8) = w; }
    __syncthreads();
}
DI void phase_cmp(ArgsP a, LAS unsigned char* lds) {
    for (int item = blockIdx.x; item < 256 + 2048; item += gridDim.x) { if (item < 256) cmp_item(a, item, lds); else vtr_item(a, item - 256, lds); }
}

constexpr float ATT_SCALE = 0.08838834764831845f;
constexpr float ATT_QSCALE = 0.08838834764831845f * 1.4426950408889634f;
#ifndef PAIR_OFF
#define PAIR_OFF 0
#endif
#ifndef ATT_NG
#define ATT_NG 1
#endif
constexpr int ATT_TQ = 32 * ATT_NG;
constexpr int ATT_NTL = SEQ / ATT_TQ;
constexpr int ATT_D = 3;
constexpr int ATT_KBUF = 0, ATT_VBUF = 65536;
constexpr int ATT_IMP = 65536;
constexpr int ATT_SELM = 131072;
constexpr int ATT_UALL = ATT_SELM + 2048;
constexpr int ATT_LIST = ATT_UALL + 128;
constexpr int ATT_GRPM = ATT_LIST + 1024;
constexpr int ATT_PAIRA = ATT_GRPM + 512;
constexpr int ATT_PAIRB = ATT_PAIRA + 1024;
static_assert(ATT_PAIRB + 1024 <= LDS_BARST, "attention LDS map");
struct AttState { float m, l; f32x4 O[8]; };
#define ATT_WAIT(n) asm volatile("s_waitcnt vmcnt(" #n ")" ::: "memory")
DI void att_barrier() { asm volatile("" ::: "memory"); __builtin_amdgcn_s_barrier(); asm volatile("" ::: "memory"); }
template <int BR> DI bool att_valid(int key, int t, int sel) {
    if (BR == 0) return (16 * key + 31 <= t);
    if (BR == 1) return sel && (key <= t);
    return (key <= t) && (t - key < 512);
}
DI float max3f(float a, float b, float c) { float r; asm("v_max3_f32 %0, %1, %2, %3" : "=v"(r) : "v"(a), "v"(b), "v"(c)); return r; }
DI u32 cvt_pk_bf16_hw(float lo, float hi) { return cvt_pk_bf16_cc(lo, hi); }
template <int BR, bool MASKED> DI void att_tile(AttState (&S)[ATT_NG], const LAS unsigned char* kbuf, const LAS unsigned char* vbuf, int kabs,
                                   const bf16x8 (&qf)[ATT_NG][4], int l16, int q, const int (&t)[ATT_NG], const int (&sel)[ATT_NG], const bool (&need)[ATT_NG],
                                   const int (&kofs)[4], const int (&vofs)[2]) {
    bf16x8 pf[ATT_NG][2]; float corr[ATT_NG];
#pragma unroll
    for (int c = 0; c < ATT_NG; ++c) {
        if (!need[c]) continue;
        f32x4 s[4];
#pragma unroll
        for (int T = 0; T < 4; ++T) {
            bf16x8 ka[4];
#pragma unroll
            for (int ks = 0; ks < 4; ++ks) ka[ks] = *(const LAS bf16x8*)(kbuf + kofs[ks] + T * 4096);
            s[T] = (f32x4){0.f, 0.f, 0.f, 0.f};
#pragma unroll
            for (int ks = 0; ks < 4; ++ks) s[T] = __builtin_amdgcn_mfma_f32_16x16x32_bf16(ka[ks], qf[c][ks], s[T], 0, 0, 0);
            if (ATT_NG > 1 || (T & 1)) __builtin_amdgcn_sched_barrier(0);
        }
        if (MASKED) {
#pragma unroll
            for (int T = 0; T < 4; ++T)
#pragma unroll
                for (int i = 0; i < 4; ++i) s[T][i] = att_valid<BR>(kabs + 32 * (T >> 1) + 8 * q + 4 * (T & 1) + i, t[c], sel[c]) ? s[T][i] : -1e30f;
        }
        asm volatile("s_nop 15\n\ts_nop 3" : "+v"(s[0]), "+v"(s[1]), "+v"(s[2]), "+v"(s[3]));
        float mx = max3f(s[0][0], s[0][1], s[0][2]); mx = max3f(mx, s[0][3], s[1][0]); mx = max3f(mx, s[1][1], s[1][2]); mx = max3f(mx, s[1][3], s[2][0]);
        mx = max3f(mx, s[2][1], s[2][2]); mx = max3f(mx, s[2][3], s[3][0]); mx = max3f(mx, s[3][1], s[3][2]); mx = max3f(mx, s[3][3], mx);
        if (BR == 1 && !MASKED) mx = sel[c] ? mx : -1e30f;
        { const auto r16 = __builtin_amdgcn_permlane16_swap(__float_as_uint(mx), __float_as_uint(mx), false, false); mx = max3f(__uint_as_float(r16[0]), __uint_as_float(r16[1]), mx);
          const auto r32 = __builtin_amdgcn_permlane32_swap(__float_as_uint(mx), __float_as_uint(mx), false, false); mx = max3f(__uint_as_float(r32[0]), __uint_as_float(r32[1]), S[c].m); }
        const float mn = mx; corr[c] = __builtin_amdgcn_exp2f(S[c].m - mn); S[c].m = mn;
        const float msub = (BR == 1 && !MASKED && !sel[c]) ? __builtin_inff() : mn;
        float p[4][4], ps = 0.f;
#pragma unroll
        for (int T = 0; T < 4; ++T)
#pragma unroll
            for (int i = 0; i < 4; ++i) { float e = __builtin_amdgcn_exp2f(s[T][i] - msub);
                if (MASKED) e = (s[T][i] > -1e29f) ? e : 0.f;
                p[T][i] = e; ps += e; }
        S[c].l = S[c].l * corr[c] + ps;
#pragma unroll
        for (int hh = 0; hh < 2; ++hh) { u32x4 pw; pw.x = cvt_pk_bf16_hw(p[2 * hh][0], p[2 * hh][1]); pw.y = cvt_pk_bf16_hw(p[2 * hh][2], p[2 * hh][3]);
            pw.z = cvt_pk_bf16_hw(p[2 * hh + 1][0], p[2 * hh + 1][1]); pw.w = cvt_pk_bf16_hw(p[2 * hh + 1][2], p[2 * hh + 1][3]); pf[c][hh] = __builtin_bit_cast(bf16x8, pw); }
    }
#pragma unroll
    for (int c = 0; c < ATT_NG; ++c) { if (!need[c]) continue;
#pragma unroll
        for (int dt = 0; dt < 8; ++dt) S[c].O[dt] = S[c].O[dt] * corr[c]; }
#pragma unroll
    for (int dt = 0; dt < 8; ++dt) {
#pragma unroll
        for (int hh = 0; hh < 2; ++hh) {
            const bf16x8 vw = *(const LAS bf16x8*)(vbuf + vofs[hh] + dt * 2048);
#pragma unroll
            for (int c = 0; c < ATT_NG; ++c) { if (!need[c]) continue;
                S[c].O[dt] = __builtin_amdgcn_mfma_f32_16x16x32_bf16(vw, pf[c][hh], S[c].O[dt], 0, 0, 0); }
        }
        if (ATT_NG > 1 || (dt & 1)) __builtin_amdgcn_sched_barrier(0);
    }
}
DI void att_imp_tile(const LAS unsigned char* kbuf, int kabs, const bf16x8 (&qf)[ATT_NG][4], int l16, int q, const int (&t)[ATT_NG],
                     const float (&mfin)[ATT_NG], const float (&inv)[ATT_NG], LAS float* impw, const int (&kofs)[4]) {
    const int tok = l16 >> 2, r = l16 & 3;
#pragma unroll
    for (int T = 0; T < 4; ++T) {
        bf16x8 ka[4];
#pragma unroll
        for (int ks = 0; ks < 4; ++ks) ka[ks] = *(const LAS bf16x8*)(kbuf + kofs[ks] + T * 4096);
#pragma unroll
        for (int c = 0; c < ATT_NG; ++c) {
            f32x4 sc = {0.f, 0.f, 0.f, 0.f};
#pragma unroll
            for (int ks = 0; ks < 4; ++ks) sc = __builtin_amdgcn_mfma_f32_16x16x32_bf16(ka[ks], qf[c][ks], sc, 0, 0, 0);
            const int k0 = kabs + 32 * (T >> 1) + 8 * q + 4 * (T & 1);
            float pv[4];
#pragma unroll
            for (int i = 0; i < 4; ++i) { pv[i] = att_valid<0>(k0 + i, t[c], 0) ? __builtin_amdgcn_exp2f(sc[i] - mfin[c]) * inv[c] : 0.f; pv[i] += dppf<DPP_XOR1>(pv[i]); pv[i] += dppf<DPP_XOR2>(pv[i]); }
            if (r == 0) { LAS float* row = impw + (4 * c + tok) * 256; const int j = k0 >> 2;
                atomicAdd((float*)&row[j], 2.0f * (pv[0] + pv[1] + pv[2]) + pv[3]);
                if (j + 1 < 256) atomicAdd((float*)&row[j + 1], pv[3]); }
        }
    }
}
template <int BR, int MODE, int PROBE = 0> DI void att_stream(LAS unsigned char* lds, const bf16_t* Kp, const bf16_t* VTp, size_t ldv, int ntiles, int kb0, const LAS int* list,
                                               AttState (&S)[ATT_NG], const bf16x8 (&qf)[ATT_NG][4], int l16_in, int q_in, const int (&t)[ATT_NG],
                                               const LAS u32* selw, const LAS u32* grpw, const float (&mfin)[ATT_NG], const float (&inv)[ATT_NG], LAS float* impw) {
    int lane = threadIdx.x & 63, l16 = l16_in, q = q_in;
    asm volatile("" : "+v"(lane), "+v"(l16), "+v"(q));
    const int wave = __builtin_amdgcn_readfirstlane(threadIdx.x >> 6);
    if (ntiles <= 0) return;
    const int tw0 = __builtin_amdgcn_readfirstlane(t[0]) & ~3;
    int kofs[4], vofs[2];
#pragma unroll
    for (int ks = 0; ks < 4; ++ks) kofs[ks] = l16 * 256 + (((4 * ks + q) ^ l16) << 4);
#pragma unroll
    for (int hh = 0; hh < 2; ++hh) vofs[hh] = l16 * 128 + (((4 * hh + q) ^ ((l16 >> 1) & 7)) << 4);
    size_t offk[2], offv[2];
#pragma unroll
    for (int h = 0; h < 2; ++h) { const int p = wave + 8 * h;
        { const int row = 4 * p + (lane >> 4), cl = (lane & 15) ^ (row & 15), r5 = row & 31, key = (row & 32) + 8 * ((r5 >> 2) & 3) + 4 * (r5 >> 4) + (r5 & 3);
          offk[h] = (size_t)key * 128 + cl * 8; }
        { const int row = 8 * p + (lane >> 3), cl = (lane & 7) ^ ((row >> 1) & 7); offv[h] = (size_t)row * ldv + cl * 8; } }
#define TILE_KB(k) ((BR == 1) ? 64 * list[(k)] : kb0 + 64 * (k))
#define TILE_ISSUE(k) do { const int kb_ = (PROBE & 1) ? 0 : TILE_KB(k), slot_ = ((k) & 3) * 16384; \
        _Pragma("unroll") for (int h = 0; h < 2; ++h) __builtin_amdgcn_global_load_lds((const u32*)(Kp + (size_t)kb_ * 128 + offk[h]), (LAS u32*)(lds + ATT_KBUF + slot_ + (wave + 8 * h) * 1024), 16, 0, 0); \
        if (MODE == 0) { _Pragma("unroll") for (int h = 0; h < 2; ++h) __builtin_amdgcn_global_load_lds((const u32*)(VTp + kb_ + offv[h]), (LAS u32*)(lds + ATT_VBUF + slot_ + (wave + 8 * h) * 1024), 16, 0, 0); } } while (0)
#pragma unroll
    for (int i = 0; i < ATT_D; ++i) if (i < ntiles) TILE_ISSUE(i);
    for (int k = 0; k < ntiles; ++k) {
        const int rem = ntiles - 1 - k;
        const int kb = TILE_KB(k);
        int sel[ATT_NG]; bool need[ATT_NG]; bool any = false;
#pragma unroll
        for (int c = 0; c < ATT_NG; ++c) { sel[c] = 1; need[c] = true;
            if (BR == 1 && MODE == 0) { const int j = kb >> 6; sel[c] = (int)((selw[(4 * c + (l16 >> 2)) * 8 + (j >> 5)] >> (j & 31)) & 1u);
                const u32 gm = grpw[c * 8 + (j >> 5)]; need[c] = ((__builtin_amdgcn_readfirstlane((int)gm) >> (j & 31)) & 1) != 0; }
            any = any || need[c]; }
        if (MODE == 0) { if (rem >= 2) ATT_WAIT(8); else if (rem == 1) ATT_WAIT(4); else ATT_WAIT(0); }
        else           { if (rem >= 2) ATT_WAIT(4); else if (rem == 1) ATT_WAIT(2); else ATT_WAIT(0); }
        att_barrier();
        if (k + ATT_D < ntiles) TILE_ISSUE(k + ATT_D);
        const LAS unsigned char* kbuf = lds + ATT_KBUF + (k & 3) * 16384; const LAS unsigned char* vbuf = lds + ATT_VBUF + (k & 3) * 16384;
        if (MODE == 0) {
            if (any && !(PROBE & 2)) {
                bool full;
                if (BR == 0) full = (16 * (kb + 63) + 31 <= tw0);
                else if (BR == 1) full = (kb + 63 <= tw0);
                else full = (kb + 63 <= tw0) && (tw0 + 4 * ATT_NG - 1 - kb < 512);
                if (full) att_tile<BR, false>(S, kbuf, vbuf, kb, qf, l16, q, t, sel, need, kofs, vofs); else att_tile<BR, true>(S, kbuf, vbuf, kb, qf, l16, q, t, sel, need, kofs, vofs);
            }
        } else { att_imp_tile(kbuf, kb, qf, l16, q, t, mfin, inv, impw, kofs); }
    }
    asm volatile("s_waitcnt lgkmcnt(0)" ::: "memory");
    att_barrier();
#undef TILE_KB
#undef TILE_ISSUE
}

template <int PROBE> DI void att_stream_pairs(LAS unsigned char* lds, const bf16_t* Kp, const bf16_t* VTp, size_t ldv, const LAS u32* cnts, const LAS int* pairA, const LAS int* pairB,
                         AttState (&S)[ATT_NG], const bf16x8 (&qf)[ATT_NG][4], int l16_in, int q_in, const int (&t)[ATT_NG], const LAS u32* selw, const LAS u32* grpw) {
    int lane = threadIdx.x & 63, l16 = l16_in, q = q_in;
    asm volatile("" : "+v"(lane), "+v"(l16), "+v"(q));
    const int wave = __builtin_amdgcn_readfirstlane(threadIdx.x >> 6);
    int cw[8], nsteps = 0;
#pragma unroll
    for (int w = 0; w < 8; ++w) { cw[w] = __builtin_amdgcn_readfirstlane((int)cnts[w]); nsteps += cw[w]; }
    if (nsteps <= 0) return;
    const int tw0 = __builtin_amdgcn_readfirstlane(t[0]) & ~3;
    int kofs[4], vofs[2];
#pragma unroll
    for (int ks = 0; ks < 4; ++ks) kofs[ks] = l16 * 256 + (((4 * ks + q) ^ l16) << 4);
#pragma unroll
    for (int hh = 0; hh < 2; ++hh) vofs[hh] = l16 * 128 + (((4 * hh + q) ^ ((l16 >> 1) & 7)) << 4);
#define PAIR_IDX(k, out) do { int k_ = (k), o_ = 0; _Pragma("unroll") for (int w = 0; w < 8; ++w) { const bool past = (k_ >= cw[w]) && (w < 7); o_ = past ? (32 * (w + 1)) : o_; k_ = past ? (k_ - cw[w]) : k_; if (!past) break; } (out) = o_ + k_; } while (0)
    unsigned offk[2], offv[2];
#pragma unroll
    for (int h = 0; h < 2; ++h) { const int p = wave + 8 * h;
        { const int row = 4 * p + (lane >> 4), cl = (lane & 15) ^ (row & 15), r5 = row & 31, key = (row & 32) + 8 * ((r5 >> 2) & 3) + 4 * (r5 >> 4) + (r5 & 3);
          offk[h] = (unsigned)(key * 128 + cl * 8); }
        { const int row = 8 * p + (lane >> 3), cl = (lane & 7) ^ ((row >> 1) & 7); offv[h] = (unsigned)(row * (int)ldv + cl * 8); } }
#define PAIR_ISSUE(blk, slot) do { const int kb_ = (PROBE & 1) ? 0 : 64 * (blk), slot_ = (slot) * 16384; \
        _Pragma("unroll") for (int h = 0; h < 2; ++h) __builtin_amdgcn_global_load_lds((const u32*)(Kp + (size_t)kb_ * 128 + offk[h]), (LAS u32*)(lds + ATT_KBUF + slot_ + (wave + 8 * h) * 1024), 16, 0, 0); \
        _Pragma("unroll") for (int h = 0; h < 2; ++h) __builtin_amdgcn_global_load_lds((const u32*)(VTp + kb_ + offv[h]), (LAS u32*)(lds + ATT_VBUF + slot_ + (wave + 8 * h) * 1024), 16, 0, 0); } while (0)
    int idx_cur; PAIR_IDX(0, idx_cur);
    { const int a0 = pairA[idx_cur], b0 = pairB[idx_cur]; PAIR_ISSUE(a0, 0); PAIR_ISSUE(b0 >= 0 ? b0 : a0, 1); }
    for (int k = 0; k < nsteps; ++k) {
        int idx_nxt = 0; if (k + 1 < nsteps) PAIR_IDX(k + 1, idx_nxt);
        int blk[2]; blk[0] = pairA[idx_cur]; blk[1] = pairB[idx_cur];
        int sel[2][ATT_NG]; bool need[2][ATT_NG];
#pragma unroll
        for (int x = 0; x < 2; ++x)
#pragma unroll
            for (int c = 0; c < ATT_NG; ++c) { const int j = blk[x] < 0 ? 0 : blk[x];
                sel[x][c] = (int)((selw[(4 * c + (l16 >> 2)) * 8 + (j >> 5)] >> (j & 31)) & 1u);
                const u32 gm = grpw[c * 8 + (j >> 5)]; need[x][c] = (blk[x] >= 0) && (((__builtin_amdgcn_readfirstlane((int)gm) >> (j & 31)) & 1) != 0); }
        ATT_WAIT(0);
        att_barrier();
        if (k + 1 < nsteps) { const int a1 = pairA[idx_nxt], b1 = pairB[idx_nxt]; PAIR_ISSUE(a1, (2 * k + 2) & 3); PAIR_ISSUE(b1 >= 0 ? b1 : a1, (2 * k + 3) & 3); }
#pragma unroll
        for (int x = 0; x < 2; ++x) {
            bool any = false;
#pragma unroll
            for (int c = 0; c < ATT_NG; ++c) any = any || need[x][c];
            if (!any || (PROBE & 2)) continue;
            const int kb = 64 * blk[x];
            const LAS unsigned char* kbuf = lds + ATT_KBUF + ((2 * k + x) & 3) * 16384; const LAS unsigned char* vbuf = lds + ATT_VBUF + ((2 * k + x) & 3) * 16384;
            if (kb + 63 <= tw0) att_tile<1, false>(S, kbuf, vbuf, kb, qf, l16, q, t, sel[x], need[x], kofs, vofs); else att_tile<1, true>(S, kbuf, vbuf, kb, qf, l16, q, t, sel[x], need[x], kofs, vofs);
        }
        idx_cur = idx_nxt;
    }
    asm volatile("s_waitcnt lgkmcnt(0)" ::: "memory");
    att_barrier();
#undef PAIR_ISSUE
#undef PAIR_IDX
}

template <int SKIP> DI void phase_att(ArgsP a, LAS unsigned char* lds) {
    const bf16_t* Qb = (const bf16_t*)(a->ws + WS_BUFA);
    const bf16_t* KVb = (const bf16_t*)(a->ws + WS_KV);
    const float* GL = (const float*)(a->ws + WS_GL);
    bf16_t* Ob = (bf16_t*)(a->ws + WS_BUFB);
    const int G = gridDim.x, NI = ATT_NTL * 4, p = blockIdx.x;
    const bool xcd_order = (G == 256);
    const int nrd = xcd_order ? (ATT_NTL / 64) : ((NI + G - 1) / G);
    for (int rd = 0; rd < nrd; ++rd) {
        int g, tile;
        if (xcd_order) { const int x = p & 7, i = p >> 3, h = x >> 2, base = ATT_NTL / 32 - 1 - 2 * rd, chunk = ((rd & 1) == h) ? base : base - 1; g = x & 3; tile = 32 * chunk + i; }
        else { const int idx = rd * G + ((rd & 1) ? (G - 1 - p) : p); if (idx >= NI) continue; g = idx & 3; tile = ATT_NTL - 1 - (idx >> 2); }
        int tid = threadIdx.x; asm volatile("" : "+v"(tid));
        const int lane = tid & 63, wave = tid >> 6, l16 = lane & 15, q = lane >> 4, tok = l16 >> 2, r = l16 & 3;
        LAS float* impw = (LAS float*)(lds + ATT_IMP) + wave * (4 * ATT_NG) * 256;
        LAS u32* selw = (LAS u32*)(lds + ATT_SELM) + wave * (4 * ATT_NG) * 8;
        LAS u32* uall = (LAS u32*)(lds + ATT_UALL);
        LAS int* list = (LAS int*)(lds + ATT_LIST);
        LAS u32* grpw = (LAS u32*)(lds + ATT_GRPM) + wave * ATT_NG * 8;
        const int t0 = tile * ATT_TQ, tlast = t0 + ATT_TQ - 1, cur = t0 >> 6;
        int t[ATT_NG]; bf16x8 qf[ATT_NG][4];
#pragma unroll
        for (int c = 0; c < ATT_NG; ++c) { t[c] = t0 + wave * (4 * ATT_NG) + 4 * c + tok; const int head = 4 * g + r;
            const bf16_t* qp = Qb + (size_t)t[c] * DM + head * 128 + 8 * q;
#pragma unroll
            for (int ks = 0; ks < 4; ++ks) { const u32x4 qw = *(const u32x4*)(qp + 32 * ks); u32x4 qs;
#pragma unroll
                for (int w = 0; w < 4; ++w) qs[w] = cvt_pk_bf16_hw(bflo(qw[w]) * ATT_QSCALE, bfhi(qw[w]) * ATT_QSCALE);
                qf[c][ks] = __builtin_bit_cast(bf16x8, qs); }
}
        AttState S[ATT_NG];
        float mfin[ATT_NG], inv[ATT_NG];
#pragma unroll
        for (int c = 0; c < ATT_NG; ++c) { mfin[c] = 0.f; inv[c] = 0.f; }
#define ATT_RESET() do { _Pragma("unroll") for (int c = 0; c < ATT_NG; ++c) { S[c].m = -1e30f; S[c].l = 0.f; _Pragma("unroll") for (int i = 0; i < 8; ++i) S[c].O[i] = (f32x4){0.f, 0.f, 0.f, 0.f}; } } while (0)
#define ATT_FOLD(b) do { _Pragma("unroll") for (int c = 0; c < ATT_NG; ++c) { float l = sum_x32(sum_x16(S[c].l)); inv[c] = (l > 0.f) ? 1.0f / l : 0.f; mfin[c] = S[c].m; \
        const float w = GL[(size_t)t[c] * 48 + (4 * g + r) * 3 + (b)] * inv[c]; bf16_t* op = Ob + (size_t)t[c] * DM + (4 * g + r) * 128 + 4 * q; \
        _Pragma("unroll") for (int dt = 0; dt < 8; ++dt) { const f32x4 o = S[c].O[dt] * w; u32x2 pr = (u32x2){0u, 0u}; if ((b) != 0) pr = *(const u32x2*)(op + 16 * dt); \
            *(u32x2*)(op + 16 * dt) = (u32x2){cvt_pk_bf16_hw(bflo(pr.x) + o[0], bfhi(pr.x) + o[1]), cvt_pk_bf16_hw(bflo(pr.y) + o[2], bfhi(pr.y) + o[3])}; } } } while (0)
        __syncthreads();
        if (lane < 4 * ATT_NG * 8) selw[lane] = 0u;
        if (lane < ATT_NG * 8) grpw[lane] = 0u;
        if (tid < 24) uall[tid] = 0u;
        const bf16_t* Kc = (const bf16_t*)(a->ws + WS_KCMP) + (size_t)g * 1024 * 128; const bf16_t* VcT = (const bf16_t*)(a->ws + WS_VCMPT) + (size_t)g * 128 * 1024;
        const int ncmp = (tlast - 31) / 16 + 1, nct = (ncmp + 63) >> 6;
        ATT_RESET();
        if (!(SKIP & 1)) att_stream<0, 0>(lds, Kc, VcT, 1024, nct, 0, nullptr, S, qf, l16, q, t, selw, grpw, mfin, inv, impw);
        ATT_FOLD(0);
        for (int i = lane; i < 4 * ATT_NG * 256; i += 64) impw[i] = 0.f;
        if (!(SKIP & 2)) att_stream<0, 1>(lds, Kc, VcT, 1024, nct, 0, nullptr, S, qf, l16, q, t, selw, grpw, mfin, inv, impw);
#pragma unroll
        for (int c = 0; c < ATT_NG; ++c) {
            if (SKIP & 4) continue;
            const int tk = q; LAS float* row = impw + (4 * c + tk) * 256; LAS u32* srow = selw + (4 * c + tk) * 8;
            int key[16];
#pragma unroll
            for (int i = 0; i < 16; ++i) { const int j = 16 * l16 + i; const float v = row[j];
                const bool forced = (j == 0) || (j == cur) || (j == cur - 1);
                key[i] = (j <= cur && !forced) ? ((__float_as_int(v) & ~255) | (255 - j)) : -1; }
            const int nforced = (cur >= 2) ? 3 : (cur + 1);
            if (l16 == 0) { atomicOr((u32*)&srow[0], 1u); atomicOr((u32*)&srow[cur >> 5], 1u << (cur & 31)); if (cur >= 1) atomicOr((u32*)&srow[(cur - 1) >> 5], 1u << ((cur - 1) & 31)); }
            for (int rr = 0; rr < 16 - nforced; ++rr) {
                int m = key[0];
#pragma unroll
                for (int i = 1; i < 16; ++i) m = max(m, key[i]);
                m = max(m, dppi<DPP_XOR1>(m)); m = max(m, dppi<DPP_XOR2>(m)); m = max(m, dppi<DPP_HMIRROR>(m)); m = max(m, dppi<DPP_MIRROR>(m));
                if (m >= 0) { const int j = 255 - (m & 255); if (l16 == 0) atomicOr((u32*)&srow[j >> 5], 1u << (j & 31));
#pragma unroll
                    for (int i = 0; i < 16; ++i) key[i] = (key[i] == m) ? -1 : key[i]; }
            }
            if (lane < 8) { const u32 gm = selw[(4 * c) * 8 + lane] | selw[(4 * c + 1) * 8 + lane] | selw[(4 * c + 2) * 8 + lane] | selw[(4 * c + 3) * 8 + lane];
                grpw[c * 8 + lane] = gm; atomicOr((u32*)&uall[lane], gm); }
        }
        __syncthreads();
        if (wave == 0) {
            int base = 0;
#pragma unroll
            for (int rr = 0; rr < 4; ++rr) { const int j = lane + 64 * rr; const bool bit = ((uall[j >> 5] >> (j & 31)) & 1u) != 0u;
                const unsigned long long bal = __ballot(bit);
                if (bit) list[base + __popcll(bal & ((1ull << lane) - 1ull))] = j;
                base += __popcll(bal); }
            if (lane == 0) uall[8] = (u32)base;
        }
        __syncthreads();
        { const int n = (int)uall[8], seg = (n + 7) >> 3, s0 = wave * seg, cntl = (n - s0 < seg) ? (n - s0 < 0 ? 0 : n - s0) : seg;
          const LAS u32* gall = (const LAS u32*)(lds + ATT_GRPM);
          int m = 0, jme = 0; bool used = (lane >= cntl);
          if (lane < cntl) { jme = list[s0 + lane];
#pragma unroll
              for (int w = 0; w < 8; ++w) { u32 g_or = 0u, g_and = 0xffffffffu;
#pragma unroll
                  for (int c = 0; c < ATT_NG; ++c) { const u32 gw = gall[(w * ATT_NG + c) * 8 + (jme >> 5)]; g_or |= gw; g_and &= gw; }
                  m |= (int)((g_or >> (jme & 31)) & 1u) << w; if (ATT_NG > 1) m |= (int)((g_and >> (jme & 31)) & 1u) << (8 + w); } }
          LAS int* pairA = (LAS int*)(lds + ATT_PAIRA) + 32 * wave; LAS int* pairB = (LAS int*)(lds + ATT_PAIRB) + 32 * wave;
          int ns = 0;
          for (int i = 0; i < cntl; ++i) {
              if (__builtin_amdgcn_readlane((int)used, i)) continue;
              const int mi = __builtin_amdgcn_readlane(m, i), ji = __builtin_amdgcn_readlane(jme, i);
              const bool cand = !used && (lane > i);
              const bool fits = (ATT_NG == 1) ? ((m & mi & 0xff) == 0) : (((((m >> 8) & mi) | ((mi >> 8) & m)) & 0xff) == 0);
              unsigned long long bal = __ballot(cand && fits);
              if (bal == 0ull) bal = __ballot(cand);
              const int partner = bal ? (int)__builtin_ctzll(bal) : -1;
              int jp = -1; if (partner >= 0) jp = __builtin_amdgcn_readlane(jme, partner);
              if (lane == i || lane == partner) used = true;
              if (lane == 0) { pairA[ns] = ji; pairB[ns] = jp; }
              ++ns;
          }
          if (lane == 0) uall[16 + wave] = (u32)ns; }
        __syncthreads();
        { const bf16_t* Ks = KVb + (size_t)2 * KV_T + (size_t)g * SEQ * 128; const bf16_t* VsT = (const bf16_t*)(a->ws + WS_VST) + (size_t)g * 128 * SEQ;
          ATT_RESET();
          if (!(SKIP & 8)) att_stream_pairs<((SKIP & 32) ? 1 : 0) | ((SKIP & 64) ? 2 : 0)>(lds, Ks, VsT, SEQ, (const LAS u32*)(uall + 16), (const LAS int*)(lds + ATT_PAIRA), (const LAS int*)(lds + ATT_PAIRB), S, qf, l16, q, t, selw, grpw);
          ATT_FOLD(1); }
        { const bf16_t* Kw = KVb + (size_t)4 * KV_T + (size_t)g * SEQ * 128; const bf16_t* VwT = (const bf16_t*)(a->ws + WS_VWT) + (size_t)g * 128 * SEQ;
          int kb0 = t0 - 511; kb0 = kb0 < 0 ? 0 : (kb0 & ~63);
          ATT_RESET();
          if (!(SKIP & 16)) att_stream<2, 0>(lds, Kw, VwT, SEQ, (tlast - kb0) / 64 + 1, kb0, nullptr, S, qf, l16, q, t, selw, grpw, mfin, inv, impw);
          ATT_FOLD(2); }
#undef ATT_RESET
#undef ATT_FOLD
    }
}

constexpr int N_PHASES = 20;
#ifndef PHASE_MASK
#define PHASE_MASK 0xFFFFF
#endif
template <class Epi> DI void run_gemm(LAS unsigned char* lds, const bf16_t* A, const bf16_t* Bt, int N, const Epi& E) {
    pg8::Gemm g{A, Bt, SEQ, N, DM}; pg8::StaticOrder S; S.init(SEQ, N, (int)gridDim.x, (int)blockIdx.x);
    pg8::gemm_phase<Epi, pg8::StaticOrder, false>((PG8_LAS unsigned char*)lds, g, S, E, nullptr);
}

__global__ void __launch_bounds__(NT, 2) fwd_mega(Args a_by_value) {
    const ArgsP a0 = (ArgsP)__builtin_amdgcn_kernarg_segment_ptr();
    extern __shared__ __attribute__((aligned(16))) unsigned char lds_raw[];
    LAS unsigned char* lds = (LAS unsigned char*)lds_raw;
    cg::grid_group grid = cg::this_grid();
    const int lo = a0->ph_lo, hi = a0->ph_hi;
    if (threadIdx.x < 4) ((LAS unsigned*)(lds + LDS_BARST))[threadIdx.x] = 0u;
    __syncthreads();
    const XcdBarrier xbar = xcd_barrier_post((unsigned*)(a0->ws + WS_BAR), (volatile LAS unsigned*)(lds + LDS_BARST));
#define PH_VARS const ArgsP a = args_fresh(a0); unsigned char* ws = a->ws; const float* mod0 = (const float*)(ws + WS_MOD); const float* mod1 = mod0 + 12288; \
    bf16_t* H = (bf16_t*)(ws + WS_H); bf16_t* BA = (bf16_t*)(ws + WS_BUFA); bf16_t* BB = (bf16_t*)(ws + WS_BUFB); float* XA = (float*)(ws + WS_XA); \
    (void)mod0; (void)mod1; (void)H; (void)BA; (void)BB; (void)XA;
#ifndef SEAM_CG
#define SEAM_CG 0
#endif
#define IN(k) (lo <= (k) && (k) < hi)
#define SEAM(k) do { if (IN(k) && IN((k) + 1)) { if ((k) == 0 || (k) == SEAM_CG) grid.sync(); else xcd_barrier(xbar); } } while (0)
#if (PHASE_MASK >> 0) & 1
#if defined(PROBE_DUP) && PROBE_DUP == 0
#ifndef PREP_ONLY
#define PREP_ONLY 0
#endif
        if (IN(0)) { PH_VARS phase_prep<PREP_ONLY>(a, lds); }
        if (IN(0)) xcd_barrier(xbar);
#endif
        if (IN(0)) { PH_VARS phase_prep<0>(a, lds); }
        SEAM(0);
#endif
#if (PHASE_MASK >> 1) & 1
#if defined(PROBE_DUP) && PROBE_DUP == 1
        if (IN(1)) { PH_VARS phase_norm(a->in[0], a->in[4], mod0, mod0 + DM, H); }
        if (IN(1)) xcd_barrier(xbar);
#endif
        if (IN(1)) { PH_VARS phase_norm(a->in[0], a->in[4], mod0, mod0 + DM, H); }
        SEAM(1);
#endif
#if (PHASE_MASK >> 2) & 1
#if defined(PROBE_DUP) && PROBE_DUP == 2
        if (IN(2)) { PH_VARS { pg8::EpiStoreBf16 E{BA, DM}; run_gemm(lds, H, (const bf16_t*)(ws + WS_WT_SIN), 2048, E); } }
        if (IN(2)) xcd_barrier(xbar);
#endif
        if (IN(2)) { PH_VARS { pg8::EpiStoreBf16 E{BA, DM}; run_gemm(lds, H, (const bf16_t*)(ws + WS_WT_SIN), 2048, E); } }
        SEAM(2);
#endif
#if (PHASE_MASK >> 3) & 1
#if defined(PROBE_DUP) && PROBE_DUP == 3
        if (IN(3)) { PH_VARS phase_s5<false>(a, lds); }
        if (IN(3)) xcd_barrier(xbar);
#endif
        if (IN(3)) { PH_VARS phase_s5<false>(a, lds); }
        SEAM(3);
#endif
#if (PHASE_MASK >> 4) & 1
#if defined(PROBE_DUP) && PROBE_DUP == 4
        if (IN(4)) { PH_VARS phase_s5<true>(a, lds); }
        if (IN(4)) xcd_barrier(xbar);
#endif
        if (IN(4)) { PH_VARS phase_s5<true>(a, lds); }
        SEAM(4);
#endif
#if (PHASE_MASK >> 5) & 1
#if defined(PROBE_DUP) && PROBE_DUP == 5
        if (IN(5)) { PH_VARS { pg8::EpiGlu E{a->in[0], XA, mod0 + 2 * DM}; run_gemm(lds, BB, (const bf16_t*)(ws + WS_WT_SOUT), 4096, E); } }
        if (IN(5)) xcd_barrier(xbar);
#endif
        if (IN(5)) { PH_VARS { pg8::EpiGlu E{a->in[0], XA, mod0 + 2 * DM}; run_gemm(lds, BB, (const bf16_t*)(ws + WS_WT_SOUT), 4096, E); } }
        SEAM(5);
#endif
#if defined(PROBE_BAR)
        if (IN(6)) { xcd_barrier(xbar); xcd_barrier(xbar); xcd_barrier(xbar); xcd_barrier(xbar); xcd_barrier(xbar); xcd_barrier(xbar); xcd_barrier(xbar); xcd_barrier(xbar); }
#endif
#if (PHASE_MASK >> 6) & 1
#if defined(PROBE_DUP) && PROBE_DUP == 6
        if (IN(6)) { PH_VARS phase_norm(XA, a->in[5], mod0 + 3 * DM, mod0 + 4 * DM, H); }
        if (IN(6)) xcd_barrier(xbar);
#endif
        if (IN(6)) { PH_VARS phase_norm(XA, a->in[5], mod0 + 3 * DM, mod0 + 4 * DM, H); }
        SEAM(6);
#endif
#if (PHASE_MASK >> 7) & 1
#if defined(PROBE_DUP) && PROBE_DUP == 7
        if (IN(7)) { PH_VARS { pg8::EpiStoreBf16 E{BA, DM}; run_gemm(lds, H, (const bf16_t*)(ws + WS_WT_PQ), 2048, E); } }
        if (IN(7)) xcd_barrier(xbar);
#endif
        if (IN(7)) { PH_VARS { pg8::EpiStoreBf16 E{BA, DM}; run_gemm(lds, H, (const bf16_t*)(ws + WS_WT_PQ), 2048, E); } }
        SEAM(7);
#endif
#if (PHASE_MASK >> 8) & 1
#if defined(PROBE_DUP) && PROBE_DUP == 8
        if (IN(8)) { PH_VARS phase_route(a, 0, lds); }
        if (IN(8)) xcd_barrier(xbar);
#endif
        if (IN(8)) { PH_VARS p0_quant_all(a); phase_route(a, 0, lds); }
        SEAM(8);
#endif
#if (PHASE_MASK >> 9) & 1
#if defined(PROBE_DUP) && PROBE_DUP == 9
        if (IN(9)) { PH_VARS phase_peer(a, 0, 1); }
        if (IN(9)) xcd_barrier(xbar);
#endif
        if (IN(9)) { PH_VARS phase_peer(a, 0, 2); }
        SEAM(9);
#endif
#if (PHASE_MASK >> 10) & 1
        if (IN(10)) { PH_VARS phase_norm(XA, a->in[4] + DM, mod1, mod1 + DM, H); }
        SEAM(10);
#endif
#if (PHASE_MASK >> 11) & 1
#if defined(PROBE_DUP) && PROBE_DUP == 11
        if (IN(11)) { PH_VARS { pg8::EpiNsaIn E{BA, (bf16_t*)(ws + WS_KV), (float*)(ws + WS_GL)}; run_gemm(lds, H, (const bf16_t*)(ws + WS_WT_NIN), 5376, E); } }
        if (IN(11)) xcd_barrier(xbar);
#endif
        if (IN(11)) { PH_VARS { pg8::EpiNsaIn E{BA, (bf16_t*)(ws + WS_KV), (float*)(ws + WS_GL)}; run_gemm(lds, H, (const bf16_t*)(ws + WS_WT_NIN), 5376, E); } }
        SEAM(11);
#endif
#if (PHASE_MASK >> 12) & 1
#if defined(PROBE_DUP) && PROBE_DUP == 12
        if (IN(12)) { PH_VARS phase_cmp(a, lds); }
        if (IN(12)) xcd_barrier(xbar);
#endif
        if (IN(12)) { PH_VARS phase_cmp(a, lds); }
        SEAM(12);
#endif
#if (PHASE_MASK >> 13) & 1
#if defined(PROBE_DUP) && PROBE_DUP == 13
#ifndef ATT_PROBE_SKIP
#define ATT_PROBE_SKIP 0
#endif
        if (IN(13)) { PH_VARS phase_att<ATT_PROBE_SKIP>(a, lds); }
        if (IN(13)) xcd_barrier(xbar);
#endif
        if (IN(13)) { PH_VARS phase_att<0>(a, lds); }
        SEAM(13);
#endif
#if (PHASE_MASK >> 14) & 1
        if (IN(14)) { PH_VARS { pg8::EpiResid E{XA, mod1 + 2 * DM}; run_gemm(lds, BB, (const bf16_t*)(ws + WS_WT_NOUT), 2048, E); } }
        SEAM(14);
#endif
#if (PHASE_MASK >> 15) & 1
#if defined(PROBE_DUP) && PROBE_DUP == 15
        if (IN(15)) { PH_VARS phase_norm(XA, a->in[5] + DM, mod1 + 3 * DM, mod1 + 4 * DM, H); }
        if (IN(15)) xcd_barrier(xbar);
#endif
        if (IN(15)) { PH_VARS phase_norm(XA, a->in[5] + DM, mod1 + 3 * DM, mod1 + 4 * DM, H); }
        SEAM(15);
#endif
#if (PHASE_MASK >> 16) & 1
#if defined(PROBE_DUP) && PROBE_DUP == 16
        if (IN(16)) { PH_VARS { pg8::EpiStoreBf16 E{BA, DM}; run_gemm(lds, H, (const bf16_t*)(ws + WS_WT_PQ) + (size_t)DM * DM, 2048, E); } }
        if (IN(16)) xcd_barrier(xbar);
#endif
        if (IN(16)) { PH_VARS { pg8::EpiStoreBf16 E{BA, DM}; run_gemm(lds, H, (const bf16_t*)(ws + WS_WT_PQ) + (size_t)DM * DM, 2048, E); } }
        SEAM(16);
#endif
#if (PHASE_MASK >> 17) & 1
#if defined(PROBE_DUP) && PROBE_DUP == 17
        if (IN(17)) { PH_VARS phase_route(a, 1, lds); }
        if (IN(17)) xcd_barrier(xbar);
#endif
        if (IN(17)) { PH_VARS phase_route(a, 1, lds); }
        SEAM(17);
#endif
#if (PHASE_MASK >> 18) & 1
#if defined(PROBE_DUP) && PROBE_DUP == 18
        if (IN(18)) { PH_VARS phase_peer(a, 1, 1); }
        if (IN(18)) xcd_barrier(xbar);
#endif
        if (IN(18)) { PH_VARS phase_peer(a, 1, 1); }
        SEAM(18);
#endif
#undef IN
#undef SEAM
}

#ifndef N_LAUNCH_MODE
#define N_LAUNCH_MODE 1
#endif
extern "C" void kernel_launch(void* const* d_in, const int* in_sizes, int n_in, void* d_out, int out_size, void* d_ws, size_t ws_size, hipStream_t stream) {
    static int grid = 0;
    if (grid == 0) {
        if (n_in != 29 || out_size != SEQ * DM || ws_size < WS_END) { fprintf(stderr, "kernel_launch: unexpected problem (n_in %d, out %d, ws %zu < %zu)\n", n_in, out_size, ws_size, (size_t)WS_END); grid = -1; return; }
        int dev = 0, cus = 0, per_cu = 0;
        hipGetDevice(&dev); hipDeviceGetAttribute(&cus, hipDeviceAttributeMultiprocessorCount, dev);
        hipFuncSetAttribute((const void*)fwd_mega, hipFuncAttributeMaxDynamicSharedMemorySize, LDS_BYTES);
        hipOccupancyMaxActiveBlocksPerMultiprocessor(&per_cu, (const void*)fwd_mega, NT, LDS_BYTES);
        if (per_cu < 1) { fprintf(stderr, "kernel_launch: occupancy query says %d workgroups per CU\n", per_cu); per_cu = 1; }
        grid = cus;
        (void)hipGetLastError();
    }
    if (grid < 0) return;
    (void)hipMemsetAsync((unsigned char*)d_ws + WS_BAR, 0, XCD_BAR_WORDS * 4, stream);
    Args a{};
    for (int i = 0; i < 29; ++i) a.in[i] = (const float*)d_in[i];
    a.out = (float*)d_out; a.ws = (unsigned char*)d_ws;
#if N_LAUNCH_MODE == 1
    a.ph_lo = 0; a.ph_hi = N_PHASES - 1;
    { void* args[] = {&a}; hipError_t e = hipLaunchCooperativeKernel((const void*)fwd_mega, dim3(grid), dim3(NT), args, LDS_BYTES, stream);
      if (e != hipSuccess) fprintf(stderr, "cooperative launch failed: %s (grid %d)\n", hipGetErrorString(e), grid); }
#else
    for (int ph = 0; ph < N_PHASES - 1; ++ph) {
        a.ph_lo = ph; a.ph_hi = ph + 1;
        void* args[] = {&a}; hipError_t e = hipLaunchCooperativeKernel((const void*)fwd_mega, dim3(grid), dim3(NT), args, LDS_BYTES, stream);
        if (e != hipSuccess) { fprintf(stderr, "launch of phase %d failed: %s (grid %d)\n", ph, hipGetErrorString(e), grid); break; }
    }
#endif
}
```

```cpp
#define ATT_NG 1
#define Q8_L1ROWS 0
#define GEMM11_WGS 224
#include <hip/hip_runtime.h>
#include <hip/hip_cooperative_groups.h>
#include <cstdio>
#include <cstdint>
namespace cg = cooperative_groups;

#define DI __device__ __forceinline__
#define LAS __attribute__((address_space(3)))
typedef unsigned short bf16_t;
typedef unsigned int u32;
typedef short bf16x8 __attribute__((ext_vector_type(8)));
typedef float f32x4 __attribute__((ext_vector_type(4)));
typedef float f32x16 __attribute__((ext_vector_type(16)));
typedef unsigned u32x4 __attribute__((ext_vector_type(4)));
typedef unsigned u32x2 __attribute__((ext_vector_type(2)));
typedef float f32x2v __attribute__((ext_vector_type(2)));
typedef short s16x2 __attribute__((ext_vector_type(2)));
typedef __bf16 bf16x2_hw __attribute__((ext_vector_type(2)));
DI u32 cvt_pk_bf16_cc(float lo, float hi) { const bf16x2_hw r = __builtin_convertvector((f32x2v){lo, hi}, bf16x2_hw); return __builtin_bit_cast(u32, r); }

constexpr int DM = 2048;
constexpr int SEQ = 16384;
constexpr int NT = 512;
constexpr int LDS_BYTES = 147456;
constexpr int LDS_BARST = LDS_BYTES - 64;

constexpr size_t MB = 1024 * 1024;
constexpr size_t WS_MOD    = 0;
constexpr size_t WS_POSB   = 98304;
constexpr size_t WS_PSC    = 262144;
constexpr size_t WS_BAR    = 524288;
constexpr size_t WS_SEND   = 1 * MB;
constexpr size_t WS_WT_SIN = 2 * MB;
constexpr size_t WS_WT_SOUT= WS_WT_SIN + 8 * MB;
constexpr size_t WS_WT_NIN = WS_WT_SOUT + 16 * MB;
constexpr size_t WS_WT_NOUT= WS_WT_NIN + 21 * MB;
constexpr size_t WS_WT_PQ  = WS_WT_NOUT + 8 * MB;
constexpr size_t WS_SUBK   = WS_WT_PQ + 16 * MB;
constexpr size_t WS_CW1T   = WS_SUBK + 1 * MB;
constexpr size_t WS_PU     = WS_CW1T + 2 * MB;
constexpr size_t WS_PV     = WS_PU + 128 * MB;
constexpr size_t WS_H      = WS_PV + 128 * MB;
constexpr size_t WS_BUFA   = WS_H + 64 * MB;
constexpr size_t WS_BUFB   = WS_BUFA + 64 * MB;
constexpr size_t WS_XA     = WS_BUFB + 64 * MB;
constexpr size_t WS_EXP    = WS_XA + 128 * MB;
constexpr size_t WS_GATE   = WS_EXP + 8 * MB;
constexpr size_t WS_KV     = WS_GATE + 8 * MB;
constexpr size_t WS_GL     = WS_KV + 96 * MB;
constexpr size_t WS_KCMP   = WS_GL + 3 * MB;
constexpr size_t WS_VCMPT  = WS_KCMP + 1 * MB;
constexpr size_t WS_VST    = WS_VCMPT + 1 * MB;
constexpr size_t WS_VWT    = WS_VST + 16 * MB;
constexpr size_t WS_S5BB   = WS_PU + 64 * MB;
constexpr size_t WS_S5CT   = WS_S5BB + 1 * MB;
constexpr size_t WS_PW     = WS_S5CT + 1 * MB;
constexpr size_t WS_PBP    = WS_PW + 8 * MB;
constexpr size_t WS_KS8    = WS_PBP + 1 * MB;
constexpr size_t WS_VST8   = WS_KS8 + 8 * MB;
constexpr size_t WS_END    = WS_VWT + 16 * MB;
constexpr int PEER_ROWB = 1536;
constexpr size_t KV_T      = (size_t)4 * SEQ * 128;

struct Args { const float* in[29]; float* out; unsigned char* ws; int ph_lo, ph_hi; };
typedef const __attribute__((address_space(4))) Args* ArgsP;
DI ArgsP args_fresh(ArgsP p) { asm volatile("" : "+s"(p)); return p; }

DI float bf2f(bf16_t b) { return __uint_as_float(((u32)b) << 16); }
DI float bflo(u32 w) { return __uint_as_float(w << 16); }
DI float bfhi(u32 w) { return __uint_as_float(w & 0xffff0000u); }
DI bf16_t f2bf(float f) { u32 u = __float_as_uint(f); u += 0x7fffu + ((u >> 16) & 1u); return (bf16_t)(u >> 16); }
DI u32 pk_bf16(float lo, float hi) { return (u32)f2bf(lo) | ((u32)f2bf(hi) << 16); }
DI float fast_rcp(float x) { return __builtin_amdgcn_rcpf(x); }
DI float sigmoidf_(float x) { return fast_rcp(1.0f + __expf(-x)); }
DI float gelu_tanh(float x) { const float z = 1.5957691216057308f * (x + 0.044715f * x * x * x); return x * fast_rcp(1.0f + __expf(-z)); }
template <int CTRL> DI float dppf(float v) { return __int_as_float(__builtin_amdgcn_update_dpp(0, __float_as_int(v), CTRL, 0xF, 0xF, false)); }
template <int CTRL> DI int dppi(int v) { return __builtin_amdgcn_update_dpp(0, v, CTRL, 0xF, 0xF, false); }
constexpr int DPP_XOR1 = 0xB1, DPP_XOR2 = 0x4E, DPP_HMIRROR = 0x141, DPP_MIRROR = 0x140;
DI float sum_x16(float v) { const auto r = __builtin_amdgcn_permlane16_swap(__float_as_uint(v), __float_as_uint(v), false, false); return __uint_as_float(r[0]) + __uint_as_float(r[1]); }
DI float sum_x32(float v) { const auto r = __builtin_amdgcn_permlane32_swap(__float_as_uint(v), __float_as_uint(v), false, false); return __uint_as_float(r[0]) + __uint_as_float(r[1]); }
DI float row16_sum(float v) { v += dppf<DPP_XOR1>(v); v += dppf<DPP_XOR2>(v); v += dppf<DPP_HMIRROR>(v); v += dppf<DPP_MIRROR>(v); return v; }
DI float wave_sum(float v) { return sum_x32(sum_x16(row16_sum(v))); }
namespace pg8 {
#define PG8_LAS __attribute__((address_space(3)))
typedef unsigned short bf16_t;
typedef short bf16x8 __attribute__((ext_vector_type(8)));
typedef float f32x4 __attribute__((ext_vector_type(4)));
typedef unsigned u32x4 __attribute__((ext_vector_type(4)));
constexpr int BM = 256, BK = 64, HALF = 128, HTB = HALF * BK * 2  , STAGE_BYTES = 8 * HTB, NXCD = 8, WGM = 8;

__host__ __device__ __forceinline__ int lds_byte(int r, int c) { const int st = (r >> 4) * 2 + (c >> 5), rr = r & 15, cc = c & 31, ob = rr * 64 + cc * 2; return st * 1024 + (ob ^ (((ob >> 9) & 1) << 5)); }
__host__ __device__ __forceinline__ void stage_rc(int b, int& R, int& C) { const int st = b / 1024, sb = b % 1024, swz = sb ^ (((sb >> 9) & 1) << 5); R = (st >> 1) * 16 + swz / 64; C = (st & 1) * 32 + (swz % 64) / 2; }
__host__ __device__ __forceinline__ int perm32(int rho) { const int n = rho >> 4, i = rho & 15; return 8 * (i >> 2) + 4 * n + (i & 3); }

struct Unit { int pm, pn; };
struct Gemm { const bf16_t* A; const bf16_t* Bt; int M, N, K; };

struct StaticOrder {
    int nM, nN, nwg, G, c;
    __host__ __device__ void init(int M, int N, int G_, int c_) { nM = M / BM; nN = N / BM; nwg = nM * nN; G = G_; c = c_; }
    __host__ __device__ bool next(int i, Unit& u) const {
        const long L = (long)i * G + c; if (L >= nwg) return false;
        int wgid = (int)L; { const int q = nwg / NXCD, r = nwg % NXCD, xcd = wgid % NXCD, off = wgid / NXCD; wgid = (xcd < r ? xcd * (q + 1) : r * (q + 1) + (xcd - r) * q) + off; }
        const int nig = WGM * nN, gid = wgid / nig, fm = gid * WGM, gsz = (nM - fm) < WGM ? (nM - fm) : WGM;
        u.pm = fm + ((wgid % nig) % gsz); u.pn = (wgid % nig) / gsz; return true;
    }
    __device__ __forceinline__ void a_ready(const Unit&) const {}
    __device__ __forceinline__ void done(const Unit&) const {}
};
__device__ __forceinline__ unsigned cvt_pk_bf16(float lo, float hi) { return cvt_pk_bf16_cc(lo, hi); }
struct EpiStoreBf16 {
    static constexpr bool PERM = true, AFTER_DRAIN = false;
    bf16_t* O; int ldc;
    __device__ __forceinline__ void operator()(const f32x4 (&acc)[2][2][4][2], const Unit& u, int wr, int wc, int fr, int fq) const {
        const int row0 = u.pm * BM + wr * 64 + fr, col0 = u.pn * BM + wc * 32 + 8 * fq;
#pragma unroll
        for (int ai = 0; ai < 2; ++ai)
#pragma unroll
            for (int m = 0; m < 4; ++m) { bf16_t* rowp = O + (size_t)(row0 + ai * HALF + m * 16) * ldc + col0;
#pragma unroll
                for (int bj = 0; bj < 2; ++bj) { const f32x4 v0 = acc[ai][bj][m][0], v1 = acc[ai][bj][m][1];
                    u32x4 w; w.x = cvt_pk_bf16(v0[0], v0[1]); w.y = cvt_pk_bf16(v0[2], v0[3]); w.z = cvt_pk_bf16(v1[0], v1[1]); w.w = cvt_pk_bf16(v1[2], v1[3]);
                    *(u32x4*)(rowp + bj * HALF) = w; } }
    }
};
struct EpiGlu {
    static constexpr bool PERM = false, AFTER_DRAIN = false;
    const float* xin; float* xout; const float* g1;
    __device__ __forceinline__ void operator()(const f32x4 (&acc)[2][2][4][2], const Unit& u, int wr, int wc, int fr, int fq) const {
        const int row0 = u.pm * BM + wr * 64 + fr, col0 = u.pn * HALF + wc * 32 + 4 * fq;
#pragma unroll
        for (int ai = 0; ai < 2; ++ai)
#pragma unroll
            for (int m = 0; m < 4; ++m) { const size_t ro = (size_t)(row0 + ai * HALF + m * 16) * DM;
#pragma unroll
                for (int n = 0; n < 2; ++n) { const int col = col0 + 16 * n;
                    const f32x4 a = acc[ai][0][m][n], b = acc[ai][1][m][n];
                    const f32x4 xi = *(const f32x4*)(xin + ro + col), gg = *(const f32x4*)(g1 + col);
                    f32x4 o;
#pragma unroll
                    for (int j = 0; j < 4; ++j) o[j] = xi[j] + gg[j] * a[j] * __builtin_amdgcn_rcpf(1.0f + __expf(-b[j]));
                    *(f32x4*)(xout + ro + col) = o; } }
    }
};
struct EpiResid {
    static constexpr bool PERM = false, AFTER_DRAIN = false;
    float* x; const float* g1;
    __device__ __forceinline__ void operator()(const f32x4 (&acc)[2][2][4][2], const Unit& u, int wr, int wc, int fr, int fq) const {
        const int row0 = u.pm * BM + wr * 64 + fr, col0 = u.pn * BM + wc * 32 + 4 * fq;
#pragma unroll
        for (int ai = 0; ai < 2; ++ai)
#pragma unroll
            for (int m = 0; m < 4; ++m) { float* rowp = x + (size_t)(row0 + ai * HALF + m * 16) * DM + col0;
#pragma unroll
                for (int bj = 0; bj < 2; ++bj)
#pragma unroll
                    for (int n = 0; n < 2; ++n) { const f32x4 gg = *(const f32x4*)(g1 + col0 + bj * HALF + n * 16);
                        f32x4 xi = *(const f32x4*)(rowp + bj * HALF + n * 16); xi += gg * acc[ai][bj][m][n]; *(f32x4*)(rowp + bj * HALF + n * 16) = xi; } }
    }
};
struct EpiNsaIn {
    static constexpr bool PERM = true, AFTER_DRAIN = false;
    bf16_t* Q; bf16_t* KV; float* GL;
    __device__ __forceinline__ void operator()(const f32x4 (&acc)[2][2][4][2], const Unit& u, int wr, int wc, int fr, int fq) const {
        const int row0 = u.pm * BM + wr * 64 + fr, lc0 = wc * 32 + 8 * fq;
#pragma unroll
        for (int ai = 0; ai < 2; ++ai)
#pragma unroll
            for (int m = 0; m < 4; ++m) { const int row = row0 + ai * HALF + m * 16;
#pragma unroll
                for (int bj = 0; bj < 2; ++bj) { const f32x4 v0 = acc[ai][bj][m][0], v1 = acc[ai][bj][m][1];
                    if (u.pn < 20) {
                        u32x4 w; w.x = cvt_pk_bf16(v0[0], v0[1]); w.y = cvt_pk_bf16(v0[2], v0[3]); w.z = cvt_pk_bf16(v1[0], v1[1]); w.w = cvt_pk_bf16(v1[2], v1[3]);
                        bf16_t* dst;
                        if (u.pn < 8) dst = Q + (size_t)row * DM + u.pn * BM + bj * HALF + lc0;
                        else { const int tsr = (u.pn - 8) >> 1, c512 = ((u.pn - 8) & 1) * 256 + bj * HALF + lc0, g = c512 >> 7, d = c512 & 127;
                               dst = KV + (size_t)tsr * ((size_t)4 * SEQ * 128) + ((size_t)g * SEQ + row) * 128 + d; }
                        *(u32x4*)dst = w;
                    } else if (bj == 0 && lc0 < 48) {
                        float* dst = GL + (size_t)row * 48 + lc0; f32x4 s0, s1;
#pragma unroll
                        for (int j = 0; j < 4; ++j) { s0[j] = __builtin_amdgcn_rcpf(1.0f + __expf(-v0[j])); s1[j] = __builtin_amdgcn_rcpf(1.0f + __expf(-v1[j])); }
                        *(f32x4*)dst = s0; *(f32x4*)(dst + 4) = s1;
                    } } }
    }
};
template <class Epi, class Sched, bool STAMP = false>
__device__ __forceinline__ void gemm_phase(PG8_LAS unsigned char* lds, const Gemm g, const Sched& S, const Epi& E, unsigned long long* stamps) {
    const int tid = threadIdx.x, wid = __builtin_amdgcn_readfirstlane(tid >> 6), lane = tid & 63, wr = wid >> 2, wc = wid & 3, fr = lane & 15, fq = lane >> 4;
    const int K = g.K, nt = K / BK;
    int ts_lo = 0, ts_hi = 0, nts = 0; const unsigned long long rt_entry = STAMP ? (unsigned long long)wall_clock64() : 0ull;
#define PG8_STAMP() do { if (STAMP && wid == 0 && nts < 64) { const unsigned long long _c = (unsigned long long)clock64(); \
        ts_lo = (lane == nts) ? (int)(unsigned)_c : ts_lo; ts_hi = (lane == nts) ? (int)(unsigned)(_c >> 32) : ts_hi; ++nts; } } while (0)
    PG8_STAMP();
    unsigned voffA[2], voffB[2];
#pragma unroll
    for (int i = 0; i < 2; ++i) { int R, C; stage_rc(tid * 16 + i * 8192, R, C); const int Rb = Epi::PERM ? ((R & ~31) + perm32(R & 31)) : R;
        voffA[i] = (unsigned)(R * K + C) * 2u; voffB[i] = (unsigned)(Rb * K + C) * 2u; }
    const size_t kstep = (size_t)(BK * 2);
    const size_t hstep = (size_t)HALF * K * 2;
    const size_t tstep = 2 * hstep;
    const unsigned ldsw = (unsigned)wid * 1024u;
    const int aoff = lds_byte(wr * 64 + fr, fq * 8), boff = lds_byte(wc * 32 + fr, fq * 8);
#define PG8_SA(b, h) (((b) * 2 + (h)) * HTB)
#define PG8_SB(b, h) ((4 + (b) * 2 + (h)) * HTB)
#define PG8_STAGE(bufoff, gbase, voff) do { _Pragma("unroll") for (int _i = 0; _i < 2; ++_i) \
        __builtin_amdgcn_global_load_lds((const unsigned*)((const char*)(gbase) + (voff)[_i]), (PG8_LAS unsigned*)(lds + (bufoff) + ldsw + _i * 8192), 16, 0, 0); } while (0)
#define PG8_LDA(dst, b, h) do { _Pragma("unroll") for (int m = 0; m < 4; ++m) _Pragma("unroll") for (int k = 0; k < 2; ++k) dst[m][k] = *(const PG8_LAS bf16x8*)(lds + PG8_SA(b, h) + aoff + m * 2048 + k * 1024); } while (0)
#define PG8_LDB(dst, b, h) do { _Pragma("unroll") for (int n = 0; n < 2; ++n) _Pragma("unroll") for (int k = 0; k < 2; ++k) dst[n][k] = *(const PG8_LAS bf16x8*)(lds + PG8_SB(b, h) + boff + n * 2048 + k * 1024); } while (0)
#define PG8_MMA(ai, bj, At, Bt) do { __builtin_amdgcn_s_setprio(1); _Pragma("unroll") for (int m = 0; m < 4; ++m) _Pragma("unroll") for (int n = 0; n < 2; ++n) _Pragma("unroll") for (int k = 0; k < 2; ++k) \
        acc[ai][bj][m][n] = __builtin_amdgcn_mfma_f32_16x16x32_bf16(Bt[n][k], At[m][k], acc[ai][bj][m][n], 0, 0, 0); __builtin_amdgcn_s_setprio(0); } while (0)
#define PG8_WAIT_V(n) asm volatile("s_waitcnt vmcnt(" #n ")" ::: "memory")
#define PG8_WAIT_L(n) asm volatile("s_waitcnt lgkmcnt(" #n ")" ::: "memory")
#define PG8_BAR __builtin_amdgcn_s_barrier()
#define PG8_SCHED __builtin_amdgcn_sched_barrier(0)
    Unit cur, nxt; int ui = 0;
    if (!S.next(0, cur)) return;
    f32x4 acc[2][2][4][2];
#pragma unroll
    for (int a = 0; a < 2; ++a)
#pragma unroll
        for (int b = 0; b < 2; ++b)
#pragma unroll
            for (int m = 0; m < 4; ++m)
#pragma unroll
                for (int n = 0; n < 2; ++n) acc[a][b][m][n] = (f32x4){0.f, 0.f, 0.f, 0.f};
    bf16x8 At[4][2], B0[2][2], B1[2][2];
    const char* cA = (const char*)g.A + (size_t)cur.pm * tstep; const char* cB = (const char*)g.Bt + (size_t)cur.pn * tstep;
    S.a_ready(cur);
    PG8_STAGE(PG8_SB(0, 0), cB, voffB); PG8_STAGE(PG8_SA(0, 0), cA, voffA); PG8_STAGE(PG8_SB(0, 1), cB + hstep, voffB); PG8_STAGE(PG8_SA(0, 1), cA + hstep, voffA);
    if (wr == 1) PG8_BAR;
    PG8_WAIT_V(4); PG8_BAR;
    PG8_STAGE(PG8_SB(1, 0), cB + kstep, voffB); PG8_STAGE(PG8_SA(1, 0), cA + kstep, voffA); PG8_STAGE(PG8_SB(1, 1), cB + hstep + kstep, voffB);
    PG8_WAIT_V(6); PG8_BAR;
    PG8_STAMP();
    for (;;) {
        const bool has_next = S.next(ui + 1, nxt);
        const char* nA = has_next ? (const char*)g.A + (size_t)nxt.pm * tstep : cA; const char* nB = has_next ? (const char*)g.Bt + (size_t)nxt.pn * tstep : cB;
        for (int t = 0; t < nt; t += 2) {
            const bool last = (t == nt - 2);
            const char* a1 = cA + (size_t)(t + 1) * kstep;
            const char* a2 = last ? nA : cA + (size_t)(t + 2) * kstep; const char* b2 = last ? nB : cB + (size_t)(t + 2) * kstep;
            const char* a3 = a2 + kstep; const char* b3 = b2 + kstep;
            if (last && has_next) S.a_ready(nxt);
            PG8_LDB(B0, 0, 0); PG8_SCHED; PG8_LDA(At, 0, 0); PG8_STAGE(PG8_SA(1, 1), a1 + hstep, voffA);
            PG8_WAIT_L(8); PG8_BAR; PG8_WAIT_L(0); PG8_MMA(0, 0, At, B0); PG8_BAR; PG8_SCHED;
            PG8_LDB(B1, 0, 1); PG8_STAGE(PG8_SB(0, 0), b2, voffB);
            PG8_BAR; PG8_WAIT_L(0); PG8_MMA(0, 1, At, B1); PG8_BAR;
            PG8_LDA(At, 0, 1); PG8_STAGE(PG8_SA(0, 0), a2, voffA);
            PG8_BAR; PG8_WAIT_L(0); PG8_MMA(1, 0, At, B0); PG8_BAR; PG8_SCHED;
            PG8_STAGE(PG8_SB(0, 1), b2 + hstep, voffB);
            PG8_WAIT_V(6); PG8_BAR; PG8_MMA(1, 1, At, B1); PG8_BAR;
            PG8_LDB(B0, 1, 0); PG8_SCHED; PG8_LDA(At, 1, 0); PG8_STAGE(PG8_SA(0, 1), a2 + hstep, voffA);
            PG8_WAIT_L(8); PG8_BAR; PG8_WAIT_L(0); PG8_MMA(0, 0, At, B0); PG8_BAR; PG8_SCHED;
            PG8_LDB(B1, 1, 1); PG8_STAGE(PG8_SB(1, 0), b3, voffB);
            PG8_BAR; PG8_WAIT_L(0); PG8_MMA(0, 1, At, B1); PG8_BAR;
            PG8_LDA(At, 1, 1); PG8_STAGE(PG8_SA(1, 0), a3, voffA);
            PG8_BAR; PG8_WAIT_L(0); PG8_MMA(1, 0, At, B0); PG8_BAR; PG8_SCHED;
            PG8_STAGE(PG8_SB(1, 1), b3 + hstep, voffB);
            PG8_WAIT_V(6); PG8_BAR; PG8_MMA(1, 1, At, B1); PG8_BAR;
        }
        PG8_STAMP();
        if constexpr (!Epi::AFTER_DRAIN) { E(acc, cur, wr, wc, fr, fq); S.done(cur); }
        PG8_STAMP();
        if (!has_next) break;
#pragma unroll
        for (int a = 0; a < 2; ++a)
#pragma unroll
            for (int b = 0; b < 2; ++b)
#pragma unroll
                for (int m = 0; m < 4; ++m)
#pragma unroll
                    for (int n = 0; n < 2; ++n) acc[a][b][m][n] = (f32x4){0.f, 0.f, 0.f, 0.f};
        cur = nxt; cA = nA; cB = nB; ++ui;
    }
    PG8_WAIT_V(0);
    if (wr == 0) PG8_BAR;
    PG8_BAR;
    if constexpr (Epi::AFTER_DRAIN) { E.fused(acc, cur, wr, wc, fr, fq, lds, wid, lane); S.done(cur); }
    PG8_STAMP();
    if (STAMP && wid == 0) { stamps[lane] = lane < nts ? (((unsigned long long)(unsigned)ts_hi << 32) | (unsigned)ts_lo) : 0ull;
        if (lane == 62) stamps[62] = rt_entry; if (lane == 63) stamps[63] = (unsigned long long)wall_clock64(); }
#undef PG8_STAMP
#undef PG8_SA
#undef PG8_SB
#undef PG8_STAGE
#undef PG8_LDA
#undef PG8_LDB
#undef PG8_MMA
#undef PG8_WAIT_V
#undef PG8_WAIT_L
#undef PG8_BAR
#undef PG8_SCHED
}
}

#define XB_TMO      128
#define XB_XCNT(j)  (256  + 64 * (j))
#define XB_XSUB(j)  (1280 + 64 * (j))
#define XB_XGEN(j)  (2304 + 64 * (j))
#define XB_TOP      3328
#define XB_TOPGEN   3392
#define XCD_BAR_WORDS 3456
#define XB_SPIN_CAP (1u << 22)

__device__ __forceinline__ unsigned xb_ld(unsigned* p)              { return __hip_atomic_load(p, __ATOMIC_RELAXED, __HIP_MEMORY_SCOPE_AGENT); }
__device__ __forceinline__ unsigned xb_add(unsigned* p, unsigned v) { return __hip_atomic_fetch_add(p, v, __ATOMIC_RELAXED, __HIP_MEMORY_SCOPE_AGENT); }
__device__ __forceinline__ unsigned xb_xcc_id() { return (unsigned)__builtin_amdgcn_s_getreg((3 << 11) | 20) & 0xFu; }
#define XB_SPIN(cond, bar) do { unsigned _sp = 0; while (cond) { __builtin_amdgcn_s_sleep(1); \
    if ((++_sp & 255u) == 0u) { if (xb_ld(&(bar)[XB_TMO])) break; if (_sp > XB_SPIN_CAP) { atomicAdd(&(bar)[XB_TMO], 1u); break; } } } } while (0)

struct XcdBarrier {
    unsigned* bar; unsigned x;
    volatile LAS unsigned* st;
};

__device__ __forceinline__ XcdBarrier xcd_barrier_post(unsigned* bar, volatile LAS unsigned* st) {
    XcdBarrier b; b.bar = bar; b.x = xb_xcc_id(); b.st = st;
    if (threadIdx.x == 0) (void)xb_add(&bar[XB_XCNT(b.x)], 1u);
    return b;
}
__device__ __forceinline__ void xcd_barrier_complete(unsigned* bar, unsigned x, unsigned& nloc, unsigned& nx) {
    const unsigned G = gridDim.x * gridDim.y * gridDim.z;
    unsigned sum, cnt, mine, sp = 0u;
    for (;;) {
        sum = 0u; cnt = 0u; mine = 0u;
#pragma unroll
        for (unsigned j = 0; j < 16; ++j) { const unsigned c = xb_ld(&bar[XB_XCNT(j)]); sum += c; cnt += (c > 0u) ? 1u : 0u; mine = (j == x) ? c : mine; }
        if (sum == G) break;
        __builtin_amdgcn_s_sleep(1);
        if ((++sp & 255u) == 0u) { if (xb_ld(&bar[XB_TMO])) break; if (sp > XB_SPIN_CAP) { atomicAdd(&bar[XB_TMO], 1u); break; } }
    }
    nloc = mine > 0u ? mine : 1u; nx = cnt > 0u ? cnt : 1u;
}

__device__ __forceinline__ void xcd_barrier(const XcdBarrier& b) {
    asm volatile("s_waitcnt vmcnt(0)" ::: "memory");
    __syncthreads();
    if (threadIdx.x == 0) {
        unsigned* bar = b.bar;
        __builtin_amdgcn_s_waitcnt(0);
        unsigned nloc = b.st[0], nx = b.st[1];
        if (nloc == 0u) { xcd_barrier_complete(bar, b.x, nloc, nx); b.st[0] = nloc; b.st[1] = nx; }
        const unsigned old = xb_add(&bar[XB_XSUB(b.x)], 1u);
        const unsigned gen = old / nloc;
        if (old + 1u == (gen + 1u) * nloc) {
            __builtin_amdgcn_fence(__ATOMIC_RELEASE, "agent");
            asm volatile("s_waitcnt vmcnt(0)" ::: "memory");
            const unsigned og = xb_add(&bar[XB_TOP], 1u);
            const unsigned tg = og / nx;
            if (og + 1u == (tg + 1u) * nx) xb_add(&bar[XB_TOPGEN], 1u);
            else XB_SPIN(xb_ld(&bar[XB_TOPGEN]) == tg, bar);
            __builtin_amdgcn_fence(__ATOMIC_ACQUIRE, "agent");
            xb_add(&bar[XB_XGEN(b.x)], 1u);
            asm volatile("s_waitcnt vmcnt(0)" ::: "memory");
        } else {
            XB_SPIN(xb_ld(&bar[XB_XGEN(b.x)]) == gen, bar);
            __builtin_amdgcn_fence(__ATOMIC_ACQUIRE, "agent");
            asm volatile("s_waitcnt vmcnt(0)" ::: "memory");
        }
    }
    __syncthreads();
}

constexpr int P0_GEMV = 768;
constexpr int P0_TR0 = P0_GEMV;
constexpr int P0_TR_TOTAL = 256 + 512 + 672 + 256 + 256 + 256 + 64 + 64;
constexpr int P0_CV0 = P0_TR0 + P0_TR_TOTAL;
constexpr int CV_PU = 0, CV_PV = 0, CV_SK = 64;
constexpr int P0_PB0 = P0_CV0 + CV_PU + CV_PV + CV_SK;
constexpr int P0_S50 = P0_PB0 + 32;
constexpr int P0_TOTAL = P0_S50 + 128;

DI void p0_gemv(ArgsP a, int item, LAS float* sm) {
    const int tid = threadIdx.x, lane = tid & 63, wave = tid >> 6, layer = item / 384, n0 = (item % 384) * 32, col = lane & 31, par = lane >> 5;
    const float* c = a->in[1];
    __syncthreads();
    for (int k = tid; k < DM; k += NT) { const float cv = c[k]; sm[k] = cv / (1.0f + __expf(-cv)); }
    __syncthreads();
    const float* W = a->in[2] + (size_t)layer * DM * 12288 + n0 + col;
    float acc = 0.f;
    const int k0 = wave * 256 + par;
#pragma unroll 1
    for (int kk = 0; kk < 256; kk += 64) {
        float w[32];
#pragma unroll
        for (int j = 0; j < 32; ++j) w[j] = W[(size_t)(k0 + kk + 2 * j) * 12288];
#pragma unroll
        for (int j = 0; j < 32; ++j) acc += sm[k0 + kk + 2 * j] * w[j];
    }
    acc += __shfl_xor(acc, 32);
    if (lane < 32) sm[DM + wave * 32 + lane] = acc;
    __syncthreads();
    if (tid < 32) { float s = 0.f;
#pragma unroll
        for (int w = 0; w < 8; ++w) s += sm[DM + w * 32 + tid];
        ((float*)(a->ws + WS_MOD))[layer * 12288 + n0 + tid] = s + a->in[3][layer * 12288 + n0 + tid]; }
}

DI void p0_transpose(ArgsP a, int idx, LAS float* sm) {
    int mat, base;
    if (idx < 256) { mat = 0; base = 0; } else if (idx < 768) { mat = 1; base = 256; } else if (idx < 1440) { mat = 2; base = 768; } else if (idx < 1696) { mat = 3; base = 1440; }
    else if (idx < 1952) { mat = 4; base = 1696; } else if (idx < 2208) { mat = 5; base = 1952; } else if (idx < 2272) { mat = 6; base = 2208; } else { mat = 7; base = 2272; }
    int N = 2048, K = 2048, Nsrc = 2048; const float* src = nullptr; bf16_t* dst = nullptr;
    switch (mat) {
        case 0: src = a->in[7];  dst = (bf16_t*)(a->ws + WS_WT_SIN);  N = 2048; K = 2048; Nsrc = 2048; break;
        case 1: src = a->in[16]; dst = (bf16_t*)(a->ws + WS_WT_SOUT); N = 4096; K = 2048; Nsrc = 4096; break;
        case 2: src = a->in[17]; dst = (bf16_t*)(a->ws + WS_WT_NIN);  N = 5376; K = 2048; Nsrc = 5168; break;
        case 3: src = a->in[24]; dst = (bf16_t*)(a->ws + WS_WT_NOUT); N = 2048; K = 2048; Nsrc = 2048; break;
        case 4: src = a->in[25]; dst = (bf16_t*)(a->ws + WS_WT_PQ);   N = 2048; K = 2048; Nsrc = 2048; break;
        case 5: src = a->in[25] + (size_t)DM * DM; dst = (bf16_t*)(a->ws + WS_WT_PQ) + (size_t)DM * DM; N = 2048; K = 2048; Nsrc = 2048; break;
        case 6: src = a->in[19]; dst = (bf16_t*)(a->ws + WS_CW1T); N = 128; K = 4096; Nsrc = 128; break;
        default: src = a->in[22]; dst = (bf16_t*)(a->ws + WS_CW1T) + (size_t)128 * 4096; N = 128; K = 4096; Nsrc = 128; break;
    }
    const int li = idx - base, ntn = (N + 255) / 256, nt = li % ntn, kt = li / ntn, k0 = kt * 64, nd0 = nt * 256;
    const int tid = threadIdx.x;
    __syncthreads();
#pragma unroll
    for (int it = 0; it < 8; ++it) {
        const int k = it * 8 + (tid >> 6), nl = (tid & 63) * 4;
        int ns = nd0 + nl;
        if (mat == 1) ns = (nl < 128) ? (128 * nt + nl) : (2048 + 128 * nt + nl - 128);
        f32x4 v = {0.f, 0.f, 0.f, 0.f};
        if (ns < Nsrc) v = *(const f32x4*)(src + (size_t)(k0 + k) * Nsrc + ns);
        LAS float* p = sm + k * 257 + nl; p[0] = v[0]; p[1] = v[1]; p[2] = v[2]; p[3] = v[3];
    }
    __syncthreads();
#pragma unroll
    for (int it = 0; it < 4; ++it) {
        const int c = it * 512 + tid, nl = c >> 3, k8 = (c & 7) * 8;
        if (nd0 + nl < N) {
            u32x4 w;
            w.x = pk_bf16(sm[(k8 + 0) * 257 + nl], sm[(k8 + 1) * 257 + nl]); w.y = pk_bf16(sm[(k8 + 2) * 257 + nl], sm[(k8 + 3) * 257 + nl]);
            w.z = pk_bf16(sm[(k8 + 4) * 257 + nl], sm[(k8 + 5) * 257 + nl]); w.w = pk_bf16(sm[(k8 + 6) * 257 + nl], sm[(k8 + 7) * 257 + nl]);
            *(u32x4*)(dst + (size_t)(nd0 + nl) * K + k0 + k8) = w;
        }
    }
}

DI void p0_convert(const float* src, bf16_t* dst, int item) {
    const size_t e0 = (size_t)item * 8192 + (size_t)threadIdx.x * 8;
#pragma unroll
    for (int h = 0; h < 2; ++h) {
        const size_t e = e0 + (size_t)h * 4096;
        const f32x4 v0 = *(const f32x4*)(src + e), v1 = *(const f32x4*)(src + e + 4);
        u32x4 w; w.x = pk_bf16(v0[0], v0[1]); w.y = pk_bf16(v0[2], v0[3]); w.z = pk_bf16(v1[0], v1[1]); w.w = pk_bf16(v1[2], v1[3]);
        *(u32x4*)(dst + e) = w;
    }
}

DI u32 fp6_e2m3(float x) {
    const u32 b = __float_as_uint(x), sgn = (b >> 26) & 0x20u; const float ax = fabsf(x);
    const u32 ab = b & 0x7fffffffu;
    const u32 nrm = ((ab + 0x7ffffu + ((ab >> 20) & 1u)) >> 20) - ((127u - 1u) << 3);
    const u32 sub = (u32)__float2int_rn(ax * 8.0f);
    u32 c = (ax < 1.0f) ? sub : nrm; c = c > 31u ? 31u : c;
    return sgn | c;
}
DI void p0_quant_load(f32x4 (&v)[8], const float* src, int row, int lane) {
    const float* sp = src + (size_t)row * DM + 4 * lane;
#pragma unroll
    for (int j = 0; j < 8; ++j) v[j] = *(const f32x4*)(sp + 256 * j);
}
typedef unsigned u32x6 __attribute__((ext_vector_type(6)));
#ifndef FP6_PACK_SEQ
#define FP6_PACK_SEQ 0
#endif
DI void p0_quant_emit(const f32x4 (&v)[8], unsigned char* dst, float* inv_scale, int row, int lane) {
    float mx = 0.f;
#pragma unroll
    for (int j = 0; j < 8; ++j) mx = fmaxf(mx, fmaxf(fmaxf(fabsf(v[j][0]), fabsf(v[j][1])), fmaxf(fabsf(v[j][2]), fabsf(v[j][3]))));
#pragma unroll
    for (int o = 32; o >= 1; o >>= 1) mx = fmaxf(mx, __shfl_xor(mx, o));
    const float sc = (mx > 0.f) ? 7.5f / mx : 1.0f;
    f32x16 s0, s1;
#pragma unroll
    for (int j = 0; j < 16; ++j) {
        const int e0 = FP6_PACK_SEQ ? j : 2 * j, e1 = FP6_PACK_SEQ ? 16 + j : 2 * j + 1;
        s0[j] = v[e0 >> 2][e0 & 3] * sc; s1[j] = v[e1 >> 2][e1 & 3] * sc; }
    const u32x6 pk = __builtin_amdgcn_cvt_scalef32_2xpk16_fp6_f32(s0, s1, 1.0f);
    u32x2* dp = (u32x2*)(dst + (size_t)row * PEER_ROWB + lane * 24);
    dp[0] = (u32x2){pk[0], pk[1]}; dp[1] = (u32x2){pk[2], pk[3]}; dp[2] = (u32x2){pk[4], pk[5]};
    if (lane == 0) inv_scale[row] = (mx > 0.f) ? mx * (1.0f / 7.5f) : 1.0f;
}
DI void p0_quant_rows(ArgsP a, int r_lo, int r_hi, int wv, int nwv) {
    const int lane = threadIdx.x & 63;
#pragma unroll 1
    for (int tb = 0; tb < 2; ++tb) {
        const float* src = a->in[27 + tb]; unsigned char* dst = a->ws + (tb ? WS_PV : WS_PU); float* isc = (float*)(a->ws + WS_PSC) + tb * 2 * 16384;
        const int per = (r_hi - r_lo + nwv - 1) / nwv, r0 = r_lo + wv * per, rend = (r0 + per < r_hi) ? (r0 + per) : r_hi;
#pragma unroll 1
        for (int row = r0; row < rend; row += 4) {
            f32x4 v0[8], v1[8], v2[8], v3[8];
            p0_quant_load(v0, src, row, lane);
            if (row + 1 < rend) p0_quant_load(v1, src, row + 1, lane);
            if (row + 2 < rend) p0_quant_load(v2, src, row + 2, lane);
            if (row + 3 < rend) p0_quant_load(v3, src, row + 3, lane);
            p0_quant_emit(v0, dst, isc, row, lane);
            if (row + 1 < rend) p0_quant_emit(v1, dst, isc, row + 1, lane);
            if (row + 2 < rend) p0_quant_emit(v2, dst, isc, row + 2, lane);
            if (row + 3 < rend) p0_quant_emit(v3, dst, isc, row + 3, lane);
        }
    }
}
DI void p0_quant_all(ArgsP a) { p0_quant_rows(a, 0, 32768, blockIdx.x * 8 + (threadIdx.x >> 6), gridDim.x * 8); }

DI void p0_posb(ArgsP a, int item, LAS float* sm) {
    const int kv = item >> 4, sl = item & 15;
    const float* pos = a->in[kv ? 21 : 18]; const float* w1 = a->in[kv ? 22 : 19];
    const int tid = threadIdx.x, h = tid & 127, part = tid >> 7, i0 = sl * 256 + part * 64;
    float acc0 = 0.f, acc1 = 0.f, acc2 = 0.f, acc3 = 0.f;
#pragma unroll 4
    for (int i = 0; i < 64; i += 4) {
        acc0 += pos[i0 + i] * w1[(size_t)(i0 + i) * 128 + h];         acc1 += pos[i0 + i + 1] * w1[(size_t)(i0 + i + 1) * 128 + h];
        acc2 += pos[i0 + i + 2] * w1[(size_t)(i0 + i + 2) * 128 + h]; acc3 += pos[i0 + i + 3] * w1[(size_t)(i0 + i + 3) * 128 + h]; }
    __syncthreads();
    sm[tid] = (acc0 + acc1) + (acc2 + acc3); __syncthreads();
    if (tid < 128) ((float*)(a->ws + WS_PBP))[(kv * 16 + sl) * 128 + tid] = (sm[tid] + sm[tid + 128]) + (sm[tid + 256] + sm[tid + 384]);
}

DI void p0_s5tab(ArgsP a, int g);
template <int ONLY> DI void phase_prep(ArgsP a, LAS unsigned char* lds) {
    LAS float* sm = (LAS float*)lds;
    for (int item = blockIdx.x; item < P0_TOTAL; item += gridDim.x) {
        if (ONLY == 1 && item >= P0_GEMV) break;
        if (ONLY == 2 && (item < P0_GEMV || item >= P0_CV0)) continue;
        if (ONLY == 3) break;
        if (item < P0_GEMV) p0_gemv(a, item, sm);
        else if (item < P0_CV0) p0_transpose(a, item - P0_TR0, sm);
        else if (item < P0_PB0) p0_convert(a->in[26], (bf16_t*)(a->ws + WS_SUBK), item - P0_CV0 - CV_PU - CV_PV);
        else if (item < P0_S50) p0_posb(a, item - P0_PB0, sm);
        else p0_s5tab(a, item - P0_S50);
    }
    if (ONLY == 3) p0_quant_all(a);
}

DI void phase_norm(const float* x, const float* gamma, const float* shift, const float* scale, bf16_t* H) {
    const int lane = threadIdx.x & 63, wave = threadIdx.x >> 6;
    for (int row = blockIdx.x * 8 + wave; row < SEQ; row += gridDim.x * 8) {
        const float* xr = x + (size_t)row * DM;
        f32x4 v[8]; float ss = 0.f;
#pragma unroll
        for (int j = 0; j < 8; ++j) { v[j] = *(const f32x4*)(xr + 4 * lane + 256 * j); ss += v[j][0] * v[j][0] + v[j][1] * v[j][1] + v[j][2] * v[j][2] + v[j][3] * v[j][3]; }
        ss = wave_sum(ss);
        const float rstd = rsqrtf(ss * (1.0f / DM) + 1e-6f);
#pragma unroll
        for (int j = 0; j < 8; ++j) {
            const int col = 4 * lane + 256 * j;
            const f32x4 g = *(const f32x4*)(gamma + col), sc = *(const f32x4*)(scale + col), sh = *(const f32x4*)(shift + col);
            float o[4];
#pragma unroll
            for (int i = 0; i < 4; ++i) o[i] = (v[j][i] * rstd * g[i]) * (1.0f + sc[i]) + sh[i];
            u32x2 w; w.x = pk_bf16(o[0], o[1]); w.y = pk_bf16(o[2], o[3]);
            *(u32x2*)(H + (size_t)row * DM + col) = w;
        }
    }
}

DI void s5_abar(ArgsP a, int g, int n, float& ar, float& ai, float& cr, float& ci) {
    const float lre = a->in[8][g * 64 + n], lim = a->in[9][g * 64 + n], dt = expf(a->in[10][g]);
    const float mag = expf(lre * dt); ar = mag * cosf(lim * dt); ai = mag * sinf(lim * dt);
    const float den = lre * lre + lim * lim;
    cr = ((ar - 1.0f) * lre + ai * lim) / den; ci = (ai * lre - (ar - 1.0f) * lim) / den;
}
DI void p0_s5tab(ArgsP a, int g) {
    const int tid = threadIdx.x;
    { const int c = tid >> 2, p0 = (tid & 3) * 4, n = c & 63, part = c >> 6;
      float ar, ai, cr, ci; s5_abar(a, g, n, ar, ai, cr, ci);
      const float* br = a->in[11] + (size_t)(g * 64 + n) * 16 + p0; const float* bi = a->in[12] + (size_t)(g * 64 + n) * 16 + p0;
      float v[4];
#pragma unroll
      for (int j = 0; j < 4; ++j) v[j] = part ? (cr * bi[j] + ci * br[j]) : (cr * br[j] - ci * bi[j]);
      *(u32x2*)((bf16_t*)(a->ws + WS_S5BB) + ((size_t)(g * 128 + c) * 16 + p0)) = (u32x2){pk_bf16(v[0], v[1]), pk_bf16(v[2], v[3])}; }
    { const int p = tid >> 5, k0 = (tid & 31) * 4;
      const float* cre = a->in[13] + (size_t)(g * 16 + p) * 64 + (k0 >> 1); const float* cim = a->in[14] + (size_t)(g * 16 + p) * 64 + (k0 >> 1);
      *(u32x2*)((bf16_t*)(a->ws + WS_S5CT) + ((size_t)(g * 16 + p) * 128 + k0)) = (u32x2){pk_bf16(cre[0], -cim[0]), pk_bf16(cre[1], -cim[1])}; }
}
template <bool FULL> DI void phase_s5(ArgsP a, LAS unsigned char* lds) {
    const int tid = threadIdx.x, lane = tid & 63, wave = tid >> 6, ln = lane & 15, q = lane >> 4;
    const bf16_t* U = (const bf16_t*)(a->ws + WS_BUFA);
    bf16_t* YG = (bf16_t*)(a->ws + WS_BUFB);
    float* Send = (float*)(a->ws + WS_SEND);
    const bf16_t* BBt = (const bf16_t*)(a->ws + WS_S5BB); const bf16_t* CT = (const bf16_t*)(a->ws + WS_S5CT);
    LAS float* BU = (LAS float*)(lds + wave * 12544);
    LAS unsigned char* HB = lds + wave * 12544 + 8192;
    const bf16x8 zero8 = {0, 0, 0, 0, 0, 0, 0, 0};
    for (int bi = blockIdx.x; bi < 256; bi += gridDim.x) {
        const int g = bi >> 1, c = (bi & 1) * 8 + wave;
        if (!FULL && c == 15) continue;
        float ar, ai, cr_, ci_; s5_abar(a, g, lane, ar, ai, cr_, ci_);
        bf16x8 bb[8];
#pragma unroll
        for (int ct = 0; ct < 8; ++ct) bb[ct] = (q < 2) ? *(const bf16x8*)(BBt + ((size_t)(g * 128 + 16 * ct + ln) * 16 + 8 * q)) : zero8;
        bf16x8 cf[4]; float dsk = 0.f;
        if (FULL) {
#pragma unroll
            for (int ks = 0; ks < 4; ++ks) cf[ks] = *(const bf16x8*)(CT + ((size_t)(g * 16 + ln) * 128 + 32 * ks + 8 * q));
            dsk = a->in[15][g * 16 + ln];
        }
        float hr = 0.f, hi = 0.f;
        if (FULL) { float tr = ar, ti = ai;
#pragma unroll
            for (int s = 0; s < 10; ++s) { const float nr = tr * tr - ti * ti, ni = 2.0f * tr * ti; tr = nr; ti = ni; }
#pragma unroll
            for (int cc = 0; cc < 15; ++cc) { const bool on = (cc < c);
                const f32x2v sv = on ? *(const f32x2v*)(Send + ((size_t)(cc * 128 + g) * 64 + lane) * 2) : (f32x2v){0.f, 0.f};
                const float nr = tr * hr - ti * hi + sv.x, ni = tr * hi + ti * hr + sv.y; hr = on ? nr : hr; hi = on ? ni : hi; } }
        const bf16_t* up = U + (size_t)c * 1024 * DM + g * 16;
        bf16_t* yp = YG + (size_t)c * 1024 * DM + g * 16;
#pragma unroll 1
        for (int t0 = 0; t0 < 1024; t0 += 16) {
            const bf16x8 af = (q < 2) ? *(const bf16x8*)(up + (size_t)(t0 + ln) * DM + 8 * q) : zero8;
            bf16_t uraw[4];
            if (FULL) {
#pragma unroll
                for (int i = 0; i < 4; ++i) uraw[i] = up[(size_t)(t0 + 4 * q + i) * DM + ln]; }
            f32x4 acc[8];
#pragma unroll
            for (int ct = 0; ct < 8; ++ct) acc[ct] = __builtin_amdgcn_mfma_f32_16x16x32_bf16(af, bb[ct], (f32x4){0.f, 0.f, 0.f, 0.f}, 0, 0, 0);
            asm volatile("" :: "v"(af));
#pragma unroll
            for (int ct = 0; ct < 4; ++ct)
#pragma unroll
                for (int i = 0; i < 4; ++i) *(LAS f32x2v*)(BU + ((4 * q + i) * 64 + 16 * ct + ln) * 2) = (f32x2v){acc[ct][i], acc[ct + 4][i]};
            asm volatile("s_waitcnt lgkmcnt(0)" ::: "memory");
#pragma unroll
            for (int tl = 0; tl < 16; ++tl) {
                const f32x2v b = *(const LAS f32x2v*)(BU + (tl * 64 + lane) * 2);
                const float nr = ar * hr - ai * hi + b.x, ni = ar * hi + ai * hr + b.y; hr = nr; hi = ni;
                if (FULL) *(LAS s16x2*)(HB + tl * 272 + lane * 4) = __builtin_bit_cast(s16x2, pk_bf16(hr, hi));
            }
            asm volatile("s_waitcnt lgkmcnt(0)" ::: "memory");
            if (FULL) {
                f32x4 y = {0.f, 0.f, 0.f, 0.f};
#pragma unroll
                for (int ks = 0; ks < 4; ++ks) { const bf16x8 ah = *(const LAS bf16x8*)(HB + ln * 272 + (32 * ks + 8 * q) * 2); y = __builtin_amdgcn_mfma_f32_16x16x32_bf16(ah, cf[ks], y, 0, 0, 0); asm volatile("" :: "v"(ah)); }
#pragma unroll
                for (int i = 0; i < 4; ++i) { const size_t o = (size_t)(t0 + 4 * q + i) * DM + ln; const float uv = bf2f(uraw[i]); yp[o] = f2bf(gelu_tanh(y[i] + dsk * uv)); }
                asm volatile("s_waitcnt lgkmcnt(0)" ::: "memory");
            }
        }
        if (!FULL) { Send[((size_t)(c * 128 + g) * 64 + lane) * 2] = hr; Send[((size_t)(c * 128 + g) * 64 + lane) * 2 + 1] = hi; }
    }
}

DI int imax3(int a, int b, int c) { return max(max(a, b), c); }
template <int N> DI int imax_tree(const int (&k)[N]) {
    if constexpr (N == 1) return k[0];
    else if constexpr (N == 2) return max(k[0], k[1]);
    else { constexpr int M = (N + 2) / 3; int t[M];
#pragma unroll
        for (int i = 0; i < M; ++i) { const int a = k[3 * i], b = (3 * i + 1 < N) ? k[3 * i + 1] : a, c = (3 * i + 2 < N) ? k[3 * i + 2] : a; t[i] = imax3(a, b, c); }
        return imax_tree<M>(t); }
}
DI void ce_desc(int& a, int& b) { const int hi = max(a, b), lo = min(a, b); a = hi; b = lo; }
DI void bitonic_merge16_desc(int (&v)[16]) {
#pragma unroll
    for (int j = 8; j > 0; j >>= 1)
#pragma unroll
        for (int i = 0; i < 16; ++i) if ((i & j) == 0) ce_desc(v[i], v[i | j]);
}
DI void sort16_desc(int (&v)[16]) {
#pragma unroll
    for (int k = 2; k <= 16; k <<= 1)
#pragma unroll
        for (int j = k >> 1; j > 0; j >>= 1)
#pragma unroll
            for (int i = 0; i < 16; ++i) { const int l = i ^ j;
                if (l > i) { if ((i & k) == 0 || k == 16) ce_desc(v[i], v[l]); else ce_desc(v[l], v[i]); } }
}
DI void top16_of_two(int (&a)[16], const int (&b)[16]) {
#pragma unroll
    for (int i = 0; i < 16; ++i) a[i] = max(a[i], b[15 - i]);
    bitonic_merge16_desc(a);
}
DI int ord_key(float f) { int b = __float_as_int(f); return b ^ ((b >> 31) & 0x7fffffff); }
DI float ord_val(int k) { return __int_as_float(k ^ ((k >> 31) & 0x7fffffff)); }

DI void phase_route(ArgsP a, int layer, LAS unsigned char* lds) {
    const int tid = threadIdx.x, lane = tid & 63, wave = tid >> 6, l32 = lane & 31, hf = lane >> 5;
    const bf16_t* Q = (const bf16_t*)(a->ws + WS_BUFA);
    const bf16_t* SK = (const bf16_t*)(a->ws + WS_SUBK) + (size_t)layer * 8 * 2 * 128 * 128;
    int* EXPv = (int*)(a->ws + WS_EXP); float* GATE = (float*)(a->ws + WS_GATE);
    LAS unsigned char* skl = lds;
    LAS int* top = (LAS int*)(lds + 69632 + wave * 8192);
    for (int item = blockIdx.x; item < 512; item += gridDim.x) {
        const int h = item & 7, tg = item >> 3, tt = tg * 8 + wave, t0 = tt * 32;
        __syncthreads();
#pragma unroll
        for (int it = 0; it < 8; ++it) { const int c16 = it * 512 + tid, row = c16 >> 4, ch = c16 & 15;
            *(LAS u32x4*)(skl + row * 272 + ch * 16) = *(const u32x4*)(SK + ((size_t)h * 256 + row) * 128 + ch * 8); }
        __syncthreads();
        int k1[16], k2[16];
#pragma unroll 1
        for (int c = 0; c < 2; ++c) {
            f32x16 acc[4];
#pragma unroll
            for (int kt = 0; kt < 4; ++kt)
#pragma unroll
                for (int i = 0; i < 16; ++i) acc[kt][i] = 0.f;
            const bf16_t* qp = Q + (size_t)(t0 + l32) * DM + h * 256 + c * 128 + hf * 8;
            const LAS unsigned char* kp = skl + (c * 128 + l32) * 272 + hf * 16;
#pragma unroll
            for (int ks = 0; ks < 8; ++ks) {
                const bf16x8 bq = *(const bf16x8*)(qp + ks * 16);
#pragma unroll
                for (int kt = 0; kt < 4; ++kt) { const bf16x8 ak = *(const LAS bf16x8*)(kp + kt * 32 * 272 + ks * 32); acc[kt] = __builtin_amdgcn_mfma_f32_32x32x16_bf16(ak, bq, acc[kt], 0, 0, 0); }
            }
            int g0[16], g1[16], g2[16], g3[16];
#pragma unroll
            for (int i = 0; i < 16; ++i) { const int kb_ = 8 * (i >> 2) + (i & 3) + 4 * hf;
                g0[i] = (ord_key(acc[0][i]) & ~127) | (127 - (kb_));      g1[i] = (ord_key(acc[1][i]) & ~127) | (127 - (32 + kb_));
                g2[i] = (ord_key(acc[2][i]) & ~127) | (127 - (64 + kb_)); g3[i] = (ord_key(acc[3][i]) & ~127) | (127 - (96 + kb_)); }
            sort16_desc(g0); sort16_desc(g1); sort16_desc(g2); sort16_desc(g3);
            top16_of_two(g0, g1); top16_of_two(g2, g3); top16_of_two(g0, g2);
            int pr[16];
#pragma unroll
            for (int i = 0; i < 16; ++i) pr[i] = __shfl_xor(g0[i], 32);
            top16_of_two(g0, pr);
#pragma unroll
            for (int i = 0; i < 16; ++i) { if (c == 0) k1[i] = g0[i]; else k2[i] = g0[i]; }
        }
        int ck[50], ce[50];
        {
            int n = 0;
#pragma unroll
            for (int aa = 0; aa < 16; ++aa)
#pragma unroll
                for (int bb = 0; bb < 16; ++bb)
                    if ((aa + 1) * (bb + 1) <= 16) {
                        const float s = ord_val(k1[aa] & ~127) + ord_val(k2[bb] & ~127);
                        ck[n] = (ord_key(s) & ~63) | (63 - n);
                        ce[n] = (127 - (k1[aa] & 127)) * 128 + (127 - (k2[bb] & 127));
                        ++n;
                    }
        }
#pragma unroll 1
        for (int r = 0; r < 16; ++r) {
            const int m = imax_tree<50>(ck);
            int e = 0;
#pragma unroll
            for (int i = 0; i < 50; ++i) { const bool hit = (ck[i] == m); e = hit ? ce[i] : e; ck[i] = hit ? (int)0x80000000 : ck[i]; }
            if (hf == 0) { top[1024 + (l32 * 16 + r) * 2] = m & ~63; top[1024 + (l32 * 16 + r) * 2 + 1] = e; }
        }
        if (hf == 0) {
            float sv[16]; int ev[16]; float mx = -3.0e38f;
#pragma unroll
            for (int i = 0; i < 16; ++i) { sv[i] = ord_val(top[1024 + (l32 * 16 + i) * 2]); ev[i] = top[1024 + (l32 * 16 + i) * 2 + 1]; mx = fmaxf(mx, sv[i]); }
            float sum = 0.f;
#pragma unroll
            for (int i = 0; i < 16; ++i) { sv[i] = __expf(sv[i] - mx); sum += sv[i]; }
            const float inv = 1.0f / sum;
            int* ep = EXPv + (size_t)(t0 + l32) * 128 + h * 16; float* gp = GATE + (size_t)(t0 + l32) * 128 + h * 16;
#pragma unroll
            for (int i = 0; i < 16; i += 4) { *(f32x4*)(gp + i) = (f32x4){sv[i] * inv, sv[i + 1] * inv, sv[i + 2] * inv, sv[i + 3] * inv};
                *(u32x4*)(ep + i) = (u32x4){(u32)ev[i], (u32)ev[i + 1], (u32)ev[i + 2], (u32)ev[i + 3]}; }
        }
    }
}

typedef float f32x32 __attribute__((ext_vector_type(32)));
typedef int i32x6 __attribute__((ext_vector_type(6)));
constexpr int PEER_B = 4;
DI void phase_peer(ArgsP a, int layer, int mode) {
    const int lane = threadIdx.x & 63, wave = threadIdx.x >> 6;
    const bf16_t* H = (const bf16_t*)(a->ws + WS_H);
    const unsigned char* PU = a->ws + WS_PU + (size_t)layer * SEQ * PEER_ROWB;
    const unsigned char* PV = a->ws + WS_PV + (size_t)layer * SEQ * PEER_ROWB;
    const float* SCU = (const float*)(a->ws + WS_PSC) + layer * 16384; const float* SCV = SCU + 2 * 16384;
    const int* EXPv = (const int*)(a->ws + WS_EXP); const float* GATE = (const float*)(a->ws + WS_GATE);
    float* XA = (float*)(a->ws + WS_XA);
    const float* g2 = (const float*)(a->ws + WS_MOD) + layer * 12288 + 5 * DM;
    for (int t = blockIdx.x * 8 + wave; t < SEQ; t += gridDim.x * 8) {
        float hf[32];
#pragma unroll
        for (int j = 0; j < 8; ++j) { const u32x2 h0 = *(const u32x2*)(H + (size_t)t * DM + 256 * j + 4 * lane);
            hf[4 * j] = bflo(h0.x); hf[4 * j + 1] = bfhi(h0.x); hf[4 * j + 2] = bflo(h0.y); hf[4 * j + 3] = bfhi(h0.y); }
        const int e_lo = EXPv[(size_t)t * 128 + lane], e_hi = EXPv[(size_t)t * 128 + 64 + lane];
        const float g_lo = GATE[(size_t)t * 128 + lane], g_hi = GATE[(size_t)t * 128 + 64 + lane];
        float y[32];
#pragma unroll
        for (int i = 0; i < 32; ++i) y[i] = 0.f;
#pragma unroll 1
        for (int kb = 0; kb < 128; kb += PEER_B) {
            u32x2 ur[PEER_B][3], vr[PEER_B][3]; float gk[PEER_B], su[PEER_B], sv[PEER_B];
#pragma unroll
            for (int k = 0; k < PEER_B; ++k) {
                const int kk = kb + k;
                const int e = (kk < 64) ? __builtin_amdgcn_readlane(e_lo, kk & 63) : __builtin_amdgcn_readlane(e_hi, kk & 63);
                gk[k] = __int_as_float((kk < 64) ? __builtin_amdgcn_readlane(__float_as_int(g_lo), kk & 63) : __builtin_amdgcn_readlane(__float_as_int(g_hi), kk & 63));
                const unsigned char* up = PU + (size_t)e * PEER_ROWB + 24 * lane; const unsigned char* vp = PV + (size_t)e * PEER_ROWB + 24 * lane;
#pragma unroll
                for (int j = 0; j < 3; ++j) { ur[k][j] = *(const u32x2*)(up + 8 * j); vr[k][j] = *(const u32x2*)(vp + 8 * j); }
                su[k] = SCU[e]; sv[k] = SCV[e];
            }
            float d[PEER_B];
#pragma unroll
            for (int k = 0; k < PEER_B; ++k) {
                const i32x6 pk = {(int)ur[k][0].x, (int)ur[k][0].y, (int)ur[k][1].x, (int)ur[k][1].y, (int)ur[k][2].x, (int)ur[k][2].y};
                const f32x32 uf = __builtin_amdgcn_cvt_scalef32_pk32_f32_fp6(pk, 1.0f);
                float s0 = 0.f, s1 = 0.f;
#pragma unroll
                for (int i = 0; i < 32; i += 2) { s0 += uf[i] * hf[i]; s1 += uf[i + 1] * hf[i + 1]; }
                d[k] = s0 + s1; __builtin_amdgcn_sched_barrier(0); }
#pragma unroll
            for (int k = 0; k < PEER_B; ++k) d[k] = wave_sum(d[k]);
#pragma unroll
            for (int k = 0; k < PEER_B; ++k) {
                const float wk = gk[k] * gelu_tanh(d[k] * su[k]) * sv[k];
                const i32x6 pk = {(int)vr[k][0].x, (int)vr[k][0].y, (int)vr[k][1].x, (int)vr[k][1].y, (int)vr[k][2].x, (int)vr[k][2].y};
                const f32x32 vf = __builtin_amdgcn_cvt_scalef32_pk32_f32_fp6(pk, 1.0f);
#pragma unroll
                for (int i = 0; i < 32; ++i) y[i] += wk * vf[i];
                __builtin_amdgcn_sched_barrier(0);
            }
        }
        float ss = 0.f;
        int lane_e = lane; asm volatile("" : "+v"(lane_e));
#pragma unroll
        for (int w = 0; w < 8; ++w) { const int col = 256 * w + 4 * lane_e;
            const f32x4 x0 = *(const f32x4*)(XA + (size_t)t * DM + col), q0 = *(const f32x4*)(g2 + col);
#pragma unroll
            for (int i = 0; i < 4; ++i) { const float v = x0[i] + q0[i] * y[4 * w + i]; y[4 * w + i] = v; ss += v * v; } }
        if (mode != 1) {
#pragma unroll
            for (int w = 0; w < 8; ++w) { const int col = 256 * w + 4 * lane_e;
                *(f32x4*)(XA + (size_t)t * DM + col) = (f32x4){y[4 * w], y[4 * w + 1], y[4 * w + 2], y[4 * w + 3]}; }
            if (mode == 2) {
                ss = wave_sum(ss);
                const float rstd = rsqrtf(ss * (1.0f / DM) + 1e-6f);
                const float* gam = a->in[4] + (layer + 1) * DM; const float* modn = (const float*)(a->ws + WS_MOD) + (layer + 1) * 12288;
                bf16_t* Hw = (bf16_t*)(a->ws + WS_H);
#pragma unroll
                for (int w = 0; w < 8; ++w) { const int col = 256 * w + 4 * lane_e;
                    const f32x4 gg = *(const f32x4*)(gam + col), sh = *(const f32x4*)(modn + col), sc = *(const f32x4*)(modn + DM + col);
                    float o[4];
#pragma unroll
                    for (int i = 0; i < 4; ++i) o[i] = (y[4 * w + i] * rstd * gg[i]) * (1.0f + sc[i]) + sh[i];
                    *(u32x2*)(Hw + (size_t)t * DM + col) = (u32x2){pk_bf16(o[0], o[1]), pk_bf16(o[2], o[3])};
                    if (w & 1) __builtin_amdgcn_sched_barrier(0); }
            }
        } else {
            ss = wave_sum(ss);
            const float rstd = rsqrtf(ss * (1.0f / DM) + 1e-6f);
            const float* nf = a->in[6];
#pragma unroll
            for (int w = 0; w < 8; ++w) { const int col = 256 * w + 4 * lane_e; const f32x4 n0 = *(const f32x4*)(nf + col);
                *(f32x4*)(a->out + (size_t)t * DM + col) = (f32x4){y[4 * w] * rstd * n0[0], y[4 * w + 1] * rstd * n0[1], y[4 * w + 2] * rstd * n0[2], y[4 * w + 3] * rstd * n0[3]}; }
        }
    }
}

DI void cmp_item(ArgsP a, int id, LAS unsigned char* lds) {
    const int tid = threadIdx.x, lane = tid & 63, wave = tid >> 6, l32 = lane & 31, hf = lane >> 5;
    const int kv = id >> 7, g = (id >> 5) & 3, ntile = id & 31;
    const bf16_t* KVb = (const bf16_t*)(a->ws + WS_KV) + (size_t)kv * KV_T + (size_t)g * SEQ * 128;
    const bf16_t* W1T = (const bf16_t*)(a->ws + WS_CW1T) + (size_t)kv * 128 * 4096;
    int rowA = 32 * ntile + l32; rowA = rowA > 1022 ? 1022 : rowA;
    const bf16_t* ap = KVb + (size_t)16 * rowA * 128 + wave * 512 + hf * 8;
    const bf16_t* bp = W1T + (size_t)l32 * 4096 + wave * 512 + hf * 8;
    f32x16 acc[4];
#pragma unroll
    for (int ht = 0; ht < 4; ++ht)
#pragma unroll
        for (int i = 0; i < 16; ++i) acc[ht][i] = 0.f;
#pragma unroll 4
    for (int ks = 0; ks < 32; ++ks) {
        const bf16x8 af = *(const bf16x8*)(ap + ks * 16);
#pragma unroll
        for (int ht = 0; ht < 4; ++ht) { const bf16x8 bf = *(const bf16x8*)(bp + (size_t)ht * 32 * 4096 + ks * 16); acc[ht] = __builtin_amdgcn_mfma_f32_32x32x16_bf16(af, bf, acc[ht], 0, 0, 0); }
    }
    LAS float* slot = (LAS float*)lds + (wave & 3) * 4096;
    __syncthreads();
    if (wave < 4) {
#pragma unroll
        for (int ht = 0; ht < 4; ++ht)
#pragma unroll
            for (int i = 0; i < 16; ++i) slot[(8 * (i >> 2) + 4 * hf + (i & 3)) * 128 + 32 * ht + l32] = acc[ht][i];
    }
    __syncthreads();
    if (wave >= 4) {
#pragma unroll
        for (int ht = 0; ht < 4; ++ht)
#pragma unroll
            for (int i = 0; i < 16; ++i) slot[(8 * (i >> 2) + 4 * hf + (i & 3)) * 128 + 32 * ht + l32] += acc[ht][i];
    }
    __syncthreads();
    LAS float* S = (LAS float*)lds; LAS float* hid = (LAS float*)lds + 16384;
    const float* pbp = (const float*)(a->ws + WS_PBP) + kv * 16 * 128 + (tid & 127);
    float posb = 0.f;
#pragma unroll
    for (int sl = 0; sl < 16; ++sl) posb += pbp[sl * 128];
#pragma unroll
    for (int j = 0; j < 8; ++j) { const int o = tid + 512 * j; const float v = (S[o] + S[4096 + o]) + (S[8192 + o] + S[12288 + o]) + posb; hid[o] = gelu_tanh(v); }
    __syncthreads();
    const float* w2 = a->in[kv ? 23 : 20];
    const int e = tid & 127, mq = tid >> 7;
    float o8[8];
#pragma unroll
    for (int r = 0; r < 8; ++r) o8[r] = 0.f;
#pragma unroll 1
    for (int h0 = 0; h0 < 128; h0 += 32) { float wv[32];
#pragma unroll
        for (int j = 0; j < 32; ++j) wv[j] = w2[(h0 + j) * 128 + e];
#pragma unroll
        for (int j = 0; j < 32; ++j)
#pragma unroll
            for (int r = 0; r < 8; ++r) o8[r] += hid[(mq * 8 + r) * 128 + h0 + j] * wv[j]; }
    bf16_t* KC = (bf16_t*)(a->ws + WS_KCMP) + (size_t)g * 1024 * 128; bf16_t* VCT = (bf16_t*)(a->ws + WS_VCMPT) + (size_t)g * 128 * 1024;
#pragma unroll
    for (int r = 0; r < 8; ++r) { const int n = 32 * ntile + mq * 8 + r; const bf16_t v = (n < 1023) ? f2bf(o8[r]) : (bf16_t)0;
        if (kv == 0) KC[(size_t)n * 128 + e] = v; else VCT[(size_t)e * 1024 + n] = v; }
    __syncthreads();
}
DI void vtr_item(ArgsP a, int id, LAS unsigned char* lds) {
    const int tid = threadIdx.x;
    const int which = id >> 10, g = (id >> 8) & 3, tt = id & 255, t0 = tt * 64;
    const bf16_t* src = (const bf16_t*)(a->ws + WS_KV) + (size_t)(which ? 5 : 3) * KV_T + ((size_t)g * SEQ + t0) * 128;
    bf16_t* dst = (bf16_t*)(a->ws + (which ? WS_VWT : WS_VST)) + (size_t)g * 128 * SEQ + t0;
    LAS bf16_t* tile = (LAS bf16_t*)lds;
#pragma unroll
    for (int h = 0; h < 2; ++h) { const int q = tid + 512 * h, tl = q >> 4, d8 = (q & 15) * 8; *(LAS u32x4*)(tile + tl * 136 + d8) = *(const u32x4*)(src + (size_t)tl * 128 + d8); }
    __syncthreads();
#pragma unroll
    for (int h = 0; h < 2; ++h) { const int q = tid + 512 * h, d = q >> 3, t8 = (q & 7) * 8;
        u32x4 w;
        w.x = (u32)tile[(t8 + 0) * 136 + d] | ((u32)tile[(t8 + 1) * 136 + d] << 16); w.y = (u32)tile[(t8 + 2) * 136 + d] | ((u32)tile[(t8 + 3) * 136 + d] << 16);
        w.z = (u32)tile[(t8 + 4) * 136 + d] | ((u32)tile[(t8 + 5) * 136 + d] << 16); w.w = (u32)tile[(t8 + 6) * 136 + d] | ((u32)tile[(t8 + 7) * 136 + d] << 16);
        *(u32x4*)(dst + (size_t)d * SEQ + t8) = w; }
    __syncthreads();
}
DI void phase_cmp(ArgsP a, LAS unsigned char* lds) {
    for (int item = blockIdx.x; item < 256 + 2048; item += gridDim.x) { if (item < 256) cmp_item(a, item, lds); else vtr_item(a, item - 256, lds); }
}

constexpr float ATT_SCALE = 0.08838834764831845f;
constexpr float ATT_QSCALE = 0.08838834764831845f * 1.4426950408889634f;
#ifndef PAIR_OFF
#define PAIR_OFF 0
#endif
#ifndef ATT_NG
#define ATT_NG 1
#endif
constexpr int ATT_TQ = 32 * ATT_NG;
constexpr int ATT_NTL = SEQ / ATT_TQ;
constexpr int ATT_D = 3;
constexpr int ATT_KBUF = 0, ATT_VBUF = 65536;
constexpr int ATT_IMP = 65536;
constexpr int ATT_SELM = 131072;
constexpr int ATT_UALL = ATT_SELM + 2048;
constexpr int ATT_LIST = ATT_UALL + 128;
constexpr int ATT_GRPM = ATT_LIST + 1024;
constexpr int ATT_PAIRA = ATT_GRPM + 512;
constexpr int ATT_PAIRB = ATT_PAIRA + 1024;
static_assert(ATT_PAIRB + 1024 <= LDS_BARST, "attention LDS map");
struct AttState { float m, l; f32x4 O[8]; };
#define ATT_WAIT(n) asm volatile("s_waitcnt vmcnt(" #n ")" ::: "memory")
DI void att_barrier() { asm volatile("" ::: "memory"); __builtin_amdgcn_s_barrier(); asm volatile("" ::: "memory"); }
template <int BR> DI bool att_valid(int key, int t, int sel) {
    if (BR == 0) return (16 * key + 31 <= t);
    if (BR == 1) return sel && (key <= t);
    return (key <= t) && (t - key < 512);
}
DI float max3f(float a, float b, float c) { float r; asm("v_max3_f32 %0, %1, %2, %3" : "=v"(r) : "v"(a), "v"(b), "v"(c)); return r; }
DI u32 cvt_pk_bf16_hw(float lo, float hi) { return cvt_pk_bf16_cc(lo, hi); }
template <int BR, bool MASKED> DI void att_tile(AttState (&S)[ATT_NG], const LAS unsigned char* kbuf, const LAS unsigned char* vbuf, int kabs,
                                   const bf16x8 (&qf)[ATT_NG][4], int l16, int q, const int (&t)[ATT_NG], const int (&sel)[ATT_NG], const bool (&need)[ATT_NG],
                                   const int (&kofs)[4], const int (&vofs)[2]) {
    bf16x8 pf[ATT_NG][2]; float corr[ATT_NG];
#pragma unroll
    for (int c = 0; c < ATT_NG; ++c) {
        if (!need[c]) continue;
        f32x4 s[4];
#pragma unroll
        for (int T = 0; T < 4; ++T) {
            bf16x8 ka[4];
#pragma unroll
            for (int ks = 0; ks < 4; ++ks) ka[ks] = *(const LAS bf16x8*)(kbuf + kofs[ks] + T * 4096);
            s[T] = (f32x4){0.f, 0.f, 0.f, 0.f};
#pragma unroll
            for (int ks = 0; ks < 4; ++ks) s[T] = __builtin_amdgcn_mfma_f32_16x16x32_bf16(ka[ks], qf[c][ks], s[T], 0, 0, 0);
            if (ATT_NG > 1 || (T & 1)) __builtin_amdgcn_sched_barrier(0);
        }
        if (MASKED) {
#pragma unroll
            for (int T = 0; T < 4; ++T)
#pragma unroll
                for (int i = 0; i < 4; ++i) s[T][i] = att_valid<BR>(kabs + 32 * (T >> 1) + 8 * q + 4 * (T & 1) + i, t[c], sel[c]) ? s[T][i] : -1e30f;
        }
        asm volatile("s_nop 15\n\ts_nop 3" : "+v"(s[0]), "+v"(s[1]), "+v"(s[2]), "+v"(s[3]));
        float mx = max3f(s[0][0], s[0][1], s[0][2]); mx = max3f(mx, s[0][3], s[1][0]); mx = max3f(mx, s[1][1], s[1][2]); mx = max3f(mx, s[1][3], s[2][0]);
        mx = max3f(mx, s[2][1], s[2][2]); mx = max3f(mx, s[2][3], s[3][0]); mx = max3f(mx, s[3][1], s[3][2]); mx = max3f(mx, s[3][3], mx);
        if (BR == 1 && !MASKED) mx = sel[c] ? mx : -1e30f;
        { const auto r16 = __builtin_amdgcn_permlane16_swap(__float_as_uint(mx), __float_as_uint(mx), false, false); mx = max3f(__uint_as_float(r16[0]), __uint_as_float(r16[1]), mx);
          const auto r32 = __builtin_amdgcn_permlane32_swap(__float_as_uint(mx), __float_as_uint(mx), false, false); mx = max3f(__uint_as_float(r32[0]), __uint_as_float(r32[1]), S[c].m); }
        const float mn = mx; corr[c] = __builtin_amdgcn_exp2f(S[c].m - mn); S[c].m = mn;
        const float msub = (BR == 1 && !MASKED && !sel[c]) ? __builtin_inff() : mn;
        float p[4][4], ps = 0.f;
#pragma unroll
        for (int T = 0; T < 4; ++T)
#pragma unroll
            for (int i = 0; i < 4; ++i) { float e = __builtin_amdgcn_exp2f(s[T][i] - msub);
                if (MASKED) e = (s[T][i] > -1e29f) ? e : 0.f;
                p[T][i] = e; ps += e; }
        S[c].l = S[c].l * corr[c] + ps;
#pragma unroll
        for (int hh = 0; hh < 2; ++hh) { u32x4 pw; pw.x = cvt_pk_bf16_hw(p[2 * hh][0], p[2 * hh][1]); pw.y = cvt_pk_bf16_hw(p[2 * hh][2], p[2 * hh][3]);
            pw.z = cvt_pk_bf16_hw(p[2 * hh + 1][0], p[2 * hh + 1][1]); pw.w = cvt_pk_bf16_hw(p[2 * hh + 1][2], p[2 * hh + 1][3]); pf[c][hh] = __builtin_bit_cast(bf16x8, pw); }
    }
#pragma unroll
    for (int c = 0; c < ATT_NG; ++c) { if (!need[c]) continue;
#pragma unroll
        for (int dt = 0; dt < 8; ++dt) S[c].O[dt] = S[c].O[dt] * corr[c]; }
#pragma unroll
    for (int dt = 0; dt < 8; ++dt) {
#pragma unroll
        for (int hh = 0; hh < 2; ++hh) {
            const bf16x8 vw = *(const LAS bf16x8*)(vbuf + vofs[hh] + dt * 2048);
#pragma unroll
            for (int c = 0; c < ATT_NG; ++c) { if (!need[c]) continue;
                S[c].O[dt] = __builtin_amdgcn_mfma_f32_16x16x32_bf16(vw, pf[c][hh], S[c].O[dt], 0, 0, 0); }
        }
        if (ATT_NG > 1 || (dt & 1)) __builtin_amdgcn_sched_barrier(0);
    }
}
DI void att_imp_tile(const LAS unsigned char* kbuf, int kabs, const bf16x8 (&qf)[ATT_NG][4], int l16, int q, const int (&t)[ATT_NG],
                     const float (&mfin)[ATT_NG], const float (&inv)[ATT_NG], LAS float* impw, const int (&kofs)[4]) {
    const int tok = l16 >> 2, r = l16 & 3;
#pragma unroll
    for (int T = 0; T < 4; ++T) {
        bf16x8 ka[4];
#pragma unroll
        for (int ks = 0; ks < 4; ++ks) ka[ks] = *(const LAS bf16x8*)(kbuf + kofs[ks] + T * 4096);
#pragma unroll
        for (int c = 0; c < ATT_NG; ++c) {
            f32x4 sc = {0.f, 0.f, 0.f, 0.f};
#pragma unroll
            for (int ks = 0; ks < 4; ++ks) sc = __builtin_amdgcn_mfma_f32_16x16x32_bf16(ka[ks], qf[c][ks], sc, 0, 0, 0);
            const int k0 = kabs + 32 * (T >> 1) + 8 * q + 4 * (T & 1);
            float pv[4];
#pragma unroll
            for (int i = 0; i < 4; ++i) { pv[i] = att_valid<0>(k0 + i, t[c], 0) ? __builtin_amdgcn_exp2f(sc[i] - mfin[c]) * inv[c] : 0.f; pv[i] += dppf<DPP_XOR1>(pv[i]); pv[i] += dppf<DPP_XOR2>(pv[i]); }
            if (r == 0) { LAS float* row = impw + (4 * c + tok) * 256; const int j = k0 >> 2;
                atomicAdd((float*)&row[j], 2.0f * (pv[0] + pv[1] + pv[2]) + pv[3]);
                if (j + 1 < 256) atomicAdd((float*)&row[j + 1], pv[3]); }
        }
    }
}
template <int BR, int MODE, int PROBE = 0> DI void att_stream(LAS unsigned char* lds, const bf16_t* Kp, const bf16_t* VTp, size_t ldv, int ntiles, int kb0, const LAS int* list,
                                               AttState (&S)[ATT_NG], const bf16x8 (&qf)[ATT_NG][4], int l16_in, int q_in, const int (&t)[ATT_NG],
                                               const LAS u32* selw, const LAS u32* grpw, const float (&mfin)[ATT_NG], const float (&inv)[ATT_NG], LAS float* impw) {
    int lane = threadIdx.x & 63, l16 = l16_in, q = q_in;
    asm volatile("" : "+v"(lane), "+v"(l16), "+v"(q));
    const int wave = __builtin_amdgcn_readfirstlane(threadIdx.x >> 6);
    if (ntiles <= 0) return;
    const int tw0 = __builtin_amdgcn_readfirstlane(t[0]) & ~3;
    int kofs[4], vofs[2];
#pragma unroll
    for (int ks = 0; ks < 4; ++ks) kofs[ks] = l16 * 256 + (((4 * ks + q) ^ l16) << 4);
#pragma unroll
    for (int hh = 0; hh < 2; ++hh) vofs[hh] = l16 * 128 + (((4 * hh + q) ^ ((l16 >> 1) & 7)) << 4);
    size_t offk[2], offv[2];
#pragma unroll
    for (int h = 0; h < 2; ++h) { const int p = wave + 8 * h;
        { const int row = 4 * p + (lane >> 4), cl = (lane & 15) ^ (row & 15), r5 = row & 31, key = (row & 32) + 8 * ((r5 >> 2) & 3) + 4 * (r5 >> 4) + (r5 & 3);
          offk[h] = (size_t)key * 128 + cl * 8; }
        { const int row = 8 * p + (lane >> 3), cl = (lane & 7) ^ ((row >> 1) & 7); offv[h] = (size_t)row * ldv + cl * 8; } }
#define TILE_KB(k) ((BR == 1) ? 64 * list[(k)] : kb0 + 64 * (k))
#define TILE_ISSUE(k) do { const int kb_ = (PROBE & 1) ? 0 : TILE_KB(k), slot_ = ((k) & 3) * 16384; \
        _Pragma("unroll") for (int h = 0; h < 2; ++h) __builtin_amdgcn_global_load_lds((const u32*)(Kp + (size_t)kb_ * 128 + offk[h]), (LAS u32*)(lds + ATT_KBUF + slot_ + (wave + 8 * h) * 1024), 16, 0, 0); \
        if (MODE == 0) { _Pragma("unroll") for (int h = 0; h < 2; ++h) __builtin_amdgcn_global_load_lds((const u32*)(VTp + kb_ + offv[h]), (LAS u32*)(lds + ATT_VBUF + slot_ + (wave + 8 * h) * 1024), 16, 0, 0); } } while (0)
#pragma unroll
    for (int i = 0; i < ATT_D; ++i) if (i < ntiles) TILE_ISSUE(i);
    for (int k = 0; k < ntiles; ++k) {
        const int rem = ntiles - 1 - k;
        const int kb = TILE_KB(k);
        int sel[ATT_NG]; bool need[ATT_NG]; bool any = false;
#pragma unroll
        for (int c = 0; c < ATT_NG; ++c) { sel[c] = 1; need[c] = true;
            if (BR == 1 && MODE == 0) { const int j = kb >> 6; sel[c] = (int)((selw[(4 * c + (l16 >> 2)) * 8 + (j >> 5)] >> (j & 31)) & 1u);
                const u32 gm = grpw[c * 8 + (j >> 5)]; need[c] = ((__builtin_amdgcn_readfirstlane((int)gm) >> (j & 31)) & 1) != 0; }
            any = any || need[c]; }
        if (MODE == 0) { if (rem >= 2) ATT_WAIT(8); else if (rem == 1) ATT_WAIT(4); else ATT_WAIT(0); }
        else           { if (rem >= 2) ATT_WAIT(4); else if (rem == 1) ATT_WAIT(2); else ATT_WAIT(0); }
        att_barrier();
        if (k + ATT_D < ntiles) TILE_ISSUE(k + ATT_D);
        const LAS unsigned char* kbuf = lds + ATT_KBUF + (k & 3) * 16384; const LAS unsigned char* vbuf = lds + ATT_VBUF + (k & 3) * 16384;
        if (MODE == 0) {
            if (any && !(PROBE & 2)) {
                bool full;
                if (BR == 0) full = (16 * (kb + 63) + 31 <= tw0);
                else if (BR == 1) full = (kb + 63 <= tw0);
                else full = (kb + 63 <= tw0) && (tw0 + 4 * ATT_NG - 1 - kb < 512);
                if (full) att_tile<BR, false>(S, kbuf, vbuf, kb, qf, l16, q, t, sel, need, kofs, vofs); else att_tile<BR, true>(S, kbuf, vbuf, kb, qf, l16, q, t, sel, need, kofs, vofs);
            }
        } else { att_imp_tile(kbuf, kb, qf, l16, q, t, mfin, inv, impw, kofs); }
    }
    asm volatile("s_waitcnt lgkmcnt(0)" ::: "memory");
    att_barrier();
#undef TILE_KB
#undef TILE_ISSUE
}

template <int PROBE> DI void att_stream_pairs(LAS unsigned char* lds, const bf16_t* Kp, const bf16_t* VTp, size_t ldv, const LAS u32* cnts, const LAS int* pairA, const LAS int* pairB,
                         AttState (&S)[ATT_NG], const bf16x8 (&qf)[ATT_NG][4], int l16_in, int q_in, const int (&t)[ATT_NG], const LAS u32* selw, const LAS u32* grpw) {
    int lane = threadIdx.x & 63, l16 = l16_in, q = q_in;
    asm volatile("" : "+v"(lane), "+v"(l16), "+v"(q));
    const int wave = __builtin_amdgcn_readfirstlane(threadIdx.x >> 6);
    int cw[8], nsteps = 0;
#pragma unroll
    for (int w = 0; w < 8; ++w) { cw[w] = __builtin_amdgcn_readfirstlane((int)cnts[w]); nsteps += cw[w]; }
    if (nsteps <= 0) return;
    const int tw0 = __builtin_amdgcn_readfirstlane(t[0]) & ~3;
    int kofs[4], vofs[2];
#pragma unroll
    for (int ks = 0; ks < 4; ++ks) kofs[ks] = l16 * 256 + (((4 * ks + q) ^ l16) << 4);
#pragma unroll
    for (int hh = 0; hh < 2; ++hh) vofs[hh] = l16 * 128 + (((4 * hh + q) ^ ((l16 >> 1) & 7)) << 4);
#define PAIR_IDX(k, out) do { int k_ = (k), o_ = 0; _Pragma("unroll") for (int w = 0; w < 8; ++w) { const bool past = (k_ >= cw[w]) && (w < 7); o_ = past ? (32 * (w + 1)) : o_; k_ = past ? (k_ - cw[w]) : k_; if (!past) break; } (out) = o_ + k_; } while (0)
    unsigned offk[2], offv[2];
#pragma unroll
    for (int h = 0; h < 2; ++h) { const int p = wave + 8 * h;
        { const int row = 4 * p + (lane >> 4), cl = (lane & 15) ^ (row & 15), r5 = row & 31, key = (row & 32) + 8 * ((r5 >> 2) & 3) + 4 * (r5 >> 4) + (r5 & 3);
          offk[h] = (unsigned)(key * 128 + cl * 8); }
        { const int row = 8 * p + (lane >> 3), cl = (lane & 7) ^ ((row >> 1) & 7); offv[h] = (unsigned)(row * (int)ldv + cl * 8); } }
#define PAIR_ISSUE(blk, slot) do { const int kb_ = (PROBE & 1) ? 0 : 64 * (blk), slot_ = (slot) * 16384; \
        _Pragma("unroll") for (int h = 0; h < 2; ++h) __builtin_amdgcn_global_load_lds((const u32*)(Kp + (size_t)kb_ * 128 + offk[h]), (LAS u32*)(lds + ATT_KBUF + slot_ + (wave + 8 * h) * 1024), 16, 0, 0); \
        _Pragma("unroll") for (int h = 0; h < 2; ++h) __builtin_amdgcn_global_load_lds((const u32*)(VTp + kb_ + offv[h]), (LAS u32*)(lds + ATT_VBUF + slot_ + (wave + 8 * h) * 1024), 16, 0, 0); } while (0)
    int idx_cur; PAIR_IDX(0, idx_cur);
    { const int a0 = pairA[idx_cur], b0 = pairB[idx_cur]; PAIR_ISSUE(a0, 0); PAIR_ISSUE(b0 >= 0 ? b0 : a0, 1); }
    for (int k = 0; k < nsteps; ++k) {
        int idx_nxt = 0; if (k + 1 < nsteps) PAIR_IDX(k + 1, idx_nxt);
        int blk[2]; blk[0] = pairA[idx_cur]; blk[1] = pairB[idx_cur];
        int sel[2][ATT_NG]; bool need[2][ATT_NG];
#pragma unroll
        for (int x = 0; x < 2; ++x)
#pragma unroll
            for (int c = 0; c < ATT_NG; ++c) { const int j = blk[x] < 0 ? 0 : blk[x];
                sel[x][c] = (int)((selw[(4 * c + (l16 >> 2)) * 8 + (j >> 5)] >> (j & 31)) & 1u);
                const u32 gm = grpw[c * 8 + (j >> 5)]; need[x][c] = (blk[x] >= 0) && (((__builtin_amdgcn_readfirstlane((int)gm) >> (j & 31)) & 1) != 0); }
        ATT_WAIT(0);
        att_barrier();
        if (k + 1 < nsteps) { const int a1 = pairA[idx_nxt], b1 = pairB[idx_nxt]; PAIR_ISSUE(a1, (2 * k + 2) & 3); PAIR_ISSUE(b1 >= 0 ? b1 : a1, (2 * k + 3) & 3); }
#pragma unroll
        for (int x = 0; x < 2; ++x) {
            bool any = false;
#pragma unroll
            for (int c = 0; c < ATT_NG; ++c) any = any || need[x][c];
            if (!any || (PROBE & 2)) continue;
            const int kb = 64 * blk[x];
            const LAS unsigned char* kbuf = lds + ATT_KBUF + ((2 * k + x) & 3) * 16384; const LAS unsigned char* vbuf = lds + ATT_VBUF + ((2 * k + x) & 3) * 16384;
            if (kb + 63 <= tw0) att_tile<1, false>(S, kbuf, vbuf, kb, qf, l16, q, t, sel[x], need[x], kofs, vofs); else att_tile<1, true>(S, kbuf, vbuf, kb, qf, l16, q, t, sel[x], need[x], kofs, vofs);
        }
        idx_cur = idx_nxt;
    }
    asm volatile("s_waitcnt lgkmcnt(0)" ::: "memory");
    att_barrier();
#undef PAIR_ISSUE
#undef PAIR_IDX
}

template <int SKIP> DI void phase_att(ArgsP a, LAS unsigned char* lds) {
    const bf16_t* Qb = (const bf16_t*)(a->ws + WS_BUFA);
    const bf16_t* KVb = (const bf16_t*)(a->ws + WS_KV);
    const float* GL = (const float*)(a->ws + WS_GL);
    bf16_t* Ob = (bf16_t*)(a->ws + WS_BUFB);
    const int G = gridDim.x, NI = ATT_NTL * 4, p = blockIdx.x;
    const bool xcd_order = (G == 256);
    const int nrd = xcd_order ? (ATT_NTL / 64) : ((NI + G - 1) / G);
    for (int rd = 0; rd < nrd; ++rd) {
        int g, tile;
        if (xcd_order) { const int x = p & 7, i = p >> 3, h = x >> 2, base = ATT_NTL / 32 - 1 - 2 * rd, chunk = ((rd & 1) == h) ? base : base - 1; g = x & 3; tile = 32 * chunk + i; }
        else { const int idx = rd * G + ((rd & 1) ? (G - 1 - p) : p); if (idx >= NI) continue; g = idx & 3; tile = ATT_NTL - 1 - (idx >> 2); }
        int tid = threadIdx.x; asm volatile("" : "+v"(tid));
        const int lane = tid & 63, wave = tid >> 6, l16 = lane & 15, q = lane >> 4, tok = l16 >> 2, r = l16 & 3;
        LAS float* impw = (LAS float*)(lds + ATT_IMP) + wave * (4 * ATT_NG) * 256;
        LAS u32* selw = (LAS u32*)(lds + ATT_SELM) + wave * (4 * ATT_NG) * 8;
        LAS u32* uall = (LAS u32*)(lds + ATT_UALL);
        LAS int* list = (LAS int*)(lds + ATT_LIST);
        LAS u32* grpw = (LAS u32*)(lds + ATT_GRPM) + wave * ATT_NG * 8;
        const int t0 = tile * ATT_TQ, tlast = t0 + ATT_TQ - 1, cur = t0 >> 6;
        int t[ATT_NG]; bf16x8 qf[ATT_NG][4];
#pragma unroll
        for (int c = 0; c < ATT_NG; ++c) { t[c] = t0 + wave * (4 * ATT_NG) + 4 * c + tok; const int head = 4 * g + r;
            const bf16_t* qp = Qb + (size_t)t[c] * DM + head * 128 + 8 * q;
#pragma unroll
            for (int ks = 0; ks < 4; ++ks) { const u32x4 qw = *(const u32x4*)(qp + 32 * ks); u32x4 qs;
#pragma unroll
                for (int w = 0; w < 4; ++w) qs[w] = cvt_pk_bf16_hw(bflo(qw[w]) * ATT_QSCALE, bfhi(qw[w]) * ATT_QSCALE);
                qf[c][ks] = __builtin_bit_cast(bf16x8, qs); }
}
        AttState S[ATT_NG];
        float mfin[ATT_NG], inv[ATT_NG];
#pragma unroll
        for (int c = 0; c < ATT_NG; ++c) { mfin[c] = 0.f; inv[c] = 0.f; }
#define ATT_RESET() do { _Pragma("unroll") for (int c = 0; c < ATT_NG; ++c) { S[c].m = -1e30f; S[c].l = 0.f; _Pragma("unroll") for (int i = 0; i < 8; ++i) S[c].O[i] = (f32x4){0.f, 0.f, 0.f, 0.f}; } } while (0)
#define ATT_FOLD(b) do { _Pragma("unroll") for (int c = 0; c < ATT_NG; ++c) { float l = sum_x32(sum_x16(S[c].l)); inv[c] = (l > 0.f) ? 1.0f / l : 0.f; mfin[c] = S[c].m; \
        const float w = GL[(size_t)t[c] * 48 + (4 * g + r) * 3 + (b)] * inv[c]; bf16_t* op = Ob + (size_t)t[c] * DM + (4 * g + r) * 128 + 4 * q; \
        _Pragma("unroll") for (int dt = 0; dt < 8; ++dt) { const f32x4 o = S[c].O[dt] * w; u32x2 pr = (u32x2){0u, 0u}; if ((b) != 0) pr = *(const u32x2*)(op + 16 * dt); \
            *(u32x2*)(op + 16 * dt) = (u32x2){cvt_pk_bf16_hw(bflo(pr.x) + o[0], bfhi(pr.x) + o[1]), cvt_pk_bf16_hw(bflo(pr.y) + o[2], bfhi(pr.y) + o[3])}; } } } while (0)
        __syncthreads();
        if (lane < 4 * ATT_NG * 8) selw[lane] = 0u;
        if (lane < ATT_NG * 8) grpw[lane] = 0u;
        if (tid < 24) uall[tid] = 0u;
        const bf16_t* Kc = (const bf16_t*)(a->ws + WS_KCMP) + (size_t)g * 1024 * 128; const bf16_t* VcT = (const bf16_t*)(a->ws + WS_VCMPT) + (size_t)g * 128 * 1024;
        const int ncmp = (tlast - 31) / 16 + 1, nct = (ncmp + 63) >> 6;
        ATT_RESET();
        if (!(SKIP & 1)) att_stream<0, 0>(lds, Kc, VcT, 1024, nct, 0, nullptr, S, qf, l16, q, t, selw, grpw, mfin, inv, impw);
        ATT_FOLD(0);
        for (int i = lane; i < 4 * ATT_NG * 256; i += 64) impw[i] = 0.f;
        if (!(SKIP & 2)) att_stream<0, 1>(lds, Kc, VcT, 1024, nct, 0, nullptr, S, qf, l16, q, t, selw, grpw, mfin, inv, impw);
#pragma unroll
        for (int c = 0; c < ATT_NG; ++c) {
            if (SKIP & 4) continue;
            const int tk = q; LAS float* row = impw + (4 * c + tk) * 256; LAS u32* srow = selw + (4 * c + tk) * 8;
            int key[16];
#pragma unroll
            for (int i = 0; i < 16; ++i) { const int j = 16 * l16 + i; const float v = row[j];
                const bool forced = (j == 0) || (j == cur) || (j == cur - 1);
                key[i] = (j <= cur && !forced) ? ((__float_as_int(v) & ~255) | (255 - j)) : -1; }
            const int nforced = (cur >= 2) ? 3 : (cur + 1);
            if (l16 == 0) { atomicOr((u32*)&srow[0], 1u); atomicOr((u32*)&srow[cur >> 5], 1u << (cur & 31)); if (cur >= 1) atomicOr((u32*)&srow[(cur - 1) >> 5], 1u << ((cur - 1) & 31)); }
            for (int rr = 0; rr < 16 - nforced; ++rr) {
                int m = key[0];
#pragma unroll
                for (int i = 1; i < 16; ++i) m = max(m, key[i]);
                m = max(m, dppi<DPP_XOR1>(m)); m = max(m, dppi<DPP_XOR2>(m)); m = max(m, dppi<DPP_HMIRROR>(m)); m = max(m, dppi<DPP_MIRROR>(m));
                if (m >= 0) { const int j = 255 - (m & 255); if (l16 == 0) atomicOr((u32*)&srow[j >> 5], 1u << (j & 31));
#pragma unroll
                    for (int i = 0; i < 16; ++i) key[i] = (key[i] == m) ? -1 : key[i]; }
            }
            if (lane < 8) { const u32 gm = selw[(4 * c) * 8 + lane] | selw[(4 * c + 1) * 8 + lane] | selw[(4 * c + 2) * 8 + lane] | selw[(4 * c + 3) * 8 + lane];
                grpw[c * 8 + lane] = gm; atomicOr((u32*)&uall[lane], gm); }
        }
        __syncthreads();
        if (wave == 0) {
            int base = 0;
#pragma unroll
            for (int rr = 0; rr < 4; ++rr) { const int j = lane + 64 * rr; const bool bit = ((uall[j >> 5] >> (j & 31)) & 1u) != 0u;
                const unsigned long long bal = __ballot(bit);
                if (bit) list[base + __popcll(bal & ((1ull << lane) - 1ull))] = j;
                base += __popcll(bal); }
            if (lane == 0) uall[8] = (u32)base;
        }
        __syncthreads();
        { const int n = (int)uall[8], seg = (n + 7) >> 3, s0 = wave * seg, cntl = (n - s0 < seg) ? (n - s0 < 0 ? 0 : n - s0) : seg;
          const LAS u32* gall = (const LAS u32*)(lds + ATT_GRPM);
          int m = 0, jme = 0; bool used = (lane >= cntl);
          if (lane < cntl) { jme = list[s0 + lane];
#pragma unroll
              for (int w = 0; w < 8; ++w) { u32 g_or = 0u, g_and = 0xffffffffu;
#pragma unroll
                  for (int c = 0; c < ATT_NG; ++c) { const u32 gw = gall[(w * ATT_NG + c) * 8 + (jme >> 5)]; g_or |= gw; g_and &= gw; }
                  m |= (int)((g_or >> (jme & 31)) & 1u) << w; if (ATT_NG > 1) m |= (int)((g_and >> (jme & 31)) & 1u) << (8 + w); } }
          LAS int* pairA = (LAS int*)(lds + ATT_PAIRA) + 32 * wave; LAS int* pairB = (LAS int*)(lds + ATT_PAIRB) + 32 * wave;
          int ns = 0;
          for (int i = 0; i < cntl; ++i) {
              if (__builtin_amdgcn_readlane((int)used, i)) continue;
              const int mi = __builtin_amdgcn_readlane(m, i), ji = __builtin_amdgcn_readlane(jme, i);
              const bool cand = !used && (lane > i);
              const bool fits = (ATT_NG == 1) ? ((m & mi & 0xff) == 0) : (((((m >> 8) & mi) | ((mi >> 8) & m)) & 0xff) == 0);
              unsigned long long bal = __ballot(cand && fits);
              if (bal == 0ull) bal = __ballot(cand);
              const int partner = bal ? (int)__builtin_ctzll(bal) : -1;
              int jp = -1; if (partner >= 0) jp = __builtin_amdgcn_readlane(jme, partner);
              if (lane == i || lane == partner) used = true;
              if (lane == 0) { pairA[ns] = ji; pairB[ns] = jp; }
              ++ns;
          }
          if (lane == 0) uall[16 + wave] = (u32)ns; }
        __syncthreads();
        { const bf16_t* Ks = KVb + (size_t)2 * KV_T + (size_t)g * SEQ * 128; const bf16_t* VsT = (const bf16_t*)(a->ws + WS_VST) + (size_t)g * 128 * SEQ;
          ATT_RESET();
          if (!(SKIP & 8)) att_stream_pairs<((SKIP & 32) ? 1 : 0) | ((SKIP & 64) ? 2 : 0)>(lds, Ks, VsT, SEQ, (const LAS u32*)(uall + 16), (const LAS int*)(lds + ATT_PAIRA), (const LAS int*)(lds + ATT_PAIRB), S, qf, l16, q, t, selw, grpw);
          ATT_FOLD(1); }
        { const bf16_t* Kw = KVb + (size_t)4 * KV_T + (size_t)g * SEQ * 128; const bf16_t* VwT = (const bf16_t*)(a->ws + WS_VWT) + (size_t)g * 128 * SEQ;
          int kb0 = t0 - 511; kb0 = kb0 < 0 ? 0 : (kb0 & ~63);
          ATT_RESET();
          if (!(SKIP & 16)) att_stream<2, 0>(lds, Kw, VwT, SEQ, (tlast - kb0) / 64 + 1, kb0, nullptr, S, qf, l16, q, t, selw, grpw, mfin, inv, impw);
          ATT_FOLD(2); }
#undef ATT_RESET
#undef ATT_FOLD
    }
}

constexpr int N_PHASES = 20;
#ifndef PHASE_MASK
#define PHASE_MASK 0xFFFFF
#endif
#ifndef Q8_L1ROWS
#define Q8_L1ROWS 0
#endif
#ifndef GEMM11_WGS
#define GEMM11_WGS 224
#endif
template <class Epi> DI void run_gemm_on(LAS unsigned char* lds, const bf16_t* A, const bf16_t* Bt, int N, const Epi& E, int nwg, int c) {
    pg8::Gemm g{A, Bt, SEQ, N, DM}; pg8::StaticOrder S; S.init(SEQ, N, nwg, c);
    pg8::gemm_phase<Epi, pg8::StaticOrder, false>((PG8_LAS unsigned char*)lds, g, S, E, nullptr);
}
template <class Epi> DI void run_gemm(LAS unsigned char* lds, const bf16_t* A, const bf16_t* Bt, int N, const Epi& E) {
    pg8::Gemm g{A, Bt, SEQ, N, DM}; pg8::StaticOrder S; S.init(SEQ, N, (int)gridDim.x, (int)blockIdx.x);
    pg8::gemm_phase<Epi, pg8::StaticOrder, false>((PG8_LAS unsigned char*)lds, g, S, E, nullptr);
}

__global__ void __launch_bounds__(NT, 2) fwd_mega(Args a_by_value) {
    const ArgsP a0 = (ArgsP)__builtin_amdgcn_kernarg_segment_ptr();
    extern __shared__ __attribute__((aligned(16))) unsigned char lds_raw[];
    LAS unsigned char* lds = (LAS unsigned char*)lds_raw;
    cg::grid_group grid = cg::this_grid();
    const int lo = a0->ph_lo, hi = a0->ph_hi;
    if (threadIdx.x < 4) ((LAS unsigned*)(lds + LDS_BARST))[threadIdx.x] = 0u;
    __syncthreads();
    const XcdBarrier xbar = xcd_barrier_post((unsigned*)(a0->ws + WS_BAR), (volatile LAS unsigned*)(lds + LDS_BARST));
#define PH_VARS const ArgsP a = args_fresh(a0); unsigned char* ws = a->ws; const float* mod0 = (const float*)(ws + WS_MOD); const float* mod1 = mod0 + 12288; \
    bf16_t* H = (bf16_t*)(ws + WS_H); bf16_t* BA = (bf16_t*)(ws + WS_BUFA); bf16_t* BB = (bf16_t*)(ws + WS_BUFB); float* XA = (float*)(ws + WS_XA); \
    (void)mod0; (void)mod1; (void)H; (void)BA; (void)BB; (void)XA;
#ifndef SEAM_CG
#define SEAM_CG 0
#endif
#define IN(k) (lo <= (k) && (k) < hi)
#define SEAM(k) do { if (IN(k) && IN((k) + 1)) { if ((k) == 0 || (k) == SEAM_CG) grid.sync(); else xcd_barrier(xbar); } } while (0)
#if (PHASE_MASK >> 0) & 1
#if defined(PROBE_DUP) && PROBE_DUP == 0
#ifndef PREP_ONLY
#define PREP_ONLY 0
#endif
        if (IN(0)) { PH_VARS phase_prep<PREP_ONLY>(a, lds); }
        if (IN(0)) xcd_barrier(xbar);
#endif
        if (IN(0)) { PH_VARS phase_prep<0>(a, lds); }
        SEAM(0);
#endif
#if (PHASE_MASK >> 1) & 1
#if defined(PROBE_DUP) && PROBE_DUP == 1
        if (IN(1)) { PH_VARS phase_norm(a->in[0], a->in[4], mod0, mod0 + DM, H); }
        if (IN(1)) xcd_barrier(xbar);
#endif
        if (IN(1)) { PH_VARS phase_norm(a->in[0], a->in[4], mod0, mod0 + DM, H); }
        SEAM(1);
#endif
#if (PHASE_MASK >> 2) & 1
#if defined(PROBE_DUP) && PROBE_DUP == 2
        if (IN(2)) { PH_VARS { pg8::EpiStoreBf16 E{BA, DM}; run_gemm(lds, H, (const bf16_t*)(ws + WS_WT_SIN), 2048, E); } }
        if (IN(2)) xcd_barrier(xbar);
#endif
        if (IN(2)) { PH_VARS { pg8::EpiStoreBf16 E{BA, DM}; run_gemm(lds, H, (const bf16_t*)(ws + WS_WT_SIN), 2048, E); } }
        SEAM(2);
#endif
#if (PHASE_MASK >> 3) & 1
#if defined(PROBE_DUP) && PROBE_DUP == 3
        if (IN(3)) { PH_VARS phase_s5<false>(a, lds); }
        if (IN(3)) xcd_barrier(xbar);
#endif
        if (IN(3)) { PH_VARS phase_s5<false>(a, lds); }
        SEAM(3);
#endif
#if (PHASE_MASK >> 4) & 1
#if defined(PROBE_DUP) && PROBE_DUP == 4
        if (IN(4)) { PH_VARS phase_s5<true>(a, lds); }
        if (IN(4)) xcd_barrier(xbar);
#endif
        if (IN(4)) { PH_VARS phase_s5<true>(a, lds); }
        SEAM(4);
#endif
#if (PHASE_MASK >> 5) & 1
#if defined(PROBE_DUP) && PROBE_DUP == 5
        if (IN(5)) { PH_VARS { pg8::EpiGlu E{a->in[0], XA, mod0 + 2 * DM}; run_gemm(lds, BB, (const bf16_t*)(ws + WS_WT_SOUT), 4096, E); } }
        if (IN(5)) xcd_barrier(xbar);
#endif
        if (IN(5)) { PH_VARS { pg8::EpiGlu E{a->in[0], XA, mod0 + 2 * DM}; run_gemm(lds, BB, (const bf16_t*)(ws + WS_WT_SOUT), 4096, E); } }
        SEAM(5);
#endif
#if defined(PROBE_BAR)
        if (IN(6)) { xcd_barrier(xbar); xcd_barrier(xbar); xcd_barrier(xbar); xcd_barrier(xbar); xcd_barrier(xbar); xcd_barrier(xbar); xcd_barrier(xbar); xcd_barrier(xbar); }
#endif
#if (PHASE_MASK >> 6) & 1
#if defined(PROBE_DUP) && PROBE_DUP == 6
        if (IN(6)) { PH_VARS phase_norm(XA, a->in[5], mod0 + 3 * DM, mod0 + 4 * DM, H); }
        if (IN(6)) xcd_barrier(xbar);
#endif
        if (IN(6)) { PH_VARS phase_norm(XA, a->in[5], mod0 + 3 * DM, mod0 + 4 * DM, H); }
        SEAM(6);
#endif
#if (PHASE_MASK >> 7) & 1
#if defined(PROBE_DUP) && PROBE_DUP == 7
        if (IN(7)) { PH_VARS { pg8::EpiStoreBf16 E{BA, DM}; run_gemm(lds, H, (const bf16_t*)(ws + WS_WT_PQ), 2048, E); } }
        if (IN(7)) xcd_barrier(xbar);
#endif
        if (IN(7)) { PH_VARS { pg8::EpiStoreBf16 E{BA, DM}; run_gemm(lds, H, (const bf16_t*)(ws + WS_WT_PQ), 2048, E); } }
        SEAM(7);
#endif
#if (PHASE_MASK >> 8) & 1
#if defined(PROBE_DUP) && PROBE_DUP == 8
        if (IN(8)) { PH_VARS phase_route(a, 0, lds); }
        if (IN(8)) xcd_barrier(xbar);
#endif
        if (IN(8)) { PH_VARS p0_quant_rows(a, 0, 16384 + Q8_L1ROWS, blockIdx.x * 8 + (threadIdx.x >> 6), gridDim.x * 8); phase_route(a, 0, lds); }
        SEAM(8);
#endif
#if (PHASE_MASK >> 9) & 1
#if defined(PROBE_DUP) && PROBE_DUP == 9
        if (IN(9)) { PH_VARS phase_peer(a, 0, 1); }
        if (IN(9)) xcd_barrier(xbar);
#endif
        if (IN(9)) { PH_VARS phase_peer(a, 0, 2); }
        SEAM(9);
#endif
#if (PHASE_MASK >> 10) & 1
        if (IN(10)) { PH_VARS phase_norm(XA, a->in[4] + DM, mod1, mod1 + DM, H); }
        SEAM(10);
#endif
#if (PHASE_MASK >> 11) & 1
#if defined(PROBE_DUP) && PROBE_DUP == 11
        if (IN(11)) { PH_VARS { pg8::EpiNsaIn E{BA, (bf16_t*)(ws + WS_KV), (float*)(ws + WS_GL)}; run_gemm(lds, H, (const bf16_t*)(ws + WS_WT_NIN), 5376, E); } }
        if (IN(11)) xcd_barrier(xbar);
#endif
        if (IN(11)) { PH_VARS
            if ((int)blockIdx.x < GEMM11_WGS) { pg8::EpiNsaIn E{BA, (bf16_t*)(ws + WS_KV), (float*)(ws + WS_GL)}; run_gemm_on(lds, H, (const bf16_t*)(ws + WS_WT_NIN), 5376, E, GEMM11_WGS, (int)blockIdx.x); }
            else p0_quant_rows(a, 16384 + Q8_L1ROWS, 32768, ((int)blockIdx.x - GEMM11_WGS) * 8 + (threadIdx.x >> 6), ((int)gridDim.x - GEMM11_WGS) * 8); }
        SEAM(11);
#endif
#if (PHASE_MASK >> 12) & 1
#if defined(PROBE_DUP) && PROBE_DUP == 12
        if (IN(12)) { PH_VARS phase_cmp(a, lds); }
        if (IN(12)) xcd_barrier(xbar);
#endif
        if (IN(12)) { PH_VARS phase_cmp(a, lds); }
        SEAM(12);
#endif
#if (PHASE_MASK >> 13) & 1
#if defined(PROBE_DUP) && PROBE_DUP == 13
#ifndef ATT_PROBE_SKIP
#define ATT_PROBE_SKIP 0
#endif
        if (IN(13)) { PH_VARS phase_att<ATT_PROBE_SKIP>(a, lds); }
        if (IN(13)) xcd_barrier(xbar);
#endif
        if (IN(13)) { PH_VARS phase_att<0>(a, lds); }
        SEAM(13);
#endif
#if (PHASE_MASK >> 14) & 1
        if (IN(14)) { PH_VARS { pg8::EpiResid E{XA, mod1 + 2 * DM}; run_gemm(lds, BB, (const bf16_t*)(ws + WS_WT_NOUT), 2048, E); } }
        SEAM(14);
#endif
#if (PHASE_MASK >> 15) & 1
#if defined(PROBE_DUP) && PROBE_DUP == 15
        if (IN(15)) { PH_VARS phase_norm(XA, a->in[5] + DM, mod1 + 3 * DM, mod1 + 4 * DM, H); }
        if (IN(15)) xcd_barrier(xbar);
#endif
        if (IN(15)) { PH_VARS phase_norm(XA, a->in[5] + DM, mod1 + 3 * DM, mod1 + 4 * DM, H); }
        SEAM(15);
#endif
#if (PHASE_MASK >> 16) & 1
#if defined(PROBE_DUP) && PROBE_DUP == 16
        if (IN(16)) { PH_VARS { pg8::EpiStoreBf16 E{BA, DM}; run_gemm(lds, H, (const bf16_t*)(ws + WS_WT_PQ) + (size_t)DM * DM, 2048, E); } }
        if (IN(16)) xcd_barrier(xbar);
#endif
        if (IN(16)) { PH_VARS { pg8::EpiStoreBf16 E{BA, DM}; run_gemm(lds, H, (const bf16_t*)(ws + WS_WT_PQ) + (size_t)DM * DM, 2048, E); } }
        SEAM(16);
#endif
#if (PHASE_MASK >> 17) & 1
#if defined(PROBE_DUP) && PROBE_DUP == 17
        if (IN(17)) { PH_VARS phase_route(a, 1, lds); }
        if (IN(17)) xcd_barrier(xbar);
#endif
        if (IN(17)) { PH_VARS phase_route(a, 1, lds); }
        SEAM(17);
#endif
#if (PHASE_MASK >> 18) & 1
#if defined(PROBE_DUP) && PROBE_DUP == 18
        if (IN(18)) { PH_VARS phase_peer(a, 1, 1); }
        if (IN(18)) xcd_barrier(xbar);
#endif
        if (IN(18)) { PH_VARS phase_peer(a, 1, 1); }
        SEAM(18);
#endif
#undef IN
#undef SEAM
}

#ifndef N_LAUNCH_MODE
#define N_LAUNCH_MODE 1
#endif
extern "C" void kernel_launch(void* const* d_in, const int* in_sizes, int n_in, void* d_out, int out_size, void* d_ws, size_t ws_size, hipStream_t stream) {
    static int grid = 0;
    if (grid == 0) {
        if (n_in != 29 || out_size != SEQ * DM || ws_size < WS_END) { fprintf(stderr, "kernel_launch: unexpected problem (n_in %d, out %d, ws %zu < %zu)\n", n_in, out_size, ws_size, (size_t)WS_END); grid = -1; return; }
        int dev = 0, cus = 0, per_cu = 0;
        hipGetDevice(&dev); hipDeviceGetAttribute(&cus, hipDeviceAttributeMultiprocessorCount, dev);
        hipFuncSetAttribute((const void*)fwd_mega, hipFuncAttributeMaxDynamicSharedMemorySize, LDS_BYTES);
        hipOccupancyMaxActiveBlocksPerMultiprocessor(&per_cu, (const void*)fwd_mega, NT, LDS_BYTES);
        if (per_cu < 1) { fprintf(stderr, "kernel_launch: occupancy query says %d workgroups per CU\n", per_cu); per_cu = 1; }
        grid = cus;
        (void)hipGetLastError();
    }
    if (grid < 0) return;
    (void)hipMemsetAsync((unsigned char*)d_ws + WS_BAR, 0, XCD_BAR_WORDS * 4, stream);
    Args a{};
    for (int i = 0; i < 29; ++i) a.in[i] = (const float*)d_in[i];
    a.out = (float*)d_out; a.ws = (unsigned char*)d_ws;
#if N_LAUNCH_MODE == 1
    a.ph_lo = 0; a.ph_hi = N_PHASES - 1;
    { void* args[] = {&a}; hipError_t e = hipLaunchCooperativeKernel((const void*)fwd_mega, dim3(grid), dim3(NT), args, LDS_BYTES, stream);
      if (e != hipSuccess) fprintf(stderr, "cooperative launch failed: %s (grid %d)\n", hipGetErrorString(e), grid); }
#else
    for (int ph = 0; ph < N_PHASES - 1; ++ph) {
        a.ph_lo = ph; a.ph_hi = ph + 1;
        void* args[] = {&a}; hipError_t e = hipLaunchCooperativeKernel((const void*)fwd_mega, dim3(grid), dim3(NT), args, LDS_BYTES, stream);
        if (e != hipSuccess) { fprintf(stderr, "launch of phase %d failed: %s (grid %d)\n", ph, hipGetErrorString(e), grid); break; }
    }
#endif
}
```

```cpp
#define ATT_NG 1
#include <hip/hip_runtime.h>
#include <hip/hip_cooperative_groups.h>
#include <cstdio>
#include <cstdint>
namespace cg = cooperative_groups;

#define DI __device__ __forceinline__
#define LAS __attribute__((address_space(3)))
typedef unsigned short bf16_t;
typedef unsigned int u32;
typedef short bf16x8 __attribute__((ext_vector_type(8)));
typedef float f32x4 __attribute__((ext_vector_type(4)));
typedef float f32x16 __attribute__((ext_vector_type(16)));
typedef unsigned u32x4 __attribute__((ext_vector_type(4)));
typedef unsigned u32x2 __attribute__((ext_vector_type(2)));
typedef float f32x2v __attribute__((ext_vector_type(2)));
typedef short s16x2 __attribute__((ext_vector_type(2)));
typedef __bf16 bf16x2_hw __attribute__((ext_vector_type(2)));
DI u32 cvt_pk_bf16_cc(float lo, float hi) { const bf16x2_hw r = __builtin_convertvector((f32x2v){lo, hi}, bf16x2_hw); return __builtin_bit_cast(u32, r); }

constexpr int DM = 2048;
constexpr int SEQ = 16384;
constexpr int NT = 512;
constexpr int LDS_BYTES = 147456;
constexpr int LDS_BARST = LDS_BYTES - 64;

constexpr size_t MB = 1024 * 1024;
constexpr size_t WS_MOD    = 0;
constexpr size_t WS_POSB   = 98304;
constexpr size_t WS_PSC    = 262144;
constexpr size_t WS_BAR    = 524288;
constexpr size_t WS_SEND   = 1 * MB;
constexpr size_t WS_WT_SIN = 2 * MB;
constexpr size_t WS_WT_SOUT= WS_WT_SIN + 8 * MB;
constexpr size_t WS_WT_NIN = WS_WT_SOUT + 16 * MB;
constexpr size_t WS_WT_NOUT= WS_WT_NIN + 21 * MB;
constexpr size_t WS_WT_PQ  = WS_WT_NOUT + 8 * MB;
constexpr size_t WS_SUBK   = WS_WT_PQ + 16 * MB;
constexpr size_t WS_CW1T   = WS_SUBK + 1 * MB;
constexpr size_t WS_PU     = WS_CW1T + 2 * MB;
constexpr size_t WS_PV     = WS_PU + 128 * MB;
constexpr size_t WS_H      = WS_PV + 128 * MB;
constexpr size_t WS_BUFA   = WS_H + 64 * MB;
constexpr size_t WS_BUFB   = WS_BUFA + 64 * MB;
constexpr size_t WS_XA     = WS_BUFB + 64 * MB;
constexpr size_t WS_EXP    = WS_XA + 128 * MB;
constexpr size_t WS_GATE   = WS_EXP + 8 * MB;
constexpr size_t WS_KV     = WS_GATE + 8 * MB;
constexpr size_t WS_GL     = WS_KV + 96 * MB;
constexpr size_t WS_KCMP   = WS_GL + 3 * MB;
constexpr size_t WS_VCMPT  = WS_KCMP + 1 * MB;
constexpr size_t WS_VST    = WS_VCMPT + 1 * MB;
constexpr size_t WS_VWT    = WS_VST + 16 * MB;
constexpr size_t WS_S5BB   = WS_PU + 64 * MB;
constexpr size_t WS_S5CT   = WS_S5BB + 1 * MB;
constexpr size_t WS_PW     = WS_S5CT + 1 * MB;
constexpr size_t WS_PBP    = WS_PW + 8 * MB;
constexpr size_t WS_KS8    = WS_PBP + 1 * MB;
constexpr size_t WS_VST8   = WS_KS8 + 8 * MB;
constexpr size_t WS_END    = WS_VWT + 16 * MB;
constexpr int PEER_ROWB = 1536;
constexpr size_t KV_T      = (size_t)4 * SEQ * 128;

struct Args { const float* in[29]; float* out; unsigned char* ws; int ph_lo, ph_hi; };
typedef const __attribute__((address_space(4))) Args* ArgsP;
DI ArgsP args_fresh(ArgsP p) { asm volatile("" : "+s"(p)); return p; }

DI float bf2f(bf16_t b) { return __uint_as_float(((u32)b) << 16); }
DI float bflo(u32 w) { return __uint_as_float(w << 16); }
DI float bfhi(u32 w) { return __uint_as_float(w & 0xffff0000u); }
DI bf16_t f2bf(float f) { u32 u = __float_as_uint(f); u += 0x7fffu + ((u >> 16) & 1u); return (bf16_t)(u >> 16); }
DI u32 pk_bf16(float lo, float hi) { return (u32)f2bf(lo) | ((u32)f2bf(hi) << 16); }
DI float fast_rcp(float x) { return __builtin_amdgcn_rcpf(x); }
DI float sigmoidf_(float x) { return fast_rcp(1.0f + __expf(-x)); }
DI float gelu_tanh(float x) { const float z = 1.5957691216057308f * (x + 0.044715f * x * x * x); return x * fast_rcp(1.0f + __expf(-z)); }
template <int CTRL> DI float dppf(float v) { return __int_as_float(__builtin_amdgcn_update_dpp(0, __float_as_int(v), CTRL, 0xF, 0xF, false)); }
template <int CTRL> DI int dppi(int v) { return __builtin_amdgcn_update_dpp(0, v, CTRL, 0xF, 0xF, false); }
constexpr int DPP_XOR1 = 0xB1, DPP_XOR2 = 0x4E, DPP_HMIRROR = 0x141, DPP_MIRROR = 0x140;
DI float sum_x16(float v) { const auto r = __builtin_amdgcn_permlane16_swap(__float_as_uint(v), __float_as_uint(v), false, false); return __uint_as_float(r[0]) + __uint_as_float(r[1]); }
DI float sum_x32(float v) { const auto r = __builtin_amdgcn_permlane32_swap(__float_as_uint(v), __float_as_uint(v), false, false); return __uint_as_float(r[0]) + __uint_as_float(r[1]); }
DI float row16_sum(float v) { v += dppf<DPP_XOR1>(v); v += dppf<DPP_XOR2>(v); v += dppf<DPP_HMIRROR>(v); v += dppf<DPP_MIRROR>(v); return v; }
DI float wave_sum(float v) { return sum_x32(sum_x16(row16_sum(v))); }
namespace pg8 {
#define PG8_LAS __attribute__((address_space(3)))
typedef unsigned short bf16_t;
typedef short bf16x8 __attribute__((ext_vector_type(8)));
typedef float f32x4 __attribute__((ext_vector_type(4)));
typedef unsigned u32x4 __attribute__((ext_vector_type(4)));
constexpr int BM = 256, BK = 64, HALF = 128, HTB = HALF * BK * 2  , STAGE_BYTES = 8 * HTB, NXCD = 8, WGM = 8;

__host__ __device__ __forceinline__ int lds_byte(int r, int c) { const int st = (r >> 4) * 2 + (c >> 5), rr = r & 15, cc = c & 31, ob = rr * 64 + cc * 2; return st * 1024 + (ob ^ (((ob >> 9) & 1) << 5)); }
__host__ __device__ __forceinline__ void stage_rc(int b, int& R, int& C) { const int st = b / 1024, sb = b % 1024, swz = sb ^ (((sb >> 9) & 1) << 5); R = (st >> 1) * 16 + swz / 64; C = (st & 1) * 32 + (swz % 64) / 2; }
__host__ __device__ __forceinline__ int perm32(int rho) { const int n = rho >> 4, i = rho & 15; return 8 * (i >> 2) + 4 * n + (i & 3); }

struct Unit { int pm, pn; };
struct Gemm { const bf16_t* A; const bf16_t* Bt; int M, N, K; };

struct StaticOrder {
    int nM, nN, nwg, G, c;
    __host__ __device__ void init(int M, int N, int G_, int c_) { nM = M / BM; nN = N / BM; nwg = nM * nN; G = G_; c = c_; }
    __host__ __device__ bool next(int i, Unit& u) const {
        const long L = (long)i * G + c; if (L >= nwg) return false;
        int wgid = (int)L; { const int q = nwg / NXCD, r = nwg % NXCD, xcd = wgid % NXCD, off = wgid / NXCD; wgid = (xcd < r ? xcd * (q + 1) : r * (q + 1) + (xcd - r) * q) + off; }
        const int nig = WGM * nN, gid = wgid / nig, fm = gid * WGM, gsz = (nM - fm) < WGM ? (nM - fm) : WGM;
        u.pm = fm + ((wgid % nig) % gsz); u.pn = (wgid % nig) / gsz; return true;
    }
    __device__ __forceinline__ void a_ready(const Unit&) const {}
    __device__ __forceinline__ void done(const Unit&) const {}
};
__device__ __forceinline__ unsigned cvt_pk_bf16(float lo, float hi) { return cvt_pk_bf16_cc(lo, hi); }
struct EpiStoreBf16 {
    static constexpr bool PERM = true, AFTER_DRAIN = false;
    bf16_t* O; int ldc;
    __device__ __forceinline__ void operator()(const f32x4 (&acc)[2][2][4][2], const Unit& u, int wr, int wc, int fr, int fq) const {
        const int row0 = u.pm * BM + wr * 64 + fr, col0 = u.pn * BM + wc * 32 + 8 * fq;
#pragma unroll
        for (int ai = 0; ai < 2; ++ai)
#pragma unroll
            for (int m = 0; m < 4; ++m) { bf16_t* rowp = O + (size_t)(row0 + ai * HALF + m * 16) * ldc + col0;
#pragma unroll
                for (int bj = 0; bj < 2; ++bj) { const f32x4 v0 = acc[ai][bj][m][0], v1 = acc[ai][bj][m][1];
                    u32x4 w; w.x = cvt_pk_bf16(v0[0], v0[1]); w.y = cvt_pk_bf16(v0[2], v0[3]); w.z = cvt_pk_bf16(v1[0], v1[1]); w.w = cvt_pk_bf16(v1[2], v1[3]);
                    *(u32x4*)(rowp + bj * HALF) = w; } }
    }
};
struct EpiGlu {
    static constexpr bool PERM = false, AFTER_DRAIN = false;
    const float* xin; float* xout; const float* g1;
    __device__ __forceinline__ void operator()(const f32x4 (&acc)[2][2][4][2], const Unit& u, int wr, int wc, int fr, int fq) const {
        const int row0 = u.pm * BM + wr * 64 + fr, col0 = u.pn * HALF + wc * 32 + 4 * fq;
#pragma unroll
        for (int ai = 0; ai < 2; ++ai)
#pragma unroll
            for (int m = 0; m < 4; ++m) { const size_t ro = (size_t)(row0 + ai * HALF + m * 16) * DM;
#pragma unroll
                for (int n = 0; n < 2; ++n) { const int col = col0 + 16 * n;
                    const f32x4 a = acc[ai][0][m][n], b = acc[ai][1][m][n];
                    const f32x4 xi = *(const f32x4*)(xin + ro + col), gg = *(const f32x4*)(g1 + col);
                    f32x4 o;
#pragma unroll
                    for (int j = 0; j < 4; ++j) o[j] = xi[j] + gg[j] * a[j] * __builtin_amdgcn_rcpf(1.0f + __expf(-b[j]));
                    *(f32x4*)(xout + ro + col) = o; } }
    }
};
struct EpiResid {
    static constexpr bool PERM = false, AFTER_DRAIN = false;
    float* x; const float* g1;
    __device__ __forceinline__ void operator()(const f32x4 (&acc)[2][2][4][2], const Unit& u, int wr, int wc, int fr, int fq) const {
        const int row0 = u.pm * BM + wr * 64 + fr, col0 = u.pn * BM + wc * 32 + 4 * fq;
#pragma unroll
        for (int ai = 0; ai < 2; ++ai)
#pragma unroll
            for (int m = 0; m < 4; ++m) { float* rowp = x + (size_t)(row0 + ai * HALF + m * 16) * DM + col0;
#pragma unroll
                for (int bj = 0; bj < 2; ++bj)
#pragma unroll
                    for (int n = 0; n < 2; ++n) { const f32x4 gg = *(const f32x4*)(g1 + col0 + bj * HALF + n * 16);
                        f32x4 xi = *(const f32x4*)(rowp + bj * HALF + n * 16); xi += gg * acc[ai][bj][m][n]; *(f32x4*)(rowp + bj * HALF + n * 16) = xi; } }
    }
};
struct EpiNsaIn {
    static constexpr bool PERM = true, AFTER_DRAIN = false;
    bf16_t* Q; bf16_t* KV; float* GL;
    __device__ __forceinline__ void operator()(const f32x4 (&acc)[2][2][4][2], const Unit& u, int wr, int wc, int fr, int fq) const {
        const int row0 = u.pm * BM + wr * 64 + fr, lc0 = wc * 32 + 8 * fq;
#pragma unroll
        for (int ai = 0; ai < 2; ++ai)
#pragma unroll
            for (int m = 0; m < 4; ++m) { const int row = row0 + ai * HALF + m * 16;
#pragma unroll
                for (int bj = 0; bj < 2; ++bj) { const f32x4 v0 = acc[ai][bj][m][0], v1 = acc[ai][bj][m][1];
                    if (u.pn < 20) {
                        u32x4 w; w.x = cvt_pk_bf16(v0[0], v0[1]); w.y = cvt_pk_bf16(v0[2], v0[3]); w.z = cvt_pk_bf16(v1[0], v1[1]); w.w = cvt_pk_bf16(v1[2], v1[3]);
                        bf16_t* dst;
                        if (u.pn < 8) dst = Q + (size_t)row * DM + u.pn * BM + bj * HALF + lc0;
                        else { const int tsr = (u.pn - 8) >> 1, c512 = ((u.pn - 8) & 1) * 256 + bj * HALF + lc0, g = c512 >> 7, d = c512 & 127;
                               dst = KV + (size_t)tsr * ((size_t)4 * SEQ * 128) + ((size_t)g * SEQ + row) * 128 + d; }
                        *(u32x4*)dst = w;
                    } else if (bj == 0 && lc0 < 48) {
                        float* dst = GL + (size_t)row * 48 + lc0; f32x4 s0, s1;
#pragma unroll
                        for (int j = 0; j < 4; ++j) { s0[j] = __builtin_amdgcn_rcpf(1.0f + __expf(-v0[j])); s1[j] = __builtin_amdgcn_rcpf(1.0f + __expf(-v1[j])); }
                        *(f32x4*)dst = s0; *(f32x4*)(dst + 4) = s1;
                    } } }
    }
};
template <class Epi, class Sched, bool STAMP = false>
__device__ __forceinline__ void gemm_phase(PG8_LAS unsigned char* lds, const Gemm g, const Sched& S, const Epi& E, unsigned long long* stamps) {
    const int tid = threadIdx.x, wid = __builtin_amdgcn_readfirstlane(tid >> 6), lane = tid & 63, wr = wid >> 2, wc = wid & 3, fr = lane & 15, fq = lane >> 4;
    const int K = g.K, nt = K / BK;
    int ts_lo = 0, ts_hi = 0, nts = 0; const unsigned long long rt_entry = STAMP ? (unsigned long long)wall_clock64() : 0ull;
#define PG8_STAMP() do { if (STAMP && wid == 0 && nts < 64) { const unsigned long long _c = (unsigned long long)clock64(); \
        ts_lo = (lane == nts) ? (int)(unsigned)_c : ts_lo; ts_hi = (lane == nts) ? (int)(unsigned)(_c >> 32) : ts_hi; ++nts; } } while (0)
    PG8_STAMP();
    unsigned voffA[2], voffB[2];
#pragma unroll
    for (int i = 0; i < 2; ++i) { int R, C; stage_rc(tid * 16 + i * 8192, R, C); const int Rb = Epi::PERM ? ((R & ~31) + perm32(R & 31)) : R;
        voffA[i] = (unsigned)(R * K + C) * 2u; voffB[i] = (unsigned)(Rb * K + C) * 2u; }
    const size_t kstep = (size_t)(BK * 2);
    const size_t hstep = (size_t)HALF * K * 2;
    const size_t tstep = 2 * hstep;
    const unsigned ldsw = (unsigned)wid * 1024u;
    const int aoff = lds_byte(wr * 64 + fr, fq * 8), boff = lds_byte(wc * 32 + fr, fq * 8);
#define PG8_SA(b, h) (((b) * 2 + (h)) * HTB)
#define PG8_SB(b, h) ((4 + (b) * 2 + (h)) * HTB)
#define PG8_STAGE(bufoff, gbase, voff) do { _Pragma("unroll") for (int _i = 0; _i < 2; ++_i) \
        __builtin_amdgcn_global_load_lds((const unsigned*)((const char*)(gbase) + (voff)[_i]), (PG8_LAS unsigned*)(lds + (bufoff) + ldsw + _i * 8192), 16, 0, 0); } while (0)
#define PG8_LDA(dst, b, h) do { _Pragma("unroll") for (int m = 0; m < 4; ++m) _Pragma("unroll") for (int k = 0; k < 2; ++k) dst[m][k] = *(const PG8_LAS bf16x8*)(lds + PG8_SA(b, h) + aoff + m * 2048 + k * 1024); } while (0)
#define PG8_LDB(dst, b, h) do { _Pragma("unroll") for (int n = 0; n < 2; ++n) _Pragma("unroll") for (int k = 0; k < 2; ++k) dst[n][k] = *(const PG8_LAS bf16x8*)(lds + PG8_SB(b, h) + boff + n * 2048 + k * 1024); } while (0)
#define PG8_MMA(ai, bj, At, Bt) do { __builtin_amdgcn_s_setprio(1); _Pragma("unroll") for (int m = 0; m < 4; ++m) _Pragma("unroll") for (int n = 0; n < 2; ++n) _Pragma("unroll") for (int k = 0; k < 2; ++k) \
        acc[ai][bj][m][n] = __builtin_amdgcn_mfma_f32_16x16x32_bf16(Bt[n][k], At[m][k], acc[ai][bj][m][n], 0, 0, 0); __builtin_amdgcn_s_setprio(0); } while (0)
#define PG8_WAIT_V(n) asm volatile("s_waitcnt vmcnt(" #n ")" ::: "memory")
#define PG8_WAIT_L(n) asm volatile("s_waitcnt lgkmcnt(" #n ")" ::: "memory")
#define PG8_BAR __builtin_amdgcn_s_barrier()
#define PG8_SCHED __builtin_amdgcn_sched_barrier(0)
    Unit cur, nxt; int ui = 0;
    if (!S.next(0, cur)) return;
    f32x4 acc[2][2][4][2];
#pragma unroll
    for (int a = 0; a < 2; ++a)
#pragma unroll
        for (int b = 0; b < 2; ++b)
#pragma unroll
            for (int m = 0; m < 4; ++m)
#pragma unroll
                for (int n = 0; n < 2; ++n) acc[a][b][m][n] = (f32x4){0.f, 0.f, 0.f, 0.f};
    bf16x8 At[4][2], B0[2][2], B1[2][2];
    const char* cA = (const char*)g.A + (size_t)cur.pm * tstep; const char* cB = (const char*)g.Bt + (size_t)cur.pn * tstep;
    S.a_ready(cur);
    PG8_STAGE(PG8_SB(0, 0), cB, voffB); PG8_STAGE(PG8_SA(0, 0), cA, voffA); PG8_STAGE(PG8_SB(0, 1), cB + hstep, voffB); PG8_STAGE(PG8_SA(0, 1), cA + hstep, voffA);
    if (wr == 1) PG8_BAR;
    PG8_WAIT_V(4); PG8_BAR;
    PG8_STAGE(PG8_SB(1, 0), cB + kstep, voffB); PG8_STAGE(PG8_SA(1, 0), cA + kstep, voffA); PG8_STAGE(PG8_SB(1, 1), cB + hstep + kstep, voffB);
    PG8_WAIT_V(6); PG8_BAR;
    PG8_STAMP();
    for (;;) {
        const bool has_next = S.next(ui + 1, nxt);
        const char* nA = has_next ? (const char*)g.A + (size_t)nxt.pm * tstep : cA; const char* nB = has_next ? (const char*)g.Bt + (size_t)nxt.pn * tstep : cB;
        for (int t = 0; t < nt; t += 2) {
            const bool last = (t == nt - 2);
            const char* a1 = cA + (size_t)(t + 1) * kstep;
            const char* a2 = last ? nA : cA + (size_t)(t + 2) * kstep; const char* b2 = last ? nB : cB + (size_t)(t + 2) * kstep;
            const char* a3 = a2 + kstep; const char* b3 = b2 + kstep;
            if (last && has_next) S.a_ready(nxt);
            PG8_LDB(B0, 0, 0); PG8_SCHED; PG8_LDA(At, 0, 0); PG8_STAGE(PG8_SA(1, 1), a1 + hstep, voffA);
            PG8_WAIT_L(8); PG8_BAR; PG8_WAIT_L(0); PG8_MMA(0, 0, At, B0); PG8_BAR; PG8_SCHED;
            PG8_LDB(B1, 0, 1); PG8_STAGE(PG8_SB(0, 0), b2, voffB);
            PG8_BAR; PG8_WAIT_L(0); PG8_MMA(0, 1, At, B1); PG8_BAR;
            PG8_LDA(At, 0, 1); PG8_STAGE(PG8_SA(0, 0), a2, voffA);
            PG8_BAR; PG8_WAIT_L(0); PG8_MMA(1, 0, At, B0); PG8_BAR; PG8_SCHED;
            PG8_STAGE(PG8_SB(0, 1), b2 + hstep, voffB);
            PG8_WAIT_V(6); PG8_BAR; PG8_MMA(1, 1, At, B1); PG8_BAR;
            PG8_LDB(B0, 1, 0); PG8_SCHED; PG8_LDA(At, 1, 0); PG8_STAGE(PG8_SA(0, 1), a2 + hstep, voffA);
            PG8_WAIT_L(8); PG8_BAR; PG8_WAIT_L(0); PG8_MMA(0, 0, At, B0); PG8_BAR; PG8_SCHED;
            PG8_LDB(B1, 1, 1); PG8_STAGE(PG8_SB(1, 0), b3, voffB);
            PG8_BAR; PG8_WAIT_L(0); PG8_MMA(0, 1, At, B1); PG8_BAR;
            PG8_LDA(At, 1, 1); PG8_STAGE(PG8_SA(1, 0), a3, voffA);
            PG8_BAR; PG8_WAIT_L(0); PG8_MMA(1, 0, At, B0); PG8_BAR; PG8_SCHED;
            PG8_STAGE(PG8_SB(1, 1), b3 + hstep, voffB);
            PG8_WAIT_V(6); PG8_BAR; PG8_MMA(1, 1, At, B1); PG8_BAR;
        }
        PG8_STAMP();
        if constexpr (!Epi::AFTER_DRAIN) { E(acc, cur, wr, wc, fr, fq); S.done(cur); }
        PG8_STAMP();
        if (!has_next) break;
#pragma unroll
        for (int a = 0; a < 2; ++a)
#pragma unroll
            for (int b = 0; b < 2; ++b)
#pragma unroll
                for (int m = 0; m < 4; ++m)
#pragma unroll
                    for (int n = 0; n < 2; ++n) acc[a][b][m][n] = (f32x4){0.f, 0.f, 0.f, 0.f};
        cur = nxt; cA = nA; cB = nB; ++ui;
    }
    PG8_WAIT_V(0);
    if (wr == 0) PG8_BAR;
    PG8_BAR;
    if constexpr (Epi::AFTER_DRAIN) { E.fused(acc, cur, wr, wc, fr, fq, lds, wid, lane); S.done(cur); }
    PG8_STAMP();
    if (STAMP && wid == 0) { stamps[lane] = lane < nts ? (((unsigned long long)(unsigned)ts_hi << 32) | (unsigned)ts_lo) : 0ull;
        if (lane == 62) stamps[62] = rt_entry; if (lane == 63) stamps[63] = (unsigned long long)wall_clock64(); }
#undef PG8_STAMP
#undef PG8_SA
#undef PG8_SB
#undef PG8_STAGE
#undef PG8_LDA
#undef PG8_LDB
#undef PG8_MMA
#undef PG8_WAIT_V
#undef PG8_WAIT_L
#undef PG8_BAR
#undef PG8_SCHED
}
}

#define XB_TMO      128
#define XB_XCNT(j)  (256  + 64 * (j))
#define XB_XSUB(j)  (1280 + 64 * (j))
#define XB_XGEN(j)  (2304 + 64 * (j))
#define XB_TOP      3328
#define XB_TOPGEN   3392
#define XCD_BAR_WORDS 3456
#define XB_SPIN_CAP (1u << 22)

__device__ __forceinline__ unsigned xb_ld(unsigned* p)              { return __hip_atomic_load(p, __ATOMIC_RELAXED, __HIP_MEMORY_SCOPE_AGENT); }
__device__ __forceinline__ unsigned xb_add(unsigned* p, unsigned v) { return __hip_atomic_fetch_add(p, v, __ATOMIC_RELAXED, __HIP_MEMORY_SCOPE_AGENT); }
__device__ __forceinline__ unsigned xb_xcc_id() { return (unsigned)__builtin_amdgcn_s_getreg((3 << 11) | 20) & 0xFu; }
#define XB_SPIN(cond, bar) do { unsigned _sp = 0; while (cond) { __builtin_amdgcn_s_sleep(1); \
    if ((++_sp & 255u) == 0u) { if (xb_ld(&(bar)[XB_TMO])) break; if (_sp > XB_SPIN_CAP) { atomicAdd(&(bar)[XB_TMO], 1u); break; } } } } while (0)

struct XcdBarrier {
    unsigned* bar; unsigned x;
    volatile LAS unsigned* st;
};

__device__ __forceinline__ XcdBarrier xcd_barrier_post(unsigned* bar, volatile LAS unsigned* st) {
    XcdBarrier b; b.bar = bar; b.x = xb_xcc_id(); b.st = st;
    if (threadIdx.x == 0) (void)xb_add(&bar[XB_XCNT(b.x)], 1u);
    return b;
}
__device__ __forceinline__ void xcd_barrier_complete(unsigned* bar, unsigned x, unsigned& nloc, unsigned& nx) {
    const unsigned G = gridDim.x * gridDim.y * gridDim.z;
    unsigned sum, cnt, mine, sp = 0u;
    for (;;) {
        sum = 0u; cnt = 0u; mine = 0u;
#pragma unroll
        for (unsigned j = 0; j < 16; ++j) { const unsigned c = xb_ld(&bar[XB_XCNT(j)]); sum += c; cnt += (c > 0u) ? 1u : 0u; mine = (j == x) ? c : mine; }
        if (sum == G) break;
        __builtin_amdgcn_s_sleep(1);
        if ((++sp & 255u) == 0u) { if (xb_ld(&bar[XB_TMO])) break; if (sp > XB_SPIN_CAP) { atomicAdd(&bar[XB_TMO], 1u); break; } }
    }
    nloc = mine > 0u ? mine : 1u; nx = cnt > 0u ? cnt : 1u;
}

__device__ __forceinline__ void xcd_barrier(const XcdBarrier& b) {
    asm volatile("s_waitcnt vmcnt(0)" ::: "memory");
    __syncthreads();
    if (threadIdx.x == 0) {
        unsigned* bar = b.bar;
        __builtin_amdgcn_s_waitcnt(0);
        unsigned nloc = b.st[0], nx = b.st[1];
        if (nloc == 0u) { xcd_barrier_complete(bar, b.x, nloc, nx); b.st[0] = nloc; b.st[1] = nx; }
        const unsigned old = xb_add(&bar[XB_XSUB(b.x)], 1u);
        const unsigned gen = old / nloc;
        if (old + 1u == (gen + 1u) * nloc) {
            __builtin_amdgcn_fence(__ATOMIC_RELEASE, "agent");
            asm volatile("s_waitcnt vmcnt(0)" ::: "memory");
            const unsigned og = xb_add(&bar[XB_TOP], 1u);
            const unsigned tg = og / nx;
            if (og + 1u == (tg + 1u) * nx) xb_add(&bar[XB_TOPGEN], 1u);
            else XB_SPIN(xb_ld(&bar[XB_TOPGEN]) == tg, bar);
            __builtin_amdgcn_fence(__ATOMIC_ACQUIRE, "agent");
            xb_add(&bar[XB_XGEN(b.x)], 1u);
            asm volatile("s_waitcnt vmcnt(0)" ::: "memory");
        } else {
            XB_SPIN(xb_ld(&bar[XB_XGEN(b.x)]) == gen, bar);
            __builtin_amdgcn_fence(__ATOMIC_ACQUIRE, "agent");
            asm volatile("s_waitcnt vmcnt(0)" ::: "memory");
        }
    }
    __syncthreads();
}

constexpr int P0_GEMV = 768;
constexpr int P0_TR0 = P0_GEMV;
constexpr int P0_TR_TOTAL = 256 + 512 + 672 + 256 + 256 + 256 + 64 + 64;
constexpr int P0_CV0 = P0_TR0 + P0_TR_TOTAL;
constexpr int CV_PU = 0, CV_PV = 0, CV_SK = 64;
constexpr int P0_PB0 = P0_CV0 + CV_PU + CV_PV + CV_SK;
constexpr int P0_S50 = P0_PB0 + 32;
constexpr int P0_TOTAL = P0_S50 + 128;

DI void p0_gemv(ArgsP a, int item, LAS float* sm) {
    const int tid = threadIdx.x, lane = tid & 63, wave = tid >> 6, layer = item / 384, n0 = (item % 384) * 32, col = lane & 31, par = lane >> 5;
    const float* c = a->in[1];
    __syncthreads();
    for (int k = tid; k < DM; k += NT) { const float cv = c[k]; sm[k] = cv / (1.0f + __expf(-cv)); }
    __syncthreads();
    const float* W = a->in[2] + (size_t)layer * DM * 12288 + n0 + col;
    float acc = 0.f;
    const int k0 = wave * 256 + par;
#pragma unroll 1
    for (int kk = 0; kk < 256; kk += 64) {
        float w[32];
#pragma unroll
        for (int j = 0; j < 32; ++j) w[j] = W[(size_t)(k0 + kk + 2 * j) * 12288];
#pragma unroll
        for (int j = 0; j < 32; ++j) acc += sm[k0 + kk + 2 * j] * w[j];
    }
    acc += __shfl_xor(acc, 32);
    if (lane < 32) sm[DM + wave * 32 + lane] = acc;
    __syncthreads();
    if (tid < 32) { float s = 0.f;
#pragma unroll
        for (int w = 0; w < 8; ++w) s += sm[DM + w * 32 + tid];
        ((float*)(a->ws + WS_MOD))[layer * 12288 + n0 + tid] = s + a->in[3][layer * 12288 + n0 + tid]; }
}

DI void p0_transpose(ArgsP a, int idx, LAS float* sm) {
    int mat, base;
    if (idx < 256) { mat = 0; base = 0; } else if (idx < 768) { mat = 1; base = 256; } else if (idx < 1440) { mat = 2; base = 768; } else if (idx < 1696) { mat = 3; base = 1440; }
    else if (idx < 1952) { mat = 4; base = 1696; } else if (idx < 2208) { mat = 5; base = 1952; } else if (idx < 2272) { mat = 6; base = 2208; } else { mat = 7; base = 2272; }
    int N = 2048, K = 2048, Nsrc = 2048; const float* src = nullptr; bf16_t* dst = nullptr;
    switch (mat) {
        case 0: src = a->in[7];  dst = (bf16_t*)(a->ws + WS_WT_SIN);  N = 2048; K = 2048; Nsrc = 2048; break;
        case 1: src = a->in[16]; dst = (bf16_t*)(a->ws + WS_WT_SOUT); N = 4096; K = 2048; Nsrc = 4096; break;
        case 2: src = a->in[17]; dst = (bf16_t*)(a->ws + WS_WT_NIN);  N = 5376; K = 2048; Nsrc = 5168; break;
        case 3: src = a->in[24]; dst = (bf16_t*)(a->ws + WS_WT_NOUT); N = 2048; K = 2048; Nsrc = 2048; break;
        case 4: src = a->in[25]; dst = (bf16_t*)(a->ws + WS_WT_PQ);   N = 2048; K = 2048; Nsrc = 2048; break;
        case 5: src = a->in[25] + (size_t)DM * DM; dst = (bf16_t*)(a->ws + WS_WT_PQ) + (size_t)DM * DM; N = 2048; K = 2048; Nsrc = 2048; break;
        case 6: src = a->in[19]; dst = (bf16_t*)(a->ws + WS_CW1T); N = 128; K = 4096; Nsrc = 128; break;
        default: src = a->in[22]; dst = (bf16_t*)(a->ws + WS_CW1T) + (size_t)128 * 4096; N = 128; K = 4096; Nsrc = 128; break;
    }
    const int li = idx - base, ntn = (N + 255) / 256, nt = li % ntn, kt = li / ntn, k0 = kt * 64, nd0 = nt * 256;
    const int tid = threadIdx.x;
    __syncthreads();
#pragma unroll
    for (int it = 0; it < 8; ++it) {
        const int k = it * 8 + (tid >> 6), nl = (tid & 63) * 4;
        int ns = nd0 + nl;
        if (mat == 1) ns = (nl < 128) ? (128 * nt + nl) : (2048 + 128 * nt + nl - 128);
        f32x4 v = {0.f, 0.f, 0.f, 0.f};
        if (ns < Nsrc) v = *(const f32x4*)(src + (size_t)(k0 + k) * Nsrc + ns);
        LAS float* p = sm + k * 257 + nl; p[0] = v[0]; p[1] = v[1]; p[2] = v[2]; p[3] = v[3];
    }
    __syncthreads();
#pragma unroll
    for (int it = 0; it < 4; ++it) {
        const int c = it * 512 + tid, nl = c >> 3, k8 = (c & 7) * 8;
        if (nd0 + nl < N) {
            u32x4 w;
            w.x = pk_bf16(sm[(k8 + 0) * 257 + nl], sm[(k8 + 1) * 257 + nl]); w.y = pk_bf16(sm[(k8 + 2) * 257 + nl], sm[(k8 + 3) * 257 + nl]);
            w.z = pk_bf16(sm[(k8 + 4) * 257 + nl], sm[(k8 + 5) * 257 + nl]); w.w = pk_bf16(sm[(k8 + 6) * 257 + nl], sm[(k8 + 7) * 257 + nl]);
            *(u32x4*)(dst + (size_t)(nd0 + nl) * K + k0 + k8) = w;
        }
    }
}

DI void p0_convert(const float* src, bf16_t* dst, int item) {
    const size_t e0 = (size_t)item * 8192 + (size_t)threadIdx.x * 8;
#pragma unroll
    for (int h = 0; h < 2; ++h) {
        const size_t e = e0 + (size_t)h * 4096;
        const f32x4 v0 = *(const f32x4*)(src + e), v1 = *(const f32x4*)(src + e + 4);
        u32x4 w; w.x = pk_bf16(v0[0], v0[1]); w.y = pk_bf16(v0[2], v0[3]); w.z = pk_bf16(v1[0], v1[1]); w.w = pk_bf16(v1[2], v1[3]);
        *(u32x4*)(dst + e) = w;
    }
}

DI u32 fp6_e2m3(float x) {
    const u32 b = __float_as_uint(x), sgn = (b >> 26) & 0x20u; const float ax = fabsf(x);
    const u32 ab = b & 0x7fffffffu;
    const u32 nrm = ((ab + 0x7ffffu + ((ab >> 20) & 1u)) >> 20) - ((127u - 1u) << 3);
    const u32 sub = (u32)__float2int_rn(ax * 8.0f);
    u32 c = (ax < 1.0f) ? sub : nrm; c = c > 31u ? 31u : c;
    return sgn | c;
}
DI void p0_quant_load(f32x4 (&v)[8], const float* src, int row, int lane) {
    const float* sp = src + (size_t)row * DM + 4 * lane;
#pragma unroll
    for (int j = 0; j < 8; ++j) v[j] = *(const f32x4*)(sp + 256 * j);
}
typedef unsigned u32x6 __attribute__((ext_vector_type(6)));
#ifndef FP6_PACK_SEQ
#define FP6_PACK_SEQ 0
#endif
DI void p0_quant_emit(const f32x4 (&v)[8], unsigned char* dst, float* inv_scale, int row, int lane) {
    float mx = 0.f;
#pragma unroll
    for (int j = 0; j < 8; ++j) mx = fmaxf(mx, fmaxf(fmaxf(fabsf(v[j][0]), fabsf(v[j][1])), fmaxf(fabsf(v[j][2]), fabsf(v[j][3]))));
#pragma unroll
    for (int o = 32; o >= 1; o >>= 1) mx = fmaxf(mx, __shfl_xor(mx, o));
    const float sc = (mx > 0.f) ? 7.5f / mx : 1.0f;
    f32x16 s0, s1;
#pragma unroll
    for (int j = 0; j < 16; ++j) {
        const int e0 = FP6_PACK_SEQ ? j : 2 * j, e1 = FP6_PACK_SEQ ? 16 + j : 2 * j + 1;
        s0[j] = v[e0 >> 2][e0 & 3] * sc; s1[j] = v[e1 >> 2][e1 & 3] * sc; }
    const u32x6 pk = __builtin_amdgcn_cvt_scalef32_2xpk16_fp6_f32(s0, s1, 1.0f);
    unsigned char* dp = dst + (size_t)row * PEER_ROWB;
    *(u32x4*)(dp + 16 * lane) = (u32x4){pk[0], pk[1], pk[2], pk[3]}; *(u32x2*)(dp + 1024 + 8 * lane) = (u32x2){pk[4], pk[5]};
    if (lane == 0) inv_scale[row] = (mx > 0.f) ? mx * (1.0f / 7.5f) : 1.0f;
}
DI void p0_quant_rows(ArgsP a, int r_lo, int r_hi, int wv, int nwv) {
    const int lane = threadIdx.x & 63;
#pragma unroll 1
    for (int tb = 0; tb < 2; ++tb) {
        const float* src = a->in[27 + tb]; unsigned char* dst = a->ws + (tb ? WS_PV : WS_PU); float* isc = (float*)(a->ws + WS_PSC) + tb * 2 * 16384;
        const int per = (r_hi - r_lo + nwv - 1) / nwv, r0 = r_lo + wv * per, rend = (r0 + per < r_hi) ? (r0 + per) : r_hi;
#pragma unroll 1
        for (int row = r0; row < rend; row += 4) {
            f32x4 v0[8], v1[8], v2[8], v3[8];
            p0_quant_load(v0, src, row, lane);
            if (row + 1 < rend) p0_quant_load(v1, src, row + 1, lane);
            if (row + 2 < rend) p0_quant_load(v2, src, row + 2, lane);
            if (row + 3 < rend) p0_quant_load(v3, src, row + 3, lane);
            p0_quant_emit(v0, dst, isc, row, lane);
            if (row + 1 < rend) p0_quant_emit(v1, dst, isc, row + 1, lane);
            if (row + 2 < rend) p0_quant_emit(v2, dst, isc, row + 2, lane);
            if (row + 3 < rend) p0_quant_emit(v3, dst, isc, row + 3, lane);
        }
    }
}
DI void p0_quant_all(ArgsP a) { p0_quant_rows(a, 0, 32768, blockIdx.x * 8 + (threadIdx.x >> 6), gridDim.x * 8); }

DI void p0_posb(ArgsP a, int item, LAS float* sm) {
    const int kv = item >> 4, sl = item & 15;
    const float* pos = a->in[kv ? 21 : 18]; const float* w1 = a->in[kv ? 22 : 19];
    const int tid = threadIdx.x, h = tid & 127, part = tid >> 7, i0 = sl * 256 + part * 64;
    float acc0 = 0.f, acc1 = 0.f, acc2 = 0.f, acc3 = 0.f;
#pragma unroll 4
    for (int i = 0; i < 64; i += 4) {
        acc0 += pos[i0 + i] * w1[(size_t)(i0 + i) * 128 + h];         acc1 += pos[i0 + i + 1] * w1[(size_t)(i0 + i + 1) * 128 + h];
        acc2 += pos[i0 + i + 2] * w1[(size_t)(i0 + i + 2) * 128 + h]; acc3 += pos[i0 + i + 3] * w1[(size_t)(i0 + i + 3) * 128 + h]; }
    __syncthreads();
    sm[tid] = (acc0 + acc1) + (acc2 + acc3); __syncthreads();
    if (tid < 128) ((float*)(a->ws + WS_PBP))[(kv * 16 + sl) * 128 + tid] = (sm[tid] + sm[tid + 128]) + (sm[tid + 256] + sm[tid + 384]);
}

DI void p0_s5tab(ArgsP a, int g);
template <int ONLY> DI void phase_prep(ArgsP a, LAS unsigned char* lds) {
    LAS float* sm = (LAS float*)lds;
    for (int item = blockIdx.x; item < P0_TOTAL; item += gridDim.x) {
        if (ONLY == 1 && item >= P0_GEMV) break;
        if (ONLY == 2 && (item < P0_GEMV || item >= P0_CV0)) continue;
        if (ONLY == 3) break;
        if (item < P0_GEMV) p0_gemv(a, item, sm);
        else if (item < P0_CV0) p0_transpose(a, item - P0_TR0, sm);
        else if (item < P0_PB0) p0_convert(a->in[26], (bf16_t*)(a->ws + WS_SUBK), item - P0_CV0 - CV_PU - CV_PV);
        else if (item < P0_S50) p0_posb(a, item - P0_PB0, sm);
        else p0_s5tab(a, item - P0_S50);
    }
    if (ONLY == 3) p0_quant_all(a);
}

DI void phase_norm(const float* x, const float* gamma, const float* shift, const float* scale, bf16_t* H) {
    const int lane = threadIdx.x & 63, wave = threadIdx.x >> 6;
    for (int row = blockIdx.x * 8 + wave; row < SEQ; row += gridDim.x * 8) {
        const float* xr = x + (size_t)row * DM;
        f32x4 v[8]; float ss = 0.f;
#pragma unroll
        for (int j = 0; j < 8; ++j) { v[j] = *(const f32x4*)(xr + 4 * lane + 256 * j); ss += v[j][0] * v[j][0] + v[j][1] * v[j][1] + v[j][2] * v[j][2] + v[j][3] * v[j][3]; }
        ss = wave_sum(ss);
        const float rstd = rsqrtf(ss * (1.0f / DM) + 1e-6f);
#pragma unroll
        for (int j = 0; j < 8; ++j) {
            const int col = 4 * lane + 256 * j;
            const f32x4 g = *(const f32x4*)(gamma + col), sc = *(const f32x4*)(scale + col), sh = *(const f32x4*)(shift + col);
            float o[4];
#pragma unroll
            for (int i = 0; i < 4; ++i) o[i] = (v[j][i] * rstd * g[i]) * (1.0f + sc[i]) + sh[i];
            u32x2 w; w.x = pk_bf16(o[0], o[1]); w.y = pk_bf16(o[2], o[3]);
            *(u32x2*)(H + (size_t)row * DM + col) = w;
        }
    }
}

DI void s5_abar(ArgsP a, int g, int n, float& ar, float& ai, float& cr, float& ci) {
    const float lre = a->in[8][g * 64 + n], lim = a->in[9][g * 64 + n], dt = expf(a->in[10][g]);
    const float mag = expf(lre * dt); ar = mag * cosf(lim * dt); ai = mag * sinf(lim * dt);
    const float den = lre * lre + lim * lim;
    cr = ((ar - 1.0f) * lre + ai * lim) / den; ci = (ai * lre - (ar - 1.0f) * lim) / den;
}
DI void p0_s5tab(ArgsP a, int g) {
    const int tid = threadIdx.x;
    { const int c = tid >> 2, p0 = (tid & 3) * 4, n = c & 63, part = c >> 6;
      float ar, ai, cr, ci; s5_abar(a, g, n, ar, ai, cr, ci);
      const float* br = a->in[11] + (size_t)(g * 64 + n) * 16 + p0; const float* bi = a->in[12] + (size_t)(g * 64 + n) * 16 + p0;
      float v[4];
#pragma unroll
      for (int j = 0; j < 4; ++j) v[j] = part ? (cr * bi[j] + ci * br[j]) : (cr * br[j] - ci * bi[j]);
      *(u32x2*)((bf16_t*)(a->ws + WS_S5BB) + ((size_t)(g * 128 + c) * 16 + p0)) = (u32x2){pk_bf16(v[0], v[1]), pk_bf16(v[2], v[3])}; }
    { const int p = tid >> 5, k0 = (tid & 31) * 4;
      const float* cre = a->in[13] + (size_t)(g * 16 + p) * 64 + (k0 >> 1); const float* cim = a->in[14] + (size_t)(g * 16 + p) * 64 + (k0 >> 1);
      *(u32x2*)((bf16_t*)(a->ws + WS_S5CT) + ((size_t)(g * 16 + p) * 128 + k0)) = (u32x2){pk_bf16(cre[0], -cim[0]), pk_bf16(cre[1], -cim[1])}; }
}
template <bool FULL> DI void phase_s5(ArgsP a, LAS unsigned char* lds) {
    const int tid = threadIdx.x, lane = tid & 63, wave = tid >> 6, ln = lane & 15, q = lane >> 4;
    const bf16_t* U = (const bf16_t*)(a->ws + WS_BUFA);
    bf16_t* YG = (bf16_t*)(a->ws + WS_BUFB);
    float* Send = (float*)(a->ws + WS_SEND);
    const bf16_t* BBt = (const bf16_t*)(a->ws + WS_S5BB); const bf16_t* CT = (const bf16_t*)(a->ws + WS_S5CT);
    LAS float* BU = (LAS float*)(lds + wave * 12544);
    LAS unsigned char* HB = lds + wave * 12544 + 8192;
    const bf16x8 zero8 = {0, 0, 0, 0, 0, 0, 0, 0};
    for (int bi = blockIdx.x; bi < 256; bi += gridDim.x) {
        const int g = bi >> 1, c = (bi & 1) * 8 + wave;
        if (!FULL && c == 15) continue;
        float ar, ai, cr_, ci_; s5_abar(a, g, lane, ar, ai, cr_, ci_);
        bf16x8 bb[8];
#pragma unroll
        for (int ct = 0; ct < 8; ++ct) bb[ct] = (q < 2) ? *(const bf16x8*)(BBt + ((size_t)(g * 128 + 16 * ct + ln) * 16 + 8 * q)) : zero8;
        bf16x8 cf[4]; float dsk = 0.f;
        if (FULL) {
#pragma unroll
            for (int ks = 0; ks < 4; ++ks) cf[ks] = *(const bf16x8*)(CT + ((size_t)(g * 16 + ln) * 128 + 32 * ks + 8 * q));
            dsk = a->in[15][g * 16 + ln];
        }
        float hr = 0.f, hi = 0.f;
        if (FULL) { float tr = ar, ti = ai;
#pragma unroll
            for (int s = 0; s < 10; ++s) { const float nr = tr * tr - ti * ti, ni = 2.0f * tr * ti; tr = nr; ti = ni; }
#pragma unroll
            for (int cc = 0; cc < 15; ++cc) { const bool on = (cc < c);
                const f32x2v sv = on ? *(const f32x2v*)(Send + ((size_t)(cc * 128 + g) * 64 + lane) * 2) : (f32x2v){0.f, 0.f};
                const float nr = tr * hr - ti * hi + sv.x, ni = tr * hi + ti * hr + sv.y; hr = on ? nr : hr; hi = on ? ni : hi; } }
        const bf16_t* up = U + (size_t)c * 1024 * DM + g * 16;
        bf16_t* yp = YG + (size_t)c * 1024 * DM + g * 16;
#pragma unroll 1
        for (int t0 = 0; t0 < 1024; t0 += 16) {
            const bf16x8 af = (q < 2) ? *(const bf16x8*)(up + (size_t)(t0 + ln) * DM + 8 * q) : zero8;
            bf16_t uraw[4];
            if (FULL) {
#pragma unroll
                for (int i = 0; i < 4; ++i) uraw[i] = up[(size_t)(t0 + 4 * q + i) * DM + ln]; }
            f32x4 acc[8];
#pragma unroll
            for (int ct = 0; ct < 8; ++ct) acc[ct] = __builtin_amdgcn_mfma_f32_16x16x32_bf16(af, bb[ct], (f32x4){0.f, 0.f, 0.f, 0.f}, 0, 0, 0);
            asm volatile("" :: "v"(af));
#pragma unroll
            for (int ct = 0; ct < 4; ++ct)
#pragma unroll
                for (int i = 0; i < 4; ++i) *(LAS f32x2v*)(BU + ((4 * q + i) * 64 + 16 * ct + ln) * 2) = (f32x2v){acc[ct][i], acc[ct + 4][i]};
            asm volatile("s_waitcnt lgkmcnt(0)" ::: "memory");
#pragma unroll
            for (int tl = 0; tl < 16; ++tl) {
                const f32x2v b = *(const LAS f32x2v*)(BU + (tl * 64 + lane) * 2);
                const float nr = ar * hr - ai * hi + b.x, ni = ar * hi + ai * hr + b.y; hr = nr; hi = ni;
                if (FULL) *(LAS s16x2*)(HB + tl * 272 + lane * 4) = __builtin_bit_cast(s16x2, pk_bf16(hr, hi));
            }
            asm volatile("s_waitcnt lgkmcnt(0)" ::: "memory");
            if (FULL) {
                f32x4 y = {0.f, 0.f, 0.f, 0.f};
#pragma unroll
                for (int ks = 0; ks < 4; ++ks) { const bf16x8 ah = *(const LAS bf16x8*)(HB + ln * 272 + (32 * ks + 8 * q) * 2); y = __builtin_amdgcn_mfma_f32_16x16x32_bf16(ah, cf[ks], y, 0, 0, 0); asm volatile("" :: "v"(ah)); }
#pragma unroll
                for (int i = 0; i < 4; ++i) { const size_t o = (size_t)(t0 + 4 * q + i) * DM + ln; const float uv = bf2f(uraw[i]); yp[o] = f2bf(gelu_tanh(y[i] + dsk * uv)); }
                asm volatile("s_waitcnt lgkmcnt(0)" ::: "memory");
            }
        }
        if (!FULL) { Send[((size_t)(c * 128 + g) * 64 + lane) * 2] = hr; Send[((size_t)(c * 128 + g) * 64 + lane) * 2 + 1] = hi; }
    }
}

DI int imax3(int a, int b, int c) { return max(max(a, b), c); }
template <int N> DI int imax_tree(const int (&k)[N]) {
    if constexpr (N == 1) return k[0];
    else if constexpr (N == 2) return max(k[0], k[1]);
    else { constexpr int M = (N + 2) / 3; int t[M];
#pragma unroll
        for (int i = 0; i < M; ++i) { const int a = k[3 * i], b = (3 * i + 1 < N) ? k[3 * i + 1] : a, c = (3 * i + 2 < N) ? k[3 * i + 2] : a; t[i] = imax3(a, b, c); }
        return imax_tree<M>(t); }
}
DI void ce_desc(int& a, int& b) { const int hi = max(a, b), lo = min(a, b); a = hi; b = lo; }
DI void bitonic_merge16_desc(int (&v)[16]) {
#pragma unroll
    for (int j = 8; j > 0; j >>= 1)
#pragma unroll
        for (int i = 0; i < 16; ++i) if ((i & j) == 0) ce_desc(v[i], v[i | j]);
}
DI void sort16_desc(int (&v)[16]) {
#pragma unroll
    for (int k = 2; k <= 16; k <<= 1)
#pragma unroll
        for (int j = k >> 1; j > 0; j >>= 1)
#pragma unroll
            for (int i = 0; i < 16; ++i) { const int l = i ^ j;
                if (l > i) { if ((i & k) == 0 || k == 16) ce_desc(v[i], v[l]); else ce_desc(v[l], v[i]); } }
}
DI void top16_of_two(int (&a)[16], const int (&b)[16]) {
#pragma unroll
    for (int i = 0; i < 16; ++i) a[i] = max(a[i], b[15 - i]);
    bitonic_merge16_desc(a);
}
DI int ord_key(float f) { int b = __float_as_int(f); return b ^ ((b >> 31) & 0x7fffffff); }
DI float ord_val(int k) { return __int_as_float(k ^ ((k >> 31) & 0x7fffffff)); }

DI void phase_route(ArgsP a, int layer, LAS unsigned char* lds) {
    const int tid = threadIdx.x, lane = tid & 63, wave = tid >> 6, l32 = lane & 31, hf = lane >> 5;
    const bf16_t* Q = (const bf16_t*)(a->ws + WS_BUFA);
    const bf16_t* SK = (const bf16_t*)(a->ws + WS_SUBK) + (size_t)layer * 8 * 2 * 128 * 128;
    int* EXPv = (int*)(a->ws + WS_EXP); float* GATE = (float*)(a->ws + WS_GATE);
    LAS unsigned char* skl = lds;
    LAS int* top = (LAS int*)(lds + 69632 + wave * 8192);
    for (int item = blockIdx.x; item < 512; item += gridDim.x) {
        const int h = item & 7, tg = item >> 3, tt = tg * 8 + wave, t0 = tt * 32;
        __syncthreads();
#pragma unroll
        for (int it = 0; it < 8; ++it) { const int c16 = it * 512 + tid, row = c16 >> 4, ch = c16 & 15;
            *(LAS u32x4*)(skl + row * 272 + ch * 16) = *(const u32x4*)(SK + ((size_t)h * 256 + row) * 128 + ch * 8); }
        __syncthreads();
        int k1[16], k2[16];
#pragma unroll 1
        for (int c = 0; c < 2; ++c) {
            f32x16 acc[4];
#pragma unroll
            for (int kt = 0; kt < 4; ++kt)
#pragma unroll
                for (int i = 0; i < 16; ++i) acc[kt][i] = 0.f;
            const bf16_t* qp = Q + (size_t)(t0 + l32) * DM + h * 256 + c * 128 + hf * 8;
            const LAS unsigned char* kp = skl + (c * 128 + l32) * 272 + hf * 16;
#pragma unroll
            for (int ks = 0; ks < 8; ++ks) {
                const bf16x8 bq = *(const bf16x8*)(qp + ks * 16);
#pragma unroll
                for (int kt = 0; kt < 4; ++kt) { const bf16x8 ak = *(const LAS bf16x8*)(kp + kt * 32 * 272 + ks * 32); acc[kt] = __builtin_amdgcn_mfma_f32_32x32x16_bf16(ak, bq, acc[kt], 0, 0, 0); }
            }
            int g0[16], g1[16], g2[16], g3[16];
#pragma unroll
            for (int i = 0; i < 16; ++i) { const int kb_ = 8 * (i >> 2) + (i & 3) + 4 * hf;
                g0[i] = (ord_key(acc[0][i]) & ~127) | (127 - (kb_));      g1[i] = (ord_key(acc[1][i]) & ~127) | (127 - (32 + kb_));
                g2[i] = (ord_key(acc[2][i]) & ~127) | (127 - (64 + kb_)); g3[i] = (ord_key(acc[3][i]) & ~127) | (127 - (96 + kb_)); }
            sort16_desc(g0); sort16_desc(g1); sort16_desc(g2); sort16_desc(g3);
            top16_of_two(g0, g1); top16_of_two(g2, g3); top16_of_two(g0, g2);
            int pr[16];
#pragma unroll
            for (int i = 0; i < 16; ++i) pr[i] = __shfl_xor(g0[i], 32);
            top16_of_two(g0, pr);
#pragma unroll
            for (int i = 0; i < 16; ++i) { if (c == 0) k1[i] = g0[i]; else k2[i] = g0[i]; }
        }
        int ck[50], ce[50];
        {
            int n = 0;
#pragma unroll
            for (int aa = 0; aa < 16; ++aa)
#pragma unroll
                for (int bb = 0; bb < 16; ++bb)
                    if ((aa + 1) * (bb + 1) <= 16) {
                        const float s = ord_val(k1[aa] & ~127) + ord_val(k2[bb] & ~127);
                        ck[n] = (ord_key(s) & ~63) | (63 - n);
                        ce[n] = (127 - (k1[aa] & 127)) * 128 + (127 - (k2[bb] & 127));
                        ++n;
                    }
        }
#pragma unroll 1
        for (int r = 0; r < 16; ++r) {
            const int m = imax_tree<50>(ck);
            int e = 0;
#pragma unroll
            for (int i = 0; i < 50; ++i) { const bool hit = (ck[i] == m); e = hit ? ce[i] : e; ck[i] = hit ? (int)0x80000000 : ck[i]; }
            if (hf == 0) { top[1024 + (l32 * 16 + r) * 2] = m & ~63; top[1024 + (l32 * 16 + r) * 2 + 1] = e; }
        }
        if (hf == 0) {
            float sv[16]; int ev[16]; float mx = -3.0e38f;
#pragma unroll
            for (int i = 0; i < 16; ++i) { sv[i] = ord_val(top[1024 + (l32 * 16 + i) * 2]); ev[i] = top[1024 + (l32 * 16 + i) * 2 + 1]; mx = fmaxf(mx, sv[i]); }
            float sum = 0.f;
#pragma unroll
            for (int i = 0; i < 16; ++i) { sv[i] = __expf(sv[i] - mx); sum += sv[i]; }
            const float inv = 1.0f / sum;
            int* ep = EXPv + (size_t)(t0 + l32) * 128 + h * 16; float* gp = GATE + (size_t)(t0 + l32) * 128 + h * 16;
#pragma unroll
            for (int i = 0; i < 16; i += 4) { *(f32x4*)(gp + i) = (f32x4){sv[i] * inv, sv[i + 1] * inv, sv[i + 2] * inv, sv[i + 3] * inv};
                *(u32x4*)(ep + i) = (u32x4){(u32)ev[i], (u32)ev[i + 1], (u32)ev[i + 2], (u32)ev[i + 3]}; }
        }
    }
}

typedef float f32x32 __attribute__((ext_vector_type(32)));
typedef int i32x6 __attribute__((ext_vector_type(6)));
constexpr int PEER_B = 4;
DI void phase_peer(ArgsP a, int layer, int mode) {
    const int lane = threadIdx.x & 63, wave = threadIdx.x >> 6;
    const bf16_t* H = (const bf16_t*)(a->ws + WS_H);
    const unsigned char* PU = a->ws + WS_PU + (size_t)layer * SEQ * PEER_ROWB;
    const unsigned char* PV = a->ws + WS_PV + (size_t)layer * SEQ * PEER_ROWB;
    const float* SCU = (const float*)(a->ws + WS_PSC) + layer * 16384; const float* SCV = SCU + 2 * 16384;
    const int* EXPv = (const int*)(a->ws + WS_EXP); const float* GATE = (const float*)(a->ws + WS_GATE);
    float* XA = (float*)(a->ws + WS_XA);
    const float* g2 = (const float*)(a->ws + WS_MOD) + layer * 12288 + 5 * DM;
    for (int t = blockIdx.x * 8 + wave; t < SEQ; t += gridDim.x * 8) {
        float hf[32];
#pragma unroll
        for (int j = 0; j < 8; ++j) { const u32x2 h0 = *(const u32x2*)(H + (size_t)t * DM + 256 * j + 4 * lane);
            hf[4 * j] = bflo(h0.x); hf[4 * j + 1] = bfhi(h0.x); hf[4 * j + 2] = bflo(h0.y); hf[4 * j + 3] = bfhi(h0.y); }
        const int e_lo = EXPv[(size_t)t * 128 + lane], e_hi = EXPv[(size_t)t * 128 + 64 + lane];
        const float g_lo = GATE[(size_t)t * 128 + lane], g_hi = GATE[(size_t)t * 128 + 64 + lane];
        float y[32];
#pragma unroll
        for (int i = 0; i < 32; ++i) y[i] = 0.f;
#pragma unroll 1
        for (int kb = 0; kb < 128; kb += PEER_B) {
            u32x4 ua[PEER_B], va[PEER_B]; u32x2 ub[PEER_B], vb[PEER_B]; float gk[PEER_B], su[PEER_B], sv[PEER_B];
#pragma unroll
            for (int k = 0; k < PEER_B; ++k) {
                const int kk = kb + k;
                const int e = (kk < 64) ? __builtin_amdgcn_readlane(e_lo, kk & 63) : __builtin_amdgcn_readlane(e_hi, kk & 63);
                gk[k] = __int_as_float((kk < 64) ? __builtin_amdgcn_readlane(__float_as_int(g_lo), kk & 63) : __builtin_amdgcn_readlane(__float_as_int(g_hi), kk & 63));
                const unsigned char* up = PU + (size_t)e * PEER_ROWB; const unsigned char* vp = PV + (size_t)e * PEER_ROWB;
                ua[k] = *(const u32x4*)(up + 16 * lane); ub[k] = *(const u32x2*)(up + 1024 + 8 * lane);
                va[k] = *(const u32x4*)(vp + 16 * lane); vb[k] = *(const u32x2*)(vp + 1024 + 8 * lane);
                su[k] = SCU[e]; sv[k] = SCV[e];
            }
            float d[PEER_B];
#pragma unroll
            for (int k = 0; k < PEER_B; ++k) {
                const i32x6 pk = {(int)ua[k][0], (int)ua[k][1], (int)ua[k][2], (int)ua[k][3], (int)ub[k].x, (int)ub[k].y};
                const f32x32 uf = __builtin_amdgcn_cvt_scalef32_pk32_f32_fp6(pk, 1.0f);
                float s0 = 0.f, s1 = 0.f;
#pragma unroll
                for (int i = 0; i < 32; i += 2) { s0 += uf[i] * hf[i]; s1 += uf[i + 1] * hf[i + 1]; }
                d[k] = s0 + s1; __builtin_amdgcn_sched_barrier(0); }
#pragma unroll
            for (int k = 0; k < PEER_B; ++k) d[k] = wave_sum(d[k]);
#pragma unroll
            for (int k = 0; k < PEER_B; ++k) {
                const float wk = gk[k] * gelu_tanh(d[k] * su[k]) * sv[k];
                const i32x6 pk = {(int)va[k][0], (int)va[k][1], (int)va[k][2], (int)va[k][3], (int)vb[k].x, (int)vb[k].y};
                const f32x32 vf = __builtin_amdgcn_cvt_scalef32_pk32_f32_fp6(pk, 1.0f);
#pragma unroll
                for (int i = 0; i < 32; ++i) y[i] += wk * vf[i];
                __builtin_amdgcn_sched_barrier(0);
            }
        }
        float ss = 0.f;
        int lane_e = lane; asm volatile("" : "+v"(lane_e));
#pragma unroll
        for (int w = 0; w < 8; ++w) { const int col = 256 * w + 4 * lane_e;
            const f32x4 x0 = *(const f32x4*)(XA + (size_t)t * DM + col), q0 = *(const f32x4*)(g2 + col);
#pragma unroll
            for (int i = 0; i < 4; ++i) { const float v = x0[i] + q0[i] * y[4 * w + i]; y[4 * w + i] = v; ss += v * v; } }
        if (mode != 1) {
#pragma unroll
            for (int w = 0; w < 8; ++w) { const int col = 256 * w + 4 * lane_e;
                *(f32x4*)(XA + (size_t)t * DM + col) = (f32x4){y[4 * w], y[4 * w + 1], y[4 * w + 2], y[4 * w + 3]}; }
            if (mode == 2) {
                ss = wave_sum(ss);
                const float rstd = rsqrtf(ss * (1.0f / DM) + 1e-6f);
                const float* gam = a->in[4] + (layer + 1) * DM; const float* modn = (const float*)(a->ws + WS_MOD) + (layer + 1) * 12288;
                bf16_t* Hw = (bf16_t*)(a->ws + WS_H);
#pragma unroll
                for (int w = 0; w < 8; ++w) { const int col = 256 * w + 4 * lane_e;
                    const f32x4 gg = *(const f32x4*)(gam + col), sh = *(const f32x4*)(modn + col), sc = *(const f32x4*)(modn + DM + col);
                    float o[4];
#pragma unroll
                    for (int i = 0; i < 4; ++i) o[i] = (y[4 * w + i] * rstd * gg[i]) * (1.0f + sc[i]) + sh[i];
                    *(u32x2*)(Hw + (size_t)t * DM + col) = (u32x2){pk_bf16(o[0], o[1]), pk_bf16(o[2], o[3])};
                    if (w & 1) __builtin_amdgcn_sched_barrier(0); }
            }
        } else {
            ss = wave_sum(ss);
            const float rstd = rsqrtf(ss * (1.0f / DM) + 1e-6f);
            const float* nf = a->in[6];
#pragma unroll
            for (int w = 0; w < 8; ++w) { const int col = 256 * w + 4 * lane_e; const f32x4 n0 = *(const f32x4*)(nf + col);
                *(f32x4*)(a->out + (size_t)t * DM + col) = (f32x4){y[4 * w] * rstd * n0[0], y[4 * w + 1] * rstd * n0[1], y[4 * w + 2] * rstd * n0[2], y[4 * w + 3] * rstd * n0[3]}; }
        }
    }
}

DI void cmp_item(ArgsP a, int id, LAS unsigned char* lds) {
    const int tid = threadIdx.x, lane = tid & 63, wave = tid >> 6, l32 = lane & 31, hf = lane >> 5;
    const int kv = id >> 7, g = (id >> 5) & 3, ntile = id & 31;
    const bf16_t* KVb = (const bf16_t*)(a->ws + WS_KV) + (size_t)kv * KV_T + (size_t)g * SEQ * 128;
    const bf16_t* W1T = (const bf16_t*)(a->ws + WS_CW1T) + (size_t)kv * 128 * 4096;
    int rowA = 32 * ntile + l32; rowA = rowA > 1022 ? 1022 : rowA;
    const bf16_t* ap = KVb + (size_t)16 * rowA * 128 + wave * 512 + hf * 8;
    const bf16_t* bp = W1T + (size_t)l32 * 4096 + wave * 512 + hf * 8;
    f32x16 acc[4];
#pragma unroll
    for (int ht = 0; ht < 4; ++ht)
#pragma unroll
        for (int i = 0; i < 16; ++i) acc[ht][i] = 0.f;
#pragma unroll 4
    for (int ks = 0; ks < 32; ++ks) {
        const bf16x8 af = *(const bf16x8*)(ap + ks * 16);
#pragma unroll
        for (int ht = 0; ht < 4; ++ht) { const bf16x8 bf = *(const bf16x8*)(bp + (size_t)ht * 32 * 4096 + ks * 16); acc[ht] = __builtin_amdgcn_mfma_f32_32x32x16_bf16(af, bf, acc[ht], 0, 0, 0); }
    }
    LAS float* slot = (LAS float*)lds + (wave & 3) * 4096;
    __syncthreads();
    if (wave < 4) {
#pragma unroll
        for (int ht = 0; ht < 4; ++ht)
#pragma unroll
            for (int i = 0; i < 16; ++i) slot[(8 * (i >> 2) + 4 * hf + (i & 3)) * 128 + 32 * ht + l32] = acc[ht][i];
    }
    __syncthreads();
    if (wave >= 4) {
#pragma unroll
        for (int ht = 0; ht < 4; ++ht)
#pragma unroll
            for (int i = 0; i < 16; ++i) slot[(8 * (i >> 2) + 4 * hf + (i & 3)) * 128 + 32 * ht + l32] += acc[ht][i];
    }
    __syncthreads();
    LAS float* S = (LAS float*)lds; LAS float* hid = (LAS float*)lds + 16384;
    const float* pbp = (const float*)(a->ws + WS_PBP) + kv * 16 * 128 + (tid & 127);
    float posb = 0.f;
#pragma unroll
    for (int sl = 0; sl < 16; ++sl) posb += pbp[sl * 128];
#pragma unroll
    for (int j = 0; j < 8; ++j) { const int o = tid + 512 * j; const float v = (S[o] + S[4096 + o]) + (S[8192 + o] + S[12288 + o]) + posb; hid[o] = gelu_tanh(v); }
    __syncthreads();
    const float* w2 = a->in[kv ? 23 : 20];
    const int e = tid & 127, mq = tid >> 7;
    float o8[8];
#pragma unroll
    for (int r = 0; r < 8; ++r) o8[r] = 0.f;
#pragma unroll 1
    for (int h0 = 0; h0 < 128; h0 += 32) { float wv[32];
#pragma unroll
        for (int j = 0; j < 32; ++j) wv[j] = w2[(h0 + j) * 128 + e];
#pragma unroll
        for (int j = 0; j < 32; ++j)
#pragma unroll
            for (int r = 0; r < 8; ++r) o8[r] += hid[(mq * 8 + r) * 128 + h0 + j] * wv[j]; }
    bf16_t* KC = (bf16_t*)(a->ws + WS_KCMP) + (size_t)g * 1024 * 128; bf16_t* VCT = (bf16_t*)(a->ws + WS_VCMPT) + (size_t)g * 128 * 1024;
#pragma unroll
    for (int r = 0; r < 8; ++r) { const int n = 32 * ntile + mq * 8 + r; const bf16_t v = (n < 1023) ? f2bf(o8[r]) : (bf16_t)0;
        if (kv == 0) KC[(size_t)n * 128 + e] = v; else VCT[(size_t)e * 1024 + n] = v; }
    __syncthreads();
}
DI void vtr_item(ArgsP a, int id, LAS unsigned char* lds) {
    const int tid = threadIdx.x;
    const int which = id >> 10, g = (id >> 8) & 3, tt = id & 255, t0 = tt * 64;
    const bf16_t* src = (const bf16_t*)(a->ws + WS_KV) + (size_t)(which ? 5 : 3) * KV_T + ((size_t)g * SEQ + t0) * 128;
    bf16_t* dst = (bf16_t*)(a->ws + (which ? WS_VWT : WS_VST)) + (size_t)g * 128 * SEQ + t0;
    LAS bf16_t* tile = (LAS bf16_t*)lds;
#pragma unroll
    for (int h = 0; h < 2; ++h) { const int q = tid + 512 * h, tl = q >> 4, d8 = (q & 15) * 8; *(LAS u32x4*)(tile + tl * 136 + d8) = *(const u32x4*)(src + (size_t)tl * 128 + d8); }
    __syncthreads();
#pragma unroll
    for (int h = 0; h < 2; ++h) { const int q = tid + 512 * h, d = q >> 3, t8 = (q & 7) * 8;
        u32x4 w;
        w.x = (u32)tile[(t8 + 0) * 136 + d] | ((u32)tile[(t8 + 1) * 136 + d] << 16); w.y = (u32)tile[(t8 + 2) * 136 + d] | ((u32)tile[(t8 + 3) * 136 + d] << 16);
        w.z = (u32)tile[(t8 + 4) * 136 + d] | ((u32)tile[(t8 + 5) * 136 + d] << 16); w.w = (u32)tile[(t8 + 6) * 136 + d] | ((u32)tile[(t8 + 7) * 136 + d] << 16);
        *(u32x4*)(dst + (size_t)d * SEQ + t8) = w; }
    __syncthreads();
}
DI void phase_cmp(ArgsP a, LAS unsigned char* lds) {
    for (int item = blockIdx.x; item < 256 + 2048; item += gridDim.x) { if (item < 256) cmp_item(a, item, lds); else vtr_item(a, item - 256, lds); }
}

constexpr float ATT_SCALE = 0.08838834764831845f;
constexpr float ATT_QSCALE = 0.08838834764831845f * 1.4426950408889634f;
#ifndef PAIR_OFF
#define PAIR_OFF 0
#endif
#ifndef ATT_NG
#define ATT_NG 1
#endif
#ifndef PAIR_SIMD
#define PAIR_SIMD 0
#endif
constexpr int ATT_TQ = 32 * ATT_NG;
constexpr int ATT_NTL = SEQ / ATT_TQ;
constexpr int ATT_D = 3;
constexpr int ATT_KBUF = 0, ATT_VBUF = 65536;
constexpr int ATT_IMP = 65536;
constexpr int ATT_SELM = 131072;
constexpr int ATT_UALL = ATT_SELM + 2048;
constexpr int ATT_LIST = ATT_UALL + 128;
constexpr int ATT_GRPM = ATT_LIST + 1024;
constexpr int ATT_PAIRA = ATT_GRPM + 512;
constexpr int ATT_PAIRB = ATT_PAIRA + 1024;
static_assert(ATT_PAIRB + 1024 <= LDS_BARST, "attention LDS map");
struct AttState { float m, l; f32x4 O[8]; };
#define ATT_WAIT(n) asm volatile("s_waitcnt vmcnt(" #n ")" ::: "memory")
DI void att_barrier() { asm volatile("" ::: "memory"); __builtin_amdgcn_s_barrier(); asm volatile("" ::: "memory"); }
template <int BR> DI bool att_valid(int key, int t, int sel) {
    if (BR == 0) return (16 * key + 31 <= t);
    if (BR == 1) return sel && (key <= t);
    return (key <= t) && (t - key < 512);
}
DI float max3f(float a, float b, float c) { float r; asm("v_max3_f32 %0, %1, %2, %3" : "=v"(r) : "v"(a), "v"(b), "v"(c)); return r; }
DI u32 cvt_pk_bf16_hw(float lo, float hi) { return cvt_pk_bf16_cc(lo, hi); }
template <int BR, bool MASKED> DI void att_tile(AttState (&S)[ATT_NG], const LAS unsigned char* kbuf, const LAS unsigned char* vbuf, int kabs,
                                   const bf16x8 (&qf)[ATT_NG][4], int l16, int q, const int (&t)[ATT_NG], const int (&sel)[ATT_NG], const bool (&need)[ATT_NG],
                                   const int (&kofs)[4], const int (&vofs)[2]) {
    bf16x8 pf[ATT_NG][2]; float corr[ATT_NG];
#pragma unroll
    for (int c = 0; c < ATT_NG; ++c) {
        if (!need[c]) continue;
        f32x4 s[4];
#pragma unroll
        for (int T = 0; T < 4; ++T) {
            bf16x8 ka[4];
#pragma unroll
            for (int ks = 0; ks < 4; ++ks) ka[ks] = *(const LAS bf16x8*)(kbuf + kofs[ks] + T * 4096);
            s[T] = (f32x4){0.f, 0.f, 0.f, 0.f};
#pragma unroll
            for (int ks = 0; ks < 4; ++ks) s[T] = __builtin_amdgcn_mfma_f32_16x16x32_bf16(ka[ks], qf[c][ks], s[T], 0, 0, 0);
            if (ATT_NG > 1 || (T & 1)) __builtin_amdgcn_sched_barrier(0);
        }
        if (MASKED) {
#pragma unroll
            for (int T = 0; T < 4; ++T)
#pragma unroll
                for (int i = 0; i < 4; ++i) s[T][i] = att_valid<BR>(kabs + 32 * (T >> 1) + 8 * q + 4 * (T & 1) + i, t[c], sel[c]) ? s[T][i] : -1e30f;
        }
        asm volatile("s_nop 15\n\ts_nop 3" : "+v"(s[0]), "+v"(s[1]), "+v"(s[2]), "+v"(s[3]));
        float mx = max3f(s[0][0], s[0][1], s[0][2]); mx = max3f(mx, s[0][3], s[1][0]); mx = max3f(mx, s[1][1], s[1][2]); mx = max3f(mx, s[1][3], s[2][0]);
        mx = max3f(mx, s[2][1], s[2][2]); mx = max3f(mx, s[2][3], s[3][0]); mx = max3f(mx, s[3][1], s[3][2]); mx = max3f(mx, s[3][3], mx);
        if (BR == 1 && !MASKED) mx = sel[c] ? mx : -1e30f;
        { const auto r16 = __builtin_amdgcn_permlane16_swap(__float_as_uint(mx), __float_as_uint(mx), false, false); mx = max3f(__uint_as_float(r16[0]), __uint_as_float(r16[1]), mx);
          const auto r32 = __builtin_amdgcn_permlane32_swap(__float_as_uint(mx), __float_as_uint(mx), false, false); mx = max3f(__uint_as_float(r32[0]), __uint_as_float(r32[1]), S[c].m); }
        const float mn = mx; corr[c] = __builtin_amdgcn_exp2f(S[c].m - mn); S[c].m = mn;
        const float msub = (BR == 1 && !MASKED && !sel[c]) ? __builtin_inff() : mn;
        float p[4][4], ps = 0.f;
#pragma unroll
        for (int T = 0; T < 4; ++T)
#pragma unroll
            for (int i = 0; i < 4; ++i) { float e = __builtin_amdgcn_exp2f(s[T][i] - msub);
                if (MASKED) e = (s[T][i] > -1e29f) ? e : 0.f;
                p[T][i] = e; ps += e; }
        S[c].l = S[c].l * corr[c] + ps;
#pragma unroll
        for (int hh = 0; hh < 2; ++hh) { u32x4 pw; pw.x = cvt_pk_bf16_hw(p[2 * hh][0], p[2 * hh][1]); pw.y = cvt_pk_bf16_hw(p[2 * hh][2], p[2 * hh][3]);
            pw.z = cvt_pk_bf16_hw(p[2 * hh + 1][0], p[2 * hh + 1][1]); pw.w = cvt_pk_bf16_hw(p[2 * hh + 1][2], p[2 * hh + 1][3]); pf[c][hh] = __builtin_bit_cast(bf16x8, pw); }
    }
#pragma unroll
    for (int c = 0; c < ATT_NG; ++c) { if (!need[c]) continue;
#pragma unroll
        for (int dt = 0; dt < 8; ++dt) S[c].O[dt] = S[c].O[dt] * corr[c]; }
#pragma unroll
    for (int dt = 0; dt < 8; ++dt) {
#pragma unroll
        for (int hh = 0; hh < 2; ++hh) {
            const bf16x8 vw = *(const LAS bf16x8*)(vbuf + vofs[hh] + dt * 2048);
#pragma unroll
            for (int c = 0; c < ATT_NG; ++c) { if (!need[c]) continue;
                S[c].O[dt] = __builtin_amdgcn_mfma_f32_16x16x32_bf16(vw, pf[c][hh], S[c].O[dt], 0, 0, 0); }
        }
        if (ATT_NG > 1 || (dt & 1)) __builtin_amdgcn_sched_barrier(0);
    }
}
constexpr int ATT_IMPY = 8 * 4 * ATT_NG * 256;
static_assert(ATT_NG == 1, "the X/Y importance arrays fill the V ring at one column group per wave");
DI void att_imp_tile(const LAS unsigned char* kbuf, int kabs, const bf16x8 (&qf)[ATT_NG][4], int l16, int q, const int (&t)[ATT_NG],
                     const float (&mfin)[ATT_NG], const float (&inv)[ATT_NG], LAS float* impw, const int (&kofs)[4]) {
    const int tok = l16 >> 2, r = l16 & 3;
#pragma unroll
    for (int Tp = 0; Tp < 2; ++Tp) {
        float ab[ATT_NG][2][2];
#pragma unroll
        for (int h = 0; h < 2; ++h) { const int T = 2 * Tp + h;
            bf16x8 ka[4];
#pragma unroll
            for (int ks = 0; ks < 4; ++ks) ka[ks] = *(const LAS bf16x8*)(kbuf + kofs[ks] + T * 4096);
#pragma unroll
            for (int c = 0; c < ATT_NG; ++c) {
                f32x4 sc = {0.f, 0.f, 0.f, 0.f};
#pragma unroll
                for (int ks = 0; ks < 4; ++ks) sc = __builtin_amdgcn_mfma_f32_16x16x32_bf16(ka[ks], qf[c][ks], sc, 0, 0, 0);
                const int k0 = kabs + 32 * Tp + 8 * q + 4 * h;
                float pv[4];
#pragma unroll
                for (int i = 0; i < 4; ++i) pv[i] = att_valid<0>(k0 + i, t[c], 0) ? __builtin_amdgcn_exp2f(sc[i] - mfin[c]) : 0.f;
                float a = 2.0f * (pv[0] + pv[1] + pv[2]) + pv[3], b = pv[3];
                a += dppf<DPP_XOR1>(a); a += dppf<DPP_XOR2>(a); b += dppf<DPP_XOR1>(b); b += dppf<DPP_XOR2>(b);
                ab[c][h][0] = a; ab[c][h][1] = b;
            }
        }
#pragma unroll
        for (int c = 0; c < ATT_NG; ++c)
            if (r == 0) { LAS float* row = impw + (4 * c + tok) * 256; const int J = (kabs >> 2) + 8 * Tp + 2 * q;
                *(LAS f32x2v*)(row + J) = (f32x2v){ab[c][0][0], ab[c][1][0] + ab[c][0][1]};
                if (J + 2 < 256) row[ATT_IMPY + J + 2] = ab[c][1][1]; }
    }
}
template <int BR, int MODE, int PROBE = 0> DI void att_stream(LAS unsigned char* lds, const bf16_t* Kp, const bf16_t* VTp, size_t ldv, int ntiles, int kb0, const LAS int* list,
                                               AttState (&S)[ATT_NG], const bf16x8 (&qf)[ATT_NG][4], int l16_in, int q_in, const int (&t)[ATT_NG],
                                               const LAS u32* selw, const LAS u32* grpw, const float (&mfin)[ATT_NG], const float (&inv)[ATT_NG], LAS float* impw) {
    int lane = threadIdx.x & 63, l16 = l16_in, q = q_in;
    asm volatile("" : "+v"(lane), "+v"(l16), "+v"(q));
    const int wave = __builtin_amdgcn_readfirstlane(threadIdx.x >> 6);
    if (ntiles <= 0) return;
    const int tw0 = __builtin_amdgcn_readfirstlane(t[0]) & ~3;
    int kofs[4], vofs[2];
#pragma unroll
    for (int ks = 0; ks < 4; ++ks) kofs[ks] = l16 * 256 + (((4 * ks + q) ^ l16) << 4);
#pragma unroll
    for (int hh = 0; hh < 2; ++hh) vofs[hh] = l16 * 128 + (((4 * hh + q) ^ ((l16 >> 1) & 7)) << 4);
    size_t offk[2], offv[2];
#pragma unroll
    for (int h = 0; h < 2; ++h) { const int p = wave + 8 * h;
        { const int row = 4 * p + (lane >> 4), cl = (lane & 15) ^ (row & 15), r5 = row & 31, key = (row & 32) + 8 * ((r5 >> 2) & 3) + 4 * (r5 >> 4) + (r5 & 3);
          offk[h] = (size_t)key * 128 + cl * 8; }
        { const int row = 8 * p + (lane >> 3), cl = (lane & 7) ^ ((row >> 1) & 7); offv[h] = (size_t)row * ldv + cl * 8; } }
#define TILE_KB(k) ((BR == 1) ? 64 * list[(k)] : kb0 + 64 * (k))
#define TILE_ISSUE(k) do { const int kb_ = (PROBE & 1) ? 0 : TILE_KB(k), slot_ = ((k) & 3) * 16384; \
        _Pragma("unroll") for (int h = 0; h < 2; ++h) __builtin_amdgcn_global_load_lds((const u32*)(Kp + (size_t)kb_ * 128 + offk[h]), (LAS u32*)(lds + ATT_KBUF + slot_ + (wave + 8 * h) * 1024), 16, 0, 0); \
        if (MODE == 0) { _Pragma("unroll") for (int h = 0; h < 2; ++h) __builtin_amdgcn_global_load_lds((const u32*)(VTp + kb_ + offv[h]), (LAS u32*)(lds + ATT_VBUF + slot_ + (wave + 8 * h) * 1024), 16, 0, 0); } } while (0)
#pragma unroll
    for (int i = 0; i < ATT_D; ++i) if (i < ntiles) TILE_ISSUE(i);
    for (int k = 0; k < ntiles; ++k) {
        const int rem = ntiles - 1 - k;
        const int kb = TILE_KB(k);
        int sel[ATT_NG]; bool need[ATT_NG]; bool any = false;
#pragma unroll
        for (int c = 0; c < ATT_NG; ++c) { sel[c] = 1; need[c] = true;
            if (BR == 1 && MODE == 0) { const int j = kb >> 6; sel[c] = (int)((selw[(4 * c + (l16 >> 2)) * 8 + (j >> 5)] >> (j & 31)) & 1u);
                const u32 gm = grpw[c * 8 + (j >> 5)]; need[c] = ((__builtin_amdgcn_readfirstlane((int)gm) >> (j & 31)) & 1) != 0; }
            any = any || need[c]; }
        if (MODE == 0) { if (rem >= 2) ATT_WAIT(8); else if (rem == 1) ATT_WAIT(4); else ATT_WAIT(0); }
        else           { if (rem >= 2) ATT_WAIT(4); else if (rem == 1) ATT_WAIT(2); else ATT_WAIT(0); }
        att_barrier();
        if (k + ATT_D < ntiles) TILE_ISSUE(k + ATT_D);
        const LAS unsigned char* kbuf = lds + ATT_KBUF + (k & 3) * 16384; const LAS unsigned char* vbuf = lds + ATT_VBUF + (k & 3) * 16384;
        if (MODE == 0) {
            if (any && !(PROBE & 2)) {
                bool full;
                if (BR == 0) full = (16 * (kb + 63) + 31 <= tw0);
                else if (BR == 1) full = (kb + 63 <= tw0);
                else full = (kb + 63 <= tw0) && (tw0 + 4 * ATT_NG - 1 - kb < 512);
                if (full) att_tile<BR, false>(S, kbuf, vbuf, kb, qf, l16, q, t, sel, need, kofs, vofs); else att_tile<BR, true>(S, kbuf, vbuf, kb, qf, l16, q, t, sel, need, kofs, vofs);
            }
        } else { att_imp_tile(kbuf, kb, qf, l16, q, t, mfin, inv, impw, kofs); }
    }
    asm volatile("s_waitcnt lgkmcnt(0)" ::: "memory");
    att_barrier();
#undef TILE_KB
#undef TILE_ISSUE
}

template <int PROBE> DI void att_stream_pairs(LAS unsigned char* lds, const bf16_t* Kp, const bf16_t* VTp, size_t ldv, const LAS u32* cnts, const LAS int* pairA, const LAS int* pairB,
                         AttState (&S)[ATT_NG], const bf16x8 (&qf)[ATT_NG][4], int l16_in, int q_in, const int (&t)[ATT_NG], const LAS u32* selw, const LAS u32* grpw) {
    int lane = threadIdx.x & 63, l16 = l16_in, q = q_in;
    asm volatile("" : "+v"(lane), "+v"(l16), "+v"(q));
    const int wave = __builtin_amdgcn_readfirstlane(threadIdx.x >> 6);
    int cw[8], nsteps = 0;
#pragma unroll
    for (int w = 0; w < 8; ++w) { cw[w] = __builtin_amdgcn_readfirstlane((int)cnts[w]); nsteps += cw[w]; }
    if (nsteps <= 0) return;
    const int tw0 = __builtin_amdgcn_readfirstlane(t[0]) & ~3;
    int kofs[4], vofs[2];
#pragma unroll
    for (int ks = 0; ks < 4; ++ks) kofs[ks] = l16 * 256 + (((4 * ks + q) ^ l16) << 4);
#pragma unroll
    for (int hh = 0; hh < 2; ++hh) vofs[hh] = l16 * 128 + (((4 * hh + q) ^ ((l16 >> 1) & 7)) << 4);
#define PAIR_IDX(k, out) do { int k_ = (k), o_ = 0; _Pragma("unroll") for (int w = 0; w < 8; ++w) { const bool past = (k_ >= cw[w]) && (w < 7); o_ = past ? (32 * (w + 1)) : o_; k_ = past ? (k_ - cw[w]) : k_; if (!past) break; } (out) = o_ + k_; } while (0)
    unsigned offk[2], offv[2];
#pragma unroll
    for (int h = 0; h < 2; ++h) { const int p = wave + 8 * h;
        { const int row = 4 * p + (lane >> 4), cl = (lane & 15) ^ (row & 15), r5 = row & 31, key = (row & 32) + 8 * ((r5 >> 2) & 3) + 4 * (r5 >> 4) + (r5 & 3);
          offk[h] = (unsigned)(key * 128 + cl * 8); }
        { const int row = 8 * p + (lane >> 3), cl = (lane & 7) ^ ((row >> 1) & 7); offv[h] = (unsigned)(row * (int)ldv + cl * 8); } }
#define PAIR_ISSUE(blk, slot) do { const int kb_ = (PROBE & 1) ? 0 : 64 * (blk), slot_ = (slot) * 16384; \
        _Pragma("unroll") for (int h = 0; h < 2; ++h) __builtin_amdgcn_global_load_lds((const u32*)(Kp + (size_t)kb_ * 128 + offk[h]), (LAS u32*)(lds + ATT_KBUF + slot_ + (wave + 8 * h) * 1024), 16, 0, 0); \
        _Pragma("unroll") for (int h = 0; h < 2; ++h) __builtin_amdgcn_global_load_lds((const u32*)(VTp + kb_ + offv[h]), (LAS u32*)(lds + ATT_VBUF + slot_ + (wave + 8 * h) * 1024), 16, 0, 0); } while (0)
    int idx_cur; PAIR_IDX(0, idx_cur);
    { const int a0 = pairA[idx_cur], b0 = pairB[idx_cur]; PAIR_ISSUE(a0, 0); PAIR_ISSUE(b0 >= 0 ? b0 : a0, 1); }
    for (int k = 0; k < nsteps; ++k) {
        int idx_nxt = 0; if (k + 1 < nsteps) PAIR_IDX(k + 1, idx_nxt);
        int blk[2]; blk[0] = pairA[idx_cur]; blk[1] = pairB[idx_cur];
        int sel[2][ATT_NG]; bool need[2][ATT_NG];
#pragma unroll
        for (int x = 0; x < 2; ++x)
#pragma unroll
            for (int c = 0; c < ATT_NG; ++c) { const int j = blk[x] < 0 ? 0 : blk[x];
                sel[x][c] = (int)((selw[(4 * c + (l16 >> 2)) * 8 + (j >> 5)] >> (j & 31)) & 1u);
                const u32 gm = grpw[c * 8 + (j >> 5)]; need[x][c] = (blk[x] >= 0) && (((__builtin_amdgcn_readfirstlane((int)gm) >> (j & 31)) & 1) != 0); }
        ATT_WAIT(0);
        att_barrier();
        if (k + 1 < nsteps) { const int a1 = pairA[idx_nxt], b1 = pairB[idx_nxt]; PAIR_ISSUE(a1, (2 * k + 2) & 3); PAIR_ISSUE(b1 >= 0 ? b1 : a1, (2 * k + 3) & 3); }
#pragma unroll
        for (int x = 0; x < 2; ++x) {
            bool any = false;
#pragma unroll
            for (int c = 0; c < ATT_NG; ++c) any = any || need[x][c];
            if (!any || (PROBE & 2)) continue;
            const int kb = 64 * blk[x];
            const LAS unsigned char* kbuf = lds + ATT_KBUF + ((2 * k + x) & 3) * 16384; const LAS unsigned char* vbuf = lds + ATT_VBUF + ((2 * k + x) & 3) * 16384;
            if (kb + 63 <= tw0) att_tile<1, false>(S, kbuf, vbuf, kb, qf, l16, q, t, sel[x], need[x], kofs, vofs); else att_tile<1, true>(S, kbuf, vbuf, kb, qf, l16, q, t, sel[x], need[x], kofs, vofs);
        }
        idx_cur = idx_nxt;
    }
    asm volatile("s_waitcnt lgkmcnt(0)" ::: "memory");
    att_barrier();
#undef PAIR_ISSUE
#undef PAIR_IDX
}

template <int SKIP> DI void phase_att(ArgsP a, LAS unsigned char* lds) {
    const bf16_t* Qb = (const bf16_t*)(a->ws + WS_BUFA);
    const bf16_t* KVb = (const bf16_t*)(a->ws + WS_KV);
    const float* GL = (const float*)(a->ws + WS_GL);
    bf16_t* Ob = (bf16_t*)(a->ws + WS_BUFB);
    const int G = gridDim.x, NI = ATT_NTL * 4, p = blockIdx.x;
    const bool xcd_order = (G == 256);
    const int nrd = xcd_order ? (ATT_NTL / 64) : ((NI + G - 1) / G);
    for (int rd = 0; rd < nrd; ++rd) {
        int g, tile;
        if (xcd_order) { const int x = p & 7, i = p >> 3, h = x >> 2, base = ATT_NTL / 32 - 1 - 2 * rd, chunk = ((rd & 1) == h) ? base : base - 1; g = x & 3; tile = 32 * chunk + i; }
        else { const int idx = rd * G + ((rd & 1) ? (G - 1 - p) : p); if (idx >= NI) continue; g = idx & 3; tile = ATT_NTL - 1 - (idx >> 2); }
        int tid = threadIdx.x; asm volatile("" : "+v"(tid));
        const int lane = tid & 63, wave = tid >> 6, l16 = lane & 15, q = lane >> 4, tok = l16 >> 2, r = l16 & 3;
        LAS float* impw = (LAS float*)(lds + ATT_IMP) + wave * (4 * ATT_NG) * 256;
        LAS u32* selw = (LAS u32*)(lds + ATT_SELM) + wave * (4 * ATT_NG) * 8;
        LAS u32* uall = (LAS u32*)(lds + ATT_UALL);
        LAS int* list = (LAS int*)(lds + ATT_LIST);
        LAS u32* grpw = (LAS u32*)(lds + ATT_GRPM) + wave * ATT_NG * 8;
        const int t0 = tile * ATT_TQ, tlast = t0 + ATT_TQ - 1, cur = t0 >> 6;
        int t[ATT_NG]; bf16x8 qf[ATT_NG][4];
#pragma unroll
        for (int c = 0; c < ATT_NG; ++c) { t[c] = t0 + wave * (4 * ATT_NG) + 4 * c + tok; const int head = 4 * g + r;
            const bf16_t* qp = Qb + (size_t)t[c] * DM + head * 128 + 8 * q;
#pragma unroll
            for (int ks = 0; ks < 4; ++ks) { const u32x4 qw = *(const u32x4*)(qp + 32 * ks); u32x4 qs;
#pragma unroll
                for (int w = 0; w < 4; ++w) qs[w] = cvt_pk_bf16_hw(bflo(qw[w]) * ATT_QSCALE, bfhi(qw[w]) * ATT_QSCALE);
                qf[c][ks] = __builtin_bit_cast(bf16x8, qs); }
}
        AttState S[ATT_NG];
        float mfin[ATT_NG], inv[ATT_NG];
#pragma unroll
        for (int c = 0; c < ATT_NG; ++c) { mfin[c] = 0.f; inv[c] = 0.f; }
#define ATT_RESET() do { _Pragma("unroll") for (int c = 0; c < ATT_NG; ++c) { S[c].m = -1e30f; S[c].l = 0.f; _Pragma("unroll") for (int i = 0; i < 8; ++i) S[c].O[i] = (f32x4){0.f, 0.f, 0.f, 0.f}; } } while (0)
#define ATT_FOLD(b) do { _Pragma("unroll") for (int c = 0; c < ATT_NG; ++c) { float l = sum_x32(sum_x16(S[c].l)); inv[c] = (l > 0.f) ? 1.0f / l : 0.f; mfin[c] = S[c].m + ((l > 0.f) ? __builtin_amdgcn_logf(l) : 0.f); \
        const float w = GL[(size_t)t[c] * 48 + (4 * g + r) * 3 + (b)] * inv[c]; bf16_t* op = Ob + (size_t)t[c] * DM + (4 * g + r) * 128 + 4 * q; \
        _Pragma("unroll") for (int dt = 0; dt < 8; ++dt) { const f32x4 o = S[c].O[dt] * w; u32x2 pr = (u32x2){0u, 0u}; if ((b) != 0) pr = *(const u32x2*)(op + 16 * dt); \
            *(u32x2*)(op + 16 * dt) = (u32x2){cvt_pk_bf16_hw(bflo(pr.x) + o[0], bfhi(pr.x) + o[1]), cvt_pk_bf16_hw(bflo(pr.y) + o[2], bfhi(pr.y) + o[3])}; } } } while (0)
        __syncthreads();
        if (lane < 4 * ATT_NG * 8) selw[lane] = 0u;
        if (lane < ATT_NG * 8) grpw[lane] = 0u;
        if (tid < 24) uall[tid] = 0u;
        const bf16_t* Kc = (const bf16_t*)(a->ws + WS_KCMP) + (size_t)g * 1024 * 128; const bf16_t* VcT = (const bf16_t*)(a->ws + WS_VCMPT) + (size_t)g * 128 * 1024;
        const int ncmp = (tlast - 31) / 16 + 1, nct = (ncmp + 63) >> 6;
        ATT_RESET();
        if (!(SKIP & 1)) att_stream<0, 0>(lds, Kc, VcT, 1024, nct, 0, nullptr, S, qf, l16, q, t, selw, grpw, mfin, inv, impw);
        ATT_FOLD(0);
        if (!(SKIP & 2)) att_stream<0, 1>(lds, Kc, VcT, 1024, nct, 0, nullptr, S, qf, l16, q, t, selw, grpw, mfin, inv, impw);
#pragma unroll
        for (int c = 0; c < ATT_NG; ++c) {
            if (SKIP & 4) continue;
            const int tk = q; LAS float* row = impw + (4 * c + tk) * 256; LAS u32* srow = selw + (4 * c + tk) * 8;
            int key[16];
#pragma unroll
            for (int i = 0; i < 16; ++i) { const int j = 16 * l16 + i; const float v = (i & 1) ? row[j] : row[j] + row[ATT_IMPY + j];
                const bool forced = (j == 0) || (j == cur) || (j == cur - 1);
                key[i] = (j <= cur && !forced) ? ((__float_as_int(v) & ~255) | (255 - j)) : -1; }
            const int nforced = (cur >= 2) ? 3 : (cur + 1);
            if (l16 == 0) { atomicOr((u32*)&srow[0], 1u); atomicOr((u32*)&srow[cur >> 5], 1u << (cur & 31)); if (cur >= 1) atomicOr((u32*)&srow[(cur - 1) >> 5], 1u << ((cur - 1) & 31)); }
            for (int rr = 0; rr < 16 - nforced; ++rr) {
                int m = key[0];
#pragma unroll
                for (int i = 1; i < 16; ++i) m = max(m, key[i]);
                m = max(m, dppi<DPP_XOR1>(m)); m = max(m, dppi<DPP_XOR2>(m)); m = max(m, dppi<DPP_HMIRROR>(m)); m = max(m, dppi<DPP_MIRROR>(m));
                if (m >= 0) { const int j = 255 - (m & 255); if (l16 == 0) atomicOr((u32*)&srow[j >> 5], 1u << (j & 31));
#pragma unroll
                    for (int i = 0; i < 16; ++i) key[i] = (key[i] == m) ? -1 : key[i]; }
            }
            if (lane < 8) { const u32 gm = selw[(4 * c) * 8 + lane] | selw[(4 * c + 1) * 8 + lane] | selw[(4 * c + 2) * 8 + lane] | selw[(4 * c + 3) * 8 + lane];
                grpw[c * 8 + lane] = gm; atomicOr((u32*)&uall[lane], gm); }
        }
        __syncthreads();
        if (wave == 0) {
            int base = 0;
#pragma unroll
            for (int rr = 0; rr < 4; ++rr) { const int j = lane + 64 * rr; const bool bit = ((uall[j >> 5] >> (j & 31)) & 1u) != 0u;
                const unsigned long long bal = __ballot(bit);
                if (bit) list[base + __popcll(bal & ((1ull << lane) - 1ull))] = j;
                base += __popcll(bal); }
            if (lane == 0) uall[8] = (u32)base;
        }
        __syncthreads();
        { const int n = (int)uall[8], seg = (n + 7) >> 3, s0 = wave * seg, cntl = (n - s0 < seg) ? (n - s0 < 0 ? 0 : n - s0) : seg;
          const LAS u32* gall = (const LAS u32*)(lds + ATT_GRPM);
          int m = 0, jme = 0; bool used = (lane >= cntl);
          if (lane < cntl) { jme = list[s0 + lane];
#pragma unroll
              for (int w = 0; w < 8; ++w) { u32 g_or = 0u, g_and = 0xffffffffu;
#pragma unroll
                  for (int c = 0; c < ATT_NG; ++c) { const u32 gw = gall[(w * ATT_NG + c) * 8 + (jme >> 5)]; g_or |= gw; g_and &= gw; }
                  m |= (int)((g_or >> (jme & 31)) & 1u) << w; if (ATT_NG > 1) m |= (int)((g_and >> (jme & 31)) & 1u) << (8 + w); } }
          LAS int* pairA = (LAS int*)(lds + ATT_PAIRA) + 32 * wave; LAS int* pairB = (LAS int*)(lds + ATT_PAIRB) + 32 * wave;
          int ns = 0;
          for (int i = 0; i < cntl; ++i) {
              if (__builtin_amdgcn_readlane((int)used, i)) continue;
              const int mi = __builtin_amdgcn_readlane(m, i), ji = __builtin_amdgcn_readlane(jme, i);
              const bool cand = !used && (lane > i);
              const bool fits = (ATT_NG == 1) ? ((m & mi & 0xff) == 0) : (((((m >> 8) & mi) | ((mi >> 8) & m)) & 0xff) == 0);
              unsigned long long bal = 0ull;
#if PAIR_SIMD
              { const int fm = PAIR_SIMD == 1 ? ((m | (m >> 4)) & 0xf) : ((m | (m >> 1)) & 0x55), fi = PAIR_SIMD == 1 ? ((mi | (mi >> 4)) & 0xf) : ((mi | (mi >> 1)) & 0x55);
                bal = __ballot(cand && fits && (fm & fi) == 0); }
              if (bal == 0ull)
#endif
              bal = __ballot(cand && fits);
              if (bal == 0ull) bal = __ballot(cand);
              const int partner = bal ? (int)__builtin_ctzll(bal) : -1;
              int jp = -1; if (partner >= 0) jp = __builtin_amdgcn_readlane(jme, partner);
              if (lane == i || lane == partner) used = true;
              if (lane == 0) { pairA[ns] = ji; pairB[ns] = jp; }
              ++ns;
          }
          if (lane == 0) uall[16 + wave] = (u32)ns; }
        __syncthreads();
        { const bf16_t* Ks = KVb + (size_t)2 * KV_T + (size_t)g * SEQ * 128; const bf16_t* VsT = (const bf16_t*)(a->ws + WS_VST) + (size_t)g * 128 * SEQ;
          ATT_RESET();
          if (!(SKIP & 8)) att_stream_pairs<((SKIP & 32) ? 1 : 0) | ((SKIP & 64) ? 2 : 0)>(lds, Ks, VsT, SEQ, (const LAS u32*)(uall + 16), (const LAS int*)(lds + ATT_PAIRA), (const LAS int*)(lds + ATT_PAIRB), S, qf, l16, q, t, selw, grpw);
          ATT_FOLD(1); }
        { const bf16_t* Kw = KVb + (size_t)4 * KV_T + (size_t)g * SEQ * 128; const bf16_t* VwT = (const bf16_t*)(a->ws + WS_VWT) + (size_t)g * 128 * SEQ;
          int kb0 = t0 - 511; kb0 = kb0 < 0 ? 0 : (kb0 & ~63);
          ATT_RESET();
          if (!(SKIP & 16)) att_stream<2, 0>(lds, Kw, VwT, SEQ, (tlast - kb0) / 64 + 1, kb0, nullptr, S, qf, l16, q, t, selw, grpw, mfin, inv, impw);
          ATT_FOLD(2); }
#undef ATT_RESET
#undef ATT_FOLD
    }
}

constexpr int N_PHASES = 20;
#ifndef PHASE_MASK
#define PHASE_MASK 0xFFFFF
#endif
#ifndef Q8_L1ROWS
#define Q8_L1ROWS 0
#endif
#ifndef GEMM11_WGS
#define GEMM11_WGS 224
#endif
template <class Epi> DI void run_gemm_on(LAS unsigned char* lds, const bf16_t* A, const bf16_t* Bt, int N, const Epi& E, int nwg, int c) {
    pg8::Gemm g{A, Bt, SEQ, N, DM}; pg8::StaticOrder S; S.init(SEQ, N, nwg, c);
    pg8::gemm_phase<Epi, pg8::StaticOrder, false>((PG8_LAS unsigned char*)lds, g, S, E, nullptr);
}
template <class Epi> DI void run_gemm(LAS unsigned char* lds, const bf16_t* A, const bf16_t* Bt, int N, const Epi& E) {
    pg8::Gemm g{A, Bt, SEQ, N, DM}; pg8::StaticOrder S; S.init(SEQ, N, (int)gridDim.x, (int)blockIdx.x);
    pg8::gemm_phase<Epi, pg8::StaticOrder, false>((PG8_LAS unsigned char*)lds, g, S, E, nullptr);
}

__global__ void __launch_bounds__(NT, 2) fwd_mega(Args a_by_value) {
    const ArgsP a0 = (ArgsP)__builtin_amdgcn_kernarg_segment_ptr();
    extern __shared__ __attribute__((aligned(16))) unsigned char lds_raw[];
    LAS unsigned char* lds = (LAS unsigned char*)lds_raw;
    cg::grid_group grid = cg::this_grid();
    const int lo = a0->ph_lo, hi = a0->ph_hi;
    if (threadIdx.x < 4) ((LAS unsigned*)(lds + LDS_BARST))[threadIdx.x] = 0u;
    __syncthreads();
    const XcdBarrier xbar = xcd_barrier_post((unsigned*)(a0->ws + WS_BAR), (volatile LAS unsigned*)(lds + LDS_BARST));
#define PH_VARS const ArgsP a = args_fresh(a0); unsigned char* ws = a->ws; const float* mod0 = (const float*)(ws + WS_MOD); const float* mod1 = mod0 + 12288; \
    bf16_t* H = (bf16_t*)(ws + WS_H); bf16_t* BA = (bf16_t*)(ws + WS_BUFA); bf16_t* BB = (bf16_t*)(ws + WS_BUFB); float* XA = (float*)(ws + WS_XA); \
    (void)mod0; (void)mod1; (void)H; (void)BA; (void)BB; (void)XA;
#ifndef SEAM_CG
#define SEAM_CG 0
#endif
#define IN(k) (lo <= (k) && (k) < hi)
#define SEAM(k) do { if (IN(k) && IN((k) + 1)) { if ((k) == 0 || (k) == SEAM_CG) grid.sync(); else xcd_barrier(xbar); } } while (0)
#if (PHASE_MASK >> 0) & 1
#if defined(PROBE_DUP) && PROBE_DUP == 0
#ifndef PREP_ONLY
#define PREP_ONLY 0
#endif
        if (IN(0)) { PH_VARS phase_prep<PREP_ONLY>(a, lds); }
        if (IN(0)) xcd_barrier(xbar);
#endif
        if (IN(0)) { PH_VARS phase_prep<0>(a, lds); }
        SEAM(0);
#endif
#if (PHASE_MASK >> 1) & 1
#if defined(PROBE_DUP) && PROBE_DUP == 1
        if (IN(1)) { PH_VARS phase_norm(a->in[0], a->in[4], mod0, mod0 + DM, H); }
        if (IN(1)) xcd_barrier(xbar);
#endif
        if (IN(1)) { PH_VARS phase_norm(a->in[0], a->in[4], mod0, mod0 + DM, H); }
        SEAM(1);
#endif
#if (PHASE_MASK >> 2) & 1
#if defined(PROBE_DUP) && PROBE_DUP == 2
        if (IN(2)) { PH_VARS { pg8::EpiStoreBf16 E{BA, DM}; run_gemm(lds, H, (const bf16_t*)(ws + WS_WT_SIN), 2048, E); } }
        if (IN(2)) xcd_barrier(xbar);
#endif
        if (IN(2)) { PH_VARS { pg8::EpiStoreBf16 E{BA, DM}; run_gemm(lds, H, (const bf16_t*)(ws + WS_WT_SIN), 2048, E); } }
        SEAM(2);
#endif
#if (PHASE_MASK >> 3) & 1
#if defined(PROBE_DUP) && PROBE_DUP == 3
        if (IN(3)) { PH_VARS phase_s5<false>(a, lds); }
        if (IN(3)) xcd_barrier(xbar);
#endif
        if (IN(3)) { PH_VARS phase_s5<false>(a, lds); }
        SEAM(3);
#endif
#if (PHASE_MASK >> 4) & 1
#if defined(PROBE_DUP) && PROBE_DUP == 4
        if (IN(4)) { PH_VARS phase_s5<true>(a, lds); }
        if (IN(4)) xcd_barrier(xbar);
#endif
        if (IN(4)) { PH_VARS phase_s5<true>(a, lds); }
        SEAM(4);
#endif
#if (PHASE_MASK >> 5) & 1
#if defined(PROBE_DUP) && PROBE_DUP == 5
        if (IN(5)) { PH_VARS { pg8::EpiGlu E{a->in[0], XA, mod0 + 2 * DM}; run_gemm(lds, BB, (const bf16_t*)(ws + WS_WT_SOUT), 4096, E); } }
        if (IN(5)) xcd_barrier(xbar);
#endif
        if (IN(5)) { PH_VARS { pg8::EpiGlu E{a->in[0], XA, mod0 + 2 * DM}; run_gemm(lds, BB, (const bf16_t*)(ws + WS_WT_SOUT), 4096, E); } }
        SEAM(5);
#endif
#if defined(PROBE_BAR)
        if (IN(6)) { xcd_barrier(xbar); xcd_barrier(xbar); xcd_barrier(xbar); xcd_barrier(xbar); xcd_barrier(xbar); xcd_barrier(xbar); xcd_barrier(xbar); xcd_barrier(xbar); }
#endif
#if (PHASE_MASK >> 6) & 1
#if defined(PROBE_DUP) && PROBE_DUP == 6
        if (IN(6)) { PH_VARS phase_norm(XA, a->in[5], mod0 + 3 * DM, mod0 + 4 * DM, H); }
        if (IN(6)) xcd_barrier(xbar);
#endif
        if (IN(6)) { PH_VARS phase_norm(XA, a->in[5], mod0 + 3 * DM, mod0 + 4 * DM, H); }
        SEAM(6);
#endif
#if (PHASE_MASK >> 7) & 1
#if defined(PROBE_DUP) && PROBE_DUP == 7
        if (IN(7)) { PH_VARS { pg8::EpiStoreBf16 E{BA, DM}; run_gemm(lds, H, (const bf16_t*)(ws + WS_WT_PQ), 2048, E); } }
        if (IN(7)) xcd_barrier(xbar);
#endif
        if (IN(7)) { PH_VARS { pg8::EpiStoreBf16 E{BA, DM}; run_gemm(lds, H, (const bf16_t*)(ws + WS_WT_PQ), 2048, E); } }
        SEAM(7);
#endif
#if (PHASE_MASK >> 8) & 1
#if defined(PROBE_DUP) && PROBE_DUP == 8
        if (IN(8)) { PH_VARS phase_route(a, 0, lds); }
        if (IN(8)) xcd_barrier(xbar);
#endif
        if (IN(8)) { PH_VARS p0_quant_rows(a, 0, 16384 + Q8_L1ROWS, blockIdx.x * 8 + (threadIdx.x >> 6), gridDim.x * 8); phase_route(a, 0, lds); }
        SEAM(8);
#endif
#if (PHASE_MASK >> 9) & 1
#if defined(PROBE_DUP) && PROBE_DUP == 9
        if (IN(9)) { PH_VARS phase_peer(a, 0, 1); }
        if (IN(9)) xcd_barrier(xbar);
#endif
        if (IN(9)) { PH_VARS phase_peer(a, 0, 2); }
        SEAM(9);
#endif
#if (PHASE_MASK >> 10) & 1
        if (IN(10)) { PH_VARS phase_norm(XA, a->in[4] + DM, mod1, mod1 + DM, H); }
        SEAM(10);
#endif
#if (PHASE_MASK >> 11) & 1
#if defined(PROBE_DUP) && PROBE_DUP == 11
        if (IN(11)) { PH_VARS { pg8::EpiNsaIn E{BA, (bf16_t*)(ws + WS_KV), (float*)(ws + WS_GL)}; run_gemm(lds, H, (const bf16_t*)(ws + WS_WT_NIN), 5376, E); } }
        if (IN(11)) xcd_barrier(xbar);
#endif
        if (IN(11)) { PH_VARS
            if ((int)blockIdx.x < GEMM11_WGS) { pg8::EpiNsaIn E{BA, (bf16_t*)(ws + WS_KV), (float*)(ws + WS_GL)}; run_gemm_on(lds, H, (const bf16_t*)(ws + WS_WT_NIN), 5376, E, GEMM11_WGS, (int)blockIdx.x); }
            else p0_quant_rows(a, 16384 + Q8_L1ROWS, 32768, ((int)blockIdx.x - GEMM11_WGS) * 8 + (threadIdx.x >> 6), ((int)gridDim.x - GEMM11_WGS) * 8); }
        SEAM(11);
#endif
#if (PHASE_MASK >> 12) & 1
#if defined(PROBE_DUP) && PROBE_DUP == 12
        if (IN(12)) { PH_VARS phase_cmp(a, lds); }
        if (IN(12)) xcd_barrier(xbar);
#endif
        if (IN(12)) { PH_VARS phase_cmp(a, lds); }
        SEAM(12);
#endif
#if (PHASE_MASK >> 13) & 1
#if defined(PROBE_DUP) && PROBE_DUP == 13
#ifndef ATT_PROBE_SKIP
#define ATT_PROBE_SKIP 0
#endif
        if (IN(13)) { PH_VARS phase_att<ATT_PROBE_SKIP>(a, lds); }
        if (IN(13)) xcd_barrier(xbar);
#endif
        if (IN(13)) { PH_VARS phase_att<0>(a, lds); }
        SEAM(13);
#endif
#if (PHASE_MASK >> 14) & 1
        if (IN(14)) { PH_VARS { pg8::EpiResid E{XA, mod1 + 2 * DM}; run_gemm(lds, BB, (const bf16_t*)(ws + WS_WT_NOUT), 2048, E); } }
        SEAM(14);
#endif
#if (PHASE_MASK >> 15) & 1
#if defined(PROBE_DUP) && PROBE_DUP == 15
        if (IN(15)) { PH_VARS phase_norm(XA, a->in[5] + DM, mod1 + 3 * DM, mod1 + 4 * DM, H); }
        if (IN(15)) xcd_barrier(xbar);
#endif
        if (IN(15)) { PH_VARS phase_norm(XA, a->in[5] + DM, mod1 + 3 * DM, mod1 + 4 * DM, H); }
        SEAM(15);
#endif
#if (PHASE_MASK >> 16) & 1
#if defined(PROBE_DUP) && PROBE_DUP == 16
        if (IN(16)) { PH_VARS { pg8::EpiStoreBf16 E{BA, DM}; run_gemm(lds, H, (const bf16_t*)(ws + WS_WT_PQ) + (size_t)DM * DM, 2048, E); } }
        if (IN(16)) xcd_barrier(xbar);
#endif
        if (IN(16)) { PH_VARS { pg8::EpiStoreBf16 E{BA, DM}; run_gemm(lds, H, (const bf16_t*)(ws + WS_WT_PQ) + (size_t)DM * DM, 2048, E); } }
        SEAM(16);
#endif
#if (PHASE_MASK >> 17) & 1
#if defined(PROBE_DUP) && PROBE_DUP == 17
        if (IN(17)) { PH_VARS phase_route(a, 1, lds); }
        if (IN(17)) xcd_barrier(xbar);
#endif
        if (IN(17)) { PH_VARS phase_route(a, 1, lds); }
        SEAM(17);
#endif
#if (PHASE_MASK >> 18) & 1
#if defined(PROBE_DUP) && PROBE_DUP == 18
        if (IN(18)) { PH_VARS phase_peer(a, 1, 1); }
        if (IN(18)) xcd_barrier(xbar);
#endif
        if (IN(18)) { PH_VARS phase_peer(a, 1, 1); }
        SEAM(18);
#endif
#undef IN
#undef SEAM
}

#ifndef N_LAUNCH_MODE
#define N_LAUNCH_MODE 1
#endif
extern "C" void kernel_launch(void* const* d_in, const int* in_sizes, int n_in, void* d_out, int out_size, void* d_ws, size_t ws_size, hipStream_t stream) {
    static int grid = 0;
    if (grid == 0) {
        if (n_in != 29 || out_size != SEQ * DM || ws_size < WS_END) { fprintf(stderr, "kernel_launch: unexpected problem (n_in %d, out %d, ws %zu < %zu)\n", n_in, out_size, ws_size, (size_t)WS_END); grid = -1; return; }
        int dev = 0, cus = 0, per_cu = 0;
        hipGetDevice(&dev); hipDeviceGetAttribute(&cus, hipDeviceAttributeMultiprocessorCount, dev);
        hipFuncSetAttribute((const void*)fwd_mega, hipFuncAttributeMaxDynamicSharedMemorySize, LDS_BYTES);
        hipOccupancyMaxActiveBlocksPerMultiprocessor(&per_cu, (const void*)fwd_mega, NT, LDS_BYTES);
        if (per_cu < 1) { fprintf(stderr, "kernel_launch: occupancy query says %d workgroups per CU\n", per_cu); per_cu = 1; }
        grid = cus;
        (void)hipGetLastError();
    }
    if (grid < 0) return;
    (void)hipMemsetAsync((unsigned char*)d_ws + WS_BAR, 0, XCD_BAR_WORDS * 4, stream);
    Args a{};
    for (int i = 0; i < 29; ++i) a.in[i] = (const float*)d_in[i];
    a.out = (float*)d_out; a.ws = (unsigned char*)d_ws;
#if N_LAUNCH_MODE == 1
    a.ph_lo = 0; a.ph_hi = N_PHASES - 1;
    { void* args[] = {&a}; hipError_t e = hipLaunchCooperativeKernel((const void*)fwd_mega, dim3(grid), dim3(NT), args, LDS_BYTES, stream);
      if (e != hipSuccess) fprintf(stderr, "cooperative launch failed: %s (grid %d)\n", hipGetErrorString(e), grid); }
#else
    for (int ph = 0; ph < N_PHASES - 1; ++ph) {
        a.ph_lo = ph; a.ph_hi = ph + 1;
        void* args[] = {&a}; hipError_t e = hipLaunchCooperativeKernel((const void*)fwd_mega, dim3(grid), dim3(NT), args, LDS_BYTES, stream);
        if (e != hipSuccess) { fprintf(stderr, "launch of phase %d failed: %s (grid %d)\n", ph, hipGetErrorString(e), grid); break; }
    }
#endif
}
```
